# Optimizing an MI355X kernel written in HIP

```python
import jax, jax.numpy as jnp
from jax import lax
import numpy as np

D_MODEL = 1024
BATCH = 16
SEQ = 2048
DEPTH = 4

RWKV_HEAD = 64
RWKV_WIDTH = 1024
RWKV_HEADS = RWKV_WIDTH // RWKV_HEAD
DECAY_LORA = 64
ICLR_LORA = 64
VRES_LORA = 32
RWKV_SHIFT_WIDTH = 3 * RWKV_WIDTH + 2 * DECAY_LORA + 2 * ICLR_LORA
RET_HEADS = 8
RET_QK_HEAD = 64
RET_V_HEAD = 128
RET_QK_WIDTH = RET_HEADS * RET_QK_HEAD
RET_V_WIDTH = RET_HEADS * RET_V_HEAD
RET_CHUNK = 128
ROPE_BASE = 10000.0
N_IN = RWKV_SHIFT_WIDTH + RWKV_WIDTH + 2 * RET_QK_WIDTH + 2 * RET_V_WIDTH + 2 * D_MODEL
NORM_EPS = 1e-6
GN_EPS = 64e-5

kernel_name = "hybrid_rwkv7_retention_gated_encoder"


def _cut_points(widths):
    pts, s = [], 0
    for w in widths[:-1]:
        s += w
        pts.append(s)
    return pts


def rmsnorm(x, g):
    xf = x.astype(jnp.float32)
    y = xf * lax.rsqrt(jnp.mean(xf * xf, axis=-1, keepdims=True) + NORM_EPS)
    return (y * g.astype(jnp.float32)).astype(x.dtype)


def head_norm(y, eps):
    mu = jnp.mean(y, axis=-1, keepdims=True)
    var = jnp.mean(jnp.square(y - mu), axis=-1, keepdims=True)
    yn = (y - mu) * lax.rsqrt(var + eps)
    return yn.reshape(y.shape[0], y.shape[1], -1)


def centred_shift(p, mu_prev, mu_next):
    prev = jnp.pad(p[:, :-1], ((0, 0), (1, 0), (0, 0)))
    nxt = jnp.pad(p[:, 1:], ((0, 0), (0, 1), (0, 0)))
    return p + mu_prev * (prev - p) + mu_next * (nxt - p)


def wkv7_scan(r, w, k, v, a, b, reverse):
    B, _, H, N = r.shape

    def step(S, inp):
        r_t, w_t, k_t, v_t, a_t, b_t = inp
        sa = jnp.einsum('bhvk,bhk->bhv', S, a_t)
        S = S * w_t[:, :, None, :] + sa[..., None] * b_t[:, :, None, :] + v_t[..., None] * k_t[:, :, None, :]
        y = jnp.einsum('bhvk,bhk->bhv', S, r_t)
        return S, y

    xs = tuple(jnp.moveaxis(t, 1, 0) for t in (r, w, k, v, a, b))
    S0 = jnp.zeros((B, H, N, N), jnp.float32)
    _, ys = lax.scan(step, S0, xs, reverse=reverse)
    return jnp.moveaxis(ys, 0, 1)


def rwkv7_branch(r, k, v, dec_lo, iclr_lo, w_decay_up, decay_bias, w_iclr_up, iclr_bias,
                 k_k, k_a, r_k, lnx_gain, lnx_bias):
    f32 = jnp.float32
    r, k, v = r.astype(f32), k.astype(f32), v.astype(f32)
    B, S, _ = r.shape
    hs = lambda t: t.reshape(B, S, RWKV_HEADS, RWKV_HEAD)
    kk = hs(k * k_k)
    kk = kk * lax.rsqrt(jnp.sum(kk * kk, axis=-1, keepdims=True) + 1e-12)
    rh, vh = hs(r), hs(v)
    y = jnp.zeros_like(rh)
    bonus = jnp.zeros_like(rh)
    for d in range(2):
        decay_logit = -jax.nn.softplus(-(decay_bias[d] + jnp.tanh(dec_lo[d].astype(f32)) @ w_decay_up[d])) - 0.5
        w = jnp.exp(-jnp.exp(decay_logit))
        a = jax.nn.sigmoid(iclr_bias[d] + iclr_lo[d].astype(f32) @ w_iclr_up[d])
        kd = k * (1.0 + (a - 1.0) * k_a)
        ah, kdh = hs(a), hs(kd)
        y = y + wkv7_scan(rh, hs(w), kdh, vh, -kk, kk * ah, reverse=(d == 1))
        bonus = bonus + jnp.sum(rh * kdh * r_k, axis=-1, keepdims=True) * vh
    return head_norm(y, GN_EPS) * lnx_gain + lnx_bias + bonus.reshape(B, S, -1)


def rotary(x, pos):
    half = x.shape[-1] // 2
    freqs = jnp.power(ROPE_BASE, -jnp.arange(half, dtype=jnp.float32) / half)
    ang = pos[:, None] * freqs[None, :]
    cos = jnp.cos(ang)[None, :, None, :]
    sin = jnp.sin(ang)[None, :, None, :]
    x1, x2 = x[..., :half], x[..., half:]
    return jnp.concatenate([x1 * cos - x2 * sin, x1 * sin + x2 * cos], axis=-1)


def retention_chunkwise(q, k, v, log_g, strict):
    f32 = jnp.float32
    B, H, S, dk = q.shape
    dv = v.shape[-1]
    C = RET_CHUNK
    NC = S // C
    qc = q.reshape(B, H, NC, C, dk)
    kc = k.reshape(B, H, NC, C, dk)
    vc = v.reshape(B, H, NC, C, dv)
    idx = jnp.arange(C)
    diff = idx[:, None] - idx[None, :]
    mask = (diff > 0) if strict else (diff >= 0)
    dmat = jnp.where(mask[None], jnp.exp(jnp.where(mask, diff, 0)[None].astype(f32) * log_g[:, None, None]), 0.0)
    scores = jnp.einsum('bhncd,bhnmd->bhncm', qc, kc) * dmat[None, :, None]
    intra = jnp.einsum('bhncm,bhnme->bhnce', scores, vc)
    posf = idx.astype(f32)
    xi = jnp.exp((posf + 1.0) * log_g[:, None])
    zeta = jnp.exp((C - 1.0 - posf) * log_g[:, None])
    kv = jnp.einsum('bhncd,hc,bhnce->bhnde', kc, zeta, vc)
    chunk_decay = jnp.exp(C * log_g)[None, :, None, None]

    def step(state, kv_j):
        return state * chunk_decay + kv_j, state

    _, s_prev = lax.scan(step, jnp.zeros((B, H, dk, dv), f32), jnp.moveaxis(kv, 2, 0))
    s_prev = jnp.moveaxis(s_prev, 0, 2)
    cross = jnp.einsum('bhncd,bhnde->bhnce', qc, s_prev) * xi[None, :, None, :, None]
    return (intra + cross).reshape(B, H, S, dv)


def retention_branch(q, k, v, gain):
    f32 = jnp.float32
    B, S, _ = q.shape
    q = q.astype(f32).reshape(B, S, RET_HEADS, RET_QK_HEAD)
    k = k.astype(f32).reshape(B, S, RET_HEADS, RET_QK_HEAD)
    v = v.astype(f32).reshape(B, S, RET_HEADS, RET_V_HEAD)
    pos = jnp.arange(S, dtype=f32)
    q = rotary(q, pos) * (RET_QK_HEAD ** -0.5)
    k = rotary(k, pos)
    q, k, v = (t.transpose(0, 2, 1, 3) for t in (q, k, v))
    log_g = jnp.log1p(-jnp.exp2(-5.0 - jnp.arange(RET_HEADS, dtype=f32)))
    fwd = retention_chunkwise(q, k, v, log_g, strict=False)
    bwd = jnp.flip(retention_chunkwise(jnp.flip(q, 2), jnp.flip(k, 2), jnp.flip(v, 2), log_g, strict=True), 2)
    y = (fwd + bwd).transpose(0, 2, 1, 3)
    return head_norm(y, NORM_EPS) * gain


def setup_inputs(seed: int = 0) -> dict:
    key = jax.random.key(seed)
    ks = jax.random.split(key, 32)
    n = jax.random.normal
    f32 = jnp.float32
    L, D, DA, DB = DEPTH, D_MODEL, RWKV_WIDTH, RET_V_WIDTH
    decay_base = jnp.linspace(-5.0, 1.0, DA, dtype=f32)
    return {
        "x": n(ks[0], (BATCH, SEQ, D), f32),
        "norm_gain": 1.0 + 0.02 * n(ks[1], (L, D), f32),
        "w_in": n(ks[2], (L, D, N_IN), f32) * D ** -0.5,
        "w_vres_down": n(ks[3], (L - 1, D, VRES_LORA), f32) * D ** -0.5,
        "shift_prev": jax.random.uniform(ks[4], (L, RWKV_SHIFT_WIDTH), f32, 0.1, 0.6),
        "shift_next": jax.random.uniform(ks[5], (L, RWKV_SHIFT_WIDTH), f32, 0.1, 0.6),
        "w_decay_up": n(ks[6], (L, 2, DECAY_LORA, DA), f32) * 0.1,
        "decay_bias": decay_base + 0.3 * n(ks[7], (L, 2, DA), f32),
        "w_iclr_up": n(ks[8], (L, 2, ICLR_LORA, DA), f32) * 0.1,
        "iclr_bias": 0.1 * n(ks[9], (L, 2, DA), f32),
        "w_vres_up": n(ks[10], (L - 1, VRES_LORA, DA), f32) * 0.1,
        "vres_bias": 0.1 * n(ks[11], (L - 1, DA), f32),
        "k_k": 0.85 + 0.02 * n(ks[12], (L, DA), f32),
        "k_a": 1.0 + 0.02 * n(ks[13], (L, DA), f32),
        "r_k": 0.1 * n(ks[14], (L, RWKV_HEADS, RWKV_HEAD), f32),
        "lnx_gain": 1.0 + 0.02 * n(ks[15], (L, DA), f32),
        "lnx_bias": 0.02 * n(ks[16], (L, DA), f32),
        "w_branch_a": n(ks[17], (L, DA, D), f32) * DA ** -0.5,
        "ret_norm_gain": 1.0 + 0.02 * n(ks[18], (L, DB), f32),
        "w_branch_b": n(ks[19], (L, DB, D), f32) * DB ** -0.5,
        "w_out": n(ks[20], (L, D, D), f32) * D ** -0.5,
        "final_gain": 1.0 + 0.02 * n(ks[21], (D,), f32),
    }


def reference(x, norm_gain, w_in, w_vres_down, shift_prev, shift_next, w_decay_up, decay_bias,
              w_iclr_up, iclr_bias, w_vres_up, vres_bias, k_k, k_a, r_k, lnx_gain, lnx_bias,
              w_branch_a, ret_norm_gain, w_branch_b, w_out, final_gain):
    shift_cuts = _cut_points([RWKV_WIDTH] * 3 + [DECAY_LORA] * 2 + [ICLR_LORA] * 2)
    rest_cuts = _cut_points([RWKV_WIDTH, RET_QK_WIDTH, RET_QK_WIDTH, RET_V_WIDTH, RET_V_WIDTH,
                             D_MODEL, D_MODEL, VRES_LORA])
    v_first = None
    for l in range(DEPTH):
        hn = rmsnorm(x, norm_gain[l])
        w_l = w_in[l] if l == 0 else jnp.concatenate([w_in[l], w_vres_down[l - 1]], axis=1)
        proj = hn @ w_l
        shifted = centred_shift(proj[..., :RWKV_SHIFT_WIDTH], shift_prev[l], shift_next[l])
        r, k, v, dec_f, dec_b, iclr_f, iclr_b = jnp.split(shifted, shift_cuts, axis=-1)
        gate_a, q_b, k_b, v_b, gate_b, mg_a, mg_b, vres_lo = jnp.split(proj[..., RWKV_SHIFT_WIDTH:], rest_cuts, axis=-1)
        if l == 0:
            v_first = v
        else:
            v = v + (v_first - v) * jax.nn.sigmoid(vres_bias[l - 1] + vres_lo @ w_vres_up[l - 1])
        y_a = rwkv7_branch(r, k, v, (dec_f, dec_b), (iclr_f, iclr_b), w_decay_up[l], decay_bias[l],
                           w_iclr_up[l], iclr_bias[l], k_k[l], k_a[l], r_k[l], lnx_gain[l], lnx_bias[l])
        y_a = y_a.astype(x.dtype) * jax.nn.silu(gate_a)
        y_b = retention_branch(q_b, k_b, v_b, ret_norm_gain[l]).astype(x.dtype) * jax.nn.silu(gate_b)
        merged = jax.nn.sigmoid(mg_a) * (y_a @ w_branch_a[l]) + jax.nn.sigmoid(mg_b) * (y_b @ w_branch_b[l])
        x = x + merged @ w_out[l]
    return rmsnorm(x, final_gain)
```

```cpp
#include <hip/hip_runtime.h>
#include <hip/hip_cooperative_groups.h>
#include <cstdio>
#include <cstdint>
namespace cg = cooperative_groups;
namespace pg8 {
#define PG8_LAS __attribute__((address_space(3)))
typedef unsigned short bf16_t;
typedef short bf16x8 __attribute__((ext_vector_type(8)));
typedef float f32x4 __attribute__((ext_vector_type(4)));
typedef unsigned u32x4 __attribute__((ext_vector_type(4)));
constexpr int BM = 256, BK = 64, HALF = 128, HTB = HALF * BK * 2  , STAGE_BYTES = 8 * HTB, NXCD = 8, WGM = 8;

__host__ __device__ __forceinline__ int lds_byte(int r, int c) { const int st = (r >> 4) * 2 + (c >> 5), rr = r & 15, cc = c & 31, ob = rr * 64 + cc * 2; return st * 1024 + (ob ^ (((ob >> 9) & 1) << 5)); }
__host__ __device__ __forceinline__ void stage_rc(int b, int& R, int& C) { const int st = b / 1024, sb = b % 1024, swz = sb ^ (((sb >> 9) & 1) << 5); R = (st >> 1) * 16 + swz / 64; C = (st & 1) * 32 + (swz % 64) / 2; }
__host__ __device__ __forceinline__ int perm32(int rho) { const int n = rho >> 4, i = rho & 15; return 8 * (i >> 2) + 4 * n + (i & 3); }

struct Unit { int pm, pn; };
struct Gemm { const bf16_t* A; const bf16_t* Bt; int M, N, K; };

struct StaticOrder {
    int nM, nN, nwg, G, c;
    __host__ __device__ void init(int M, int N, int G_, int c_) { nM = M / BM; nN = N / BM; nwg = nM * nN; G = G_; c = c_; }
    __host__ __device__ bool next(int i, Unit& u) const {
        const long L = (long)i * G + c; if (L >= nwg) return false;
        int wgid = (int)L; { const int q = nwg / NXCD, r = nwg % NXCD, xcd = wgid % NXCD, off = wgid / NXCD; wgid = (xcd < r ? xcd * (q + 1) : r * (q + 1) + (xcd - r) * q) + off; }
        const int nig = WGM * nN, gid = wgid / nig, fm = gid * WGM, gsz = (nM - fm) < WGM ? (nM - fm) : WGM;
        u.pm = fm + ((wgid % nig) % gsz); u.pn = (wgid % nig) / gsz; return true;
    }
    __device__ __forceinline__ void a_ready(const Unit&) const {}
    __device__ __forceinline__ void done(const Unit&) const {}
};
__device__ __forceinline__ unsigned cvt_pk_bf16(float lo, float hi) { unsigned r; asm volatile("v_cvt_pk_bf16_f32 %0, %1, %2" : "=v"(r) : "v"(lo), "v"(hi)); return r; }
typedef float f32x2 __attribute__((ext_vector_type(2)));
template <class Epi, class Sched, bool ALIGN_EPI = false, bool SP2 = false>
__device__ __forceinline__ void gemm_phase(PG8_LAS unsigned char* lds, const Gemm g, const Sched& S, const Epi& E) {
    int tid_ = threadIdx.x; asm volatile("" : "+v"(tid_));
    const int tid = tid_, wid = __builtin_amdgcn_readfirstlane(tid >> 6), lane = tid & 63, wr = wid >> 2, wc = wid & 3, fr = lane & 15, fq = lane >> 4;
    const int K = g.K, nt = K / BK;
    unsigned voffA[2], voffB[2];
#pragma unroll
    for (int i = 0; i < 2; ++i) { int R, C; stage_rc(tid * 16 + i * 8192, R, C); const int Rb = Epi::PERM ? ((R & ~31) + perm32(R & 31)) : R;
        voffA[i] = (unsigned)(R * K + C) * 2u; voffB[i] = (unsigned)(Rb * K + C) * 2u; }
    const size_t kstep = (size_t)(BK * 2);
    const size_t hstep = (size_t)HALF * K * 2;
    const size_t tstep = 2 * hstep;
    const unsigned ldsw = (unsigned)wid * 1024u;
    const int aoff = lds_byte(wr * 64 + fr, fq * 8), boff = lds_byte(wc * 32 + fr, fq * 8);
#define PG8_SA(b, h) (((b) * 2 + (h)) * HTB)
#define PG8_SB(b, h) ((4 + (b) * 2 + (h)) * HTB)
#define PG8_STAGE(bufoff, gbase, voff) do { _Pragma("unroll") for (int _i = 0; _i < 2; ++_i) \
        __builtin_amdgcn_global_load_lds((const unsigned*)((const char*)(gbase) + (voff)[_i]), (PG8_LAS unsigned*)(lds + (bufoff) + ldsw + _i * 8192), 16, 0, 0); } while (0)
#define PG8_LDA(dst, b, h) do { _Pragma("unroll") for (int m = 0; m < 4; ++m) _Pragma("unroll") for (int k = 0; k < 2; ++k) dst[m][k] = *(const PG8_LAS bf16x8*)(lds + PG8_SA(b, h) + aoff + m * 2048 + k * 1024); } while (0)
#define PG8_LDB(dst, b, h) do { _Pragma("unroll") for (int n = 0; n < 2; ++n) _Pragma("unroll") for (int k = 0; k < 2; ++k) dst[n][k] = *(const PG8_LAS bf16x8*)(lds + PG8_SB(b, h) + boff + n * 2048 + k * 1024); } while (0)
#define PG8_MMA(ai, bj, At, Bt) do { __builtin_amdgcn_s_setprio(1); _Pragma("unroll") for (int m = 0; m < 4; ++m) _Pragma("unroll") for (int n = 0; n < 2; ++n) _Pragma("unroll") for (int k = 0; k < 2; ++k) \
        acc[ai][bj][m][n] = __builtin_amdgcn_mfma_f32_16x16x32_bf16(Bt[n][k], At[m][k], acc[ai][bj][m][n], 0, 0, 0); __builtin_amdgcn_s_setprio(0); } while (0)
#define PG8_WAIT_V(n) asm volatile("s_waitcnt vmcnt(" #n ")" ::: "memory")
#define PG8_WAIT_L(n) asm volatile("s_waitcnt lgkmcnt(" #n ")" ::: "memory")
#define PG8_BAR __builtin_amdgcn_s_barrier()
#define PG8_SCHED __builtin_amdgcn_sched_barrier(0)
    Unit cur, nxt; int ui = 0;
    if (!S.next(0, cur)) return;
    f32x4 acc[2][2][4][2];
#pragma unroll
    for (int a = 0; a < 2; ++a)
#pragma unroll
        for (int b = 0; b < 2; ++b)
#pragma unroll
            for (int m = 0; m < 4; ++m)
#pragma unroll
                for (int n = 0; n < 2; ++n) acc[a][b][m][n] = (f32x4){0.f, 0.f, 0.f, 0.f};
    bf16x8 At[4][2], B0[2][2], B1[2][2];
    const char* cA = (const char*)g.A + (size_t)cur.pm * tstep; const char* cB = (const char*)g.Bt + (size_t)cur.pn * tstep;
    S.a_ready(cur);
    if constexpr (SP2) {
        PG8_STAGE(PG8_SB(0, 0), cB, voffB); PG8_STAGE(PG8_SB(0, 1), cB + hstep, voffB); PG8_STAGE(PG8_SA(0, 0), cA, voffA); PG8_STAGE(PG8_SA(0, 1), cA + hstep, voffA);
        if (wr == 1) PG8_BAR;
        PG8_WAIT_V(2); PG8_BAR;
        PG8_STAGE(PG8_SB(1, 0), cB + kstep, voffB); PG8_STAGE(PG8_SA(1, 0), cA + kstep, voffA); PG8_STAGE(PG8_SB(1, 1), cB + hstep + kstep, voffB);
        PG8_WAIT_V(6); PG8_BAR;
    } else {
        PG8_STAGE(PG8_SB(0, 0), cB, voffB); PG8_STAGE(PG8_SA(0, 0), cA, voffA); PG8_STAGE(PG8_SB(0, 1), cB + hstep, voffB); PG8_STAGE(PG8_SA(0, 1), cA + hstep, voffA);
        if (wr == 1) PG8_BAR;
        PG8_WAIT_V(4); PG8_BAR;
        PG8_STAGE(PG8_SB(1, 0), cB + kstep, voffB); PG8_STAGE(PG8_SA(1, 0), cA + kstep, voffA); PG8_STAGE(PG8_SB(1, 1), cB + hstep + kstep, voffB);
        PG8_WAIT_V(6); PG8_BAR;
    }
    for (;;) {
        const bool has_next = S.next(ui + 1, nxt);
        const char* nA = has_next ? (const char*)g.A + (size_t)nxt.pm * tstep : cA; const char* nB = has_next ? (const char*)g.Bt + (size_t)nxt.pn * tstep : cB;
        for (int t = 0; t < nt; t += 2) {
            const bool last = (t == nt - 2);
            const char* a1 = cA + (size_t)(t + 1) * kstep;
            const char* a2 = last ? nA : cA + (size_t)(t + 2) * kstep; const char* b2 = last ? nB : cB + (size_t)(t + 2) * kstep;
            const char* a3 = a2 + kstep; const char* b3 = b2 + kstep;
            if (last && has_next) S.a_ready(nxt);
            if constexpr (SP2) {
            PG8_LDB(B0, 0, 0); PG8_LDB(B1, 0, 1); PG8_SCHED; PG8_LDA(At, 0, 0); PG8_STAGE(PG8_SA(1, 1), a1 + hstep, voffA);
            PG8_WAIT_V(8); PG8_WAIT_L(0); PG8_BAR; PG8_MMA(0, 0, At, B0); PG8_MMA(0, 1, At, B1); PG8_BAR; PG8_SCHED;
            PG8_LDA(At, 0, 1); PG8_STAGE(PG8_SB(0, 0), b2, voffB); PG8_STAGE(PG8_SB(0, 1), b2 + hstep, voffB); PG8_STAGE(PG8_SA(0, 0), a2, voffA);
            PG8_WAIT_V(8); PG8_WAIT_L(0); PG8_BAR; PG8_MMA(1, 0, At, B0); PG8_MMA(1, 1, At, B1); PG8_BAR; PG8_SCHED;
            PG8_LDB(B0, 1, 0); PG8_LDB(B1, 1, 1); PG8_SCHED; PG8_LDA(At, 1, 0); PG8_STAGE(PG8_SA(0, 1), a2 + hstep, voffA);
            PG8_WAIT_V(8); PG8_WAIT_L(0); PG8_BAR; PG8_MMA(0, 0, At, B0); PG8_MMA(0, 1, At, B1); PG8_BAR; PG8_SCHED;
            PG8_LDA(At, 1, 1); PG8_STAGE(PG8_SB(1, 0), b3, voffB); PG8_STAGE(PG8_SB(1, 1), b3 + hstep, voffB); PG8_STAGE(PG8_SA(1, 0), a3, voffA);
            PG8_WAIT_V(8); PG8_WAIT_L(0); PG8_BAR; PG8_MMA(1, 0, At, B0); PG8_MMA(1, 1, At, B1); PG8_BAR; PG8_SCHED;
            } else {
            PG8_LDB(B0, 0, 0); PG8_SCHED; PG8_LDA(At, 0, 0); PG8_STAGE(PG8_SA(1, 1), a1 + hstep, voffA);
            PG8_WAIT_L(8); PG8_BAR; PG8_WAIT_L(0); PG8_MMA(0, 0, At, B0); PG8_BAR; PG8_SCHED;
            PG8_LDB(B1, 0, 1); PG8_STAGE(PG8_SB(0, 0), b2, voffB);
            PG8_BAR; PG8_WAIT_L(0); PG8_MMA(0, 1, At, B1); PG8_BAR;
            PG8_LDA(At, 0, 1); PG8_STAGE(PG8_SA(0, 0), a2, voffA);
            PG8_BAR; PG8_WAIT_L(0); PG8_MMA(1, 0, At, B0); PG8_BAR; PG8_SCHED;
            PG8_STAGE(PG8_SB(0, 1), b2 + hstep, voffB);
            PG8_WAIT_V(6); PG8_BAR; PG8_MMA(1, 1, At, B1); PG8_BAR;
            PG8_LDB(B0, 1, 0); PG8_SCHED; PG8_LDA(At, 1, 0); PG8_STAGE(PG8_SA(0, 1), a2 + hstep, voffA);
            PG8_WAIT_L(8); PG8_BAR; PG8_WAIT_L(0); PG8_MMA(0, 0, At, B0); PG8_BAR; PG8_SCHED;
            PG8_LDB(B1, 1, 1); PG8_STAGE(PG8_SB(1, 0), b3, voffB);
            PG8_BAR; PG8_WAIT_L(0); PG8_MMA(0, 1, At, B1); PG8_BAR;
            PG8_LDA(At, 1, 1); PG8_STAGE(PG8_SA(1, 0), a3, voffA);
            PG8_BAR; PG8_WAIT_L(0); PG8_MMA(1, 0, At, B0); PG8_BAR; PG8_SCHED;
            PG8_STAGE(PG8_SB(1, 1), b3 + hstep, voffB);
            PG8_WAIT_V(6); PG8_BAR; PG8_MMA(1, 1, At, B1); PG8_BAR;
            }
        }
        if constexpr (ALIGN_EPI) { if (wr == 0) PG8_BAR; }
        if constexpr (!Epi::AFTER_DRAIN) { E(acc, cur, wr, wc, fr, fq); S.done(cur); }
        if (!has_next) break;
#pragma unroll
        for (int a = 0; a < 2; ++a)
#pragma unroll
            for (int b = 0; b < 2; ++b)
#pragma unroll
                for (int m = 0; m < 4; ++m)
#pragma unroll
                    for (int n = 0; n < 2; ++n) acc[a][b][m][n] = (f32x4){0.f, 0.f, 0.f, 0.f};
        cur = nxt; cA = nA; cB = nB; ++ui;
        if constexpr (ALIGN_EPI) { if (wr == 1) PG8_BAR; }
    }
    PG8_WAIT_V(0);
    if constexpr (!ALIGN_EPI) { if (wr == 0) PG8_BAR; }
    PG8_BAR;
    if constexpr (Epi::AFTER_DRAIN) { E.fused(acc, cur, wr, wc, fr, fq, lds, wid, lane); S.done(cur); }
#undef PG8_SA
#undef PG8_SB
#undef PG8_STAGE
#undef PG8_LDA
#undef PG8_LDB
#undef PG8_MMA
#undef PG8_WAIT_V
#undef PG8_WAIT_L
#undef PG8_BAR
#undef PG8_SCHED
}
}
#define PG8_SP2 true
#define PG8_ALIGN true
#define GAS __attribute__((address_space(1)))
#define LAS __attribute__((address_space(3)))
#define CAS __attribute__((address_space(4)))
typedef unsigned short bf16;
typedef unsigned u32x4 __attribute__((ext_vector_type(4)));
typedef unsigned u32x2 __attribute__((ext_vector_type(2)));
typedef float f32x4 __attribute__((ext_vector_type(4)));
typedef float f32x2 __attribute__((ext_vector_type(2)));
typedef short bf16x8 __attribute__((ext_vector_type(8)));
#define LDS_WAIT() asm volatile("s_waitcnt lgkmcnt(0)" ::: "memory")
#define VM_WAIT() asm volatile("s_waitcnt vmcnt(0)" ::: "memory")

constexpr int BATCH = 16, SEQ = 2048, DM = 1024, DEPTH = 4, T = BATCH * SEQ;
constexpr int NIN = 9472;
constexpr int NA = 3584, LDA = 3360;
constexpr int CHS = 16, NCH = SEQ / CHS;
constexpr int RSTEP = 260;
constexpr int RC = 128, NRC = SEQ / RC;
constexpr size_t MiB = 1u << 20;
constexpr size_t OFF_WA = 2 * MiB, OFF_WB = 9 * MiB, OFF_WG = 13 * MiB, OFF_Wa = 21 * MiB, OFF_Wb = 23 * MiB, OFF_Wo = 25 * MiB;
constexpr size_t OFF_WDEC = 27 * MiB, OFF_WIC = OFF_WDEC + 256 * 1024, OFF_WVR = OFF_WIC + 256 * 1024, OFF_ROT = OFF_WVR + 64 * 1024;
constexpr size_t OFF_VFIRST = 29 * MiB, OFF_VFIN = 93 * MiB, OFF_YS = 157 * MiB, OFF_COEF = 221 * MiB, OFF_XB = 225 * MiB, OFF_RAWA = 289 * MiB;
constexpr size_t OFF_YB = OFF_VFIN;
constexpr size_t OFF_RAWB = OFF_RAWA, OFF_ST = OFF_RAWA + 128 * MiB;
constexpr size_t OFF_SIGA = OFF_RAWA, OFF_SIGB = OFF_RAWA + 64 * MiB, OFF_M1 = OFF_ST, OFF_MG = OFF_XB;
constexpr size_t OFF_COEF2 = 499 * MiB;
constexpr size_t WS_END = 503 * MiB;
static_assert(OFF_ROT + 2 * 2048 * 32 * 4 <= OFF_VFIRST, "small region");
static_assert(32768 + 2 * 2 * CHS * RSTEP * 4 <= 133120, "scan LDS map");
static_assert(OFF_RAWA + (size_t)T * LDA * 2 <= WS_END, "rawA");
constexpr int XB_LDS_OFF = 133120 + 16384 + 6144;
constexpr int LDS_BYTES = XB_LDS_OFF + 64;

enum { I_X = 0, I_NG, I_WIN, I_WVD, I_SP, I_SN, I_WDU, I_DB, I_WIU, I_IB, I_WVU, I_VB, I_KK, I_KA, I_RK, I_LG, I_LB, I_WBA, I_RG, I_WBB, I_WO, I_FG };
struct Params { const float* in[22]; float* out; unsigned char* ws; };
#define KARG() ({ const CAS Params* kp_ = (const CAS Params*)__builtin_amdgcn_kernarg_segment_ptr(); asm volatile("" : "+s"(kp_)); kp_; })

__device__ __forceinline__ unsigned f2bf(float f) { unsigned u = __builtin_bit_cast(unsigned, f); return (u + 0x7fffu + ((u >> 16) & 1u)) >> 16; }
__device__ __forceinline__ unsigned pk2(float lo, float hi) { return f2bf(lo) | (f2bf(hi) << 16); }
__device__ __forceinline__ float bflo(unsigned u) { return __builtin_bit_cast(float, u << 16); }
__device__ __forceinline__ float bfhi(unsigned u) { return __builtin_bit_cast(float, u & 0xffff0000u); }
__device__ __forceinline__ float bf1(bf16 h) { return __builtin_bit_cast(float, (unsigned)h << 16); }
__device__ __forceinline__ void unpack8(u32x4 u, float* o) { o[0] = bflo(u.x); o[1] = bfhi(u.x); o[2] = bflo(u.y); o[3] = bfhi(u.y); o[4] = bflo(u.z); o[5] = bfhi(u.z); o[6] = bflo(u.w); o[7] = bfhi(u.w); }
__device__ __forceinline__ void unpack4(u32x2 u, float* o) { o[0] = bflo(u.x); o[1] = bfhi(u.x); o[2] = bflo(u.y); o[3] = bfhi(u.y); }
__device__ __forceinline__ u32x4 pack8u(const float* f) { u32x4 u; u.x = pk2(f[0], f[1]); u.y = pk2(f[2], f[3]); u.z = pk2(f[4], f[5]); u.w = pk2(f[6], f[7]); return u; }
__device__ __forceinline__ bf16x8 pack8(const float* f) { return __builtin_bit_cast(bf16x8, pack8u(f)); }
__device__ __forceinline__ float sigm(float x) { return __builtin_amdgcn_rcpf(1.0f + __expf(-x)); }
__device__ __forceinline__ float wave_sum(float v) {
#pragma unroll
    for (int o = 1; o < 64; o <<= 1) v += __shfl_xor(v, o);
    return v;
}
#define MFMA16(a, b, c) __builtin_amdgcn_mfma_f32_16x16x32_bf16((a), (b), (c), 0, 0, 0)

__device__ __forceinline__ void tr_item(const float* W, int ldw, int K, bf16* WT, int item, int nblk, LAS float* scr, int lane) {
    const int kb = item / nblk, nb = item % nblk, k0 = 64 * kb, n0 = 32 * nb;
    float wv[32];
#pragma unroll
    for (int i = 0; i < 32; ++i) wv[i] = W[(size_t)(k0 + 2 * i + (lane >> 5)) * ldw + n0 + (lane & 31)];
#pragma unroll
    for (int i = 0; i < 32; ++i) scr[(2 * i + (lane >> 5)) * 33 + (lane & 31)] = wv[i];
    LDS_WAIT(); asm volatile("" ::: "memory");
    const int c = lane & 7;
#pragma unroll
    for (int j = 0; j < 4; ++j) { const int n = (lane >> 3) + 8 * j; const LAS float* s = scr + (8 * c) * 33 + n;
        u32x4 o; o.x = pk2(s[0 * 33], s[1 * 33]); o.y = pk2(s[2 * 33], s[3 * 33]); o.z = pk2(s[4 * 33], s[5 * 33]); o.w = pk2(s[6 * 33], s[7 * 33]);
        *(u32x4*)(WT + (size_t)(n0 + n) * K + k0 + 8 * c) = o; }
    LDS_WAIT(); asm volatile("" ::: "memory");
}

__device__ __forceinline__ void convert_weights(int l, LAS unsigned char* lds, int gw, int NGW, int wave, int lane) {
    asm volatile("" : "+s"(NGW), "+s"(gw));
    asm volatile("" : "+v"(lane));
    const CAS Params* p = KARG(); unsigned char* ws = p->ws;
    LAS float* scr = (LAS float*)(lds + wave * 16384);
    const float* win = p->in[I_WIN] + (size_t)l * DM * NIN;
    bf16* WA = (bf16*)(ws + OFF_WA); bf16* WB = (bf16*)(ws + OFF_WB); bf16* WG = (bf16*)(ws + OFF_WG);
    constexpr int S1 = 16 * 104, S2 = 16 * 64, S3 = 16 * 32, S4 = 16 * 96, S5 = 512, S8 = 16, S10 = 32;
    constexpr int NIT = S1 + S2 + S3 + S4 + 3 * S5 + S8 + 4 * S10;
    for (int it = gw; it < NIT; it += NGW) {
        int r = it;
        if (r < S1) { tr_item(win, NIN, DM, WA, r, 104, scr, lane); continue; } r -= S1;
        if (r < S2) { tr_item(win + 4352, NIN, DM, WB, r, 64, scr, lane); continue; } r -= S2;
        if (r < S3) { tr_item(win + 3328, NIN, DM, WG, r, 32, scr, lane); continue; } r -= S3;
        if (r < S4) { tr_item(win + 6400, NIN, DM, WG + (size_t)1024 * DM, r, 96, scr, lane); continue; } r -= S4;
        if (r < S5) { tr_item(p->in[I_WBA] + (size_t)l * DM * DM, DM, DM, (bf16*)(ws + OFF_Wa), r, 32, scr, lane); continue; } r -= S5;
        if (r < S5) { tr_item(p->in[I_WBB] + (size_t)l * DM * DM, DM, DM, (bf16*)(ws + OFF_Wb), r, 32, scr, lane); continue; } r -= S5;
        if (r < S5) { tr_item(p->in[I_WO] + (size_t)l * DM * DM, DM, DM, (bf16*)(ws + OFF_Wo), r, 32, scr, lane); continue; } r -= S5;
        if (r < S8) { if (l > 0) tr_item(p->in[I_WVD] + (size_t)(l - 1) * DM * 32, 32, DM, WA + (size_t)3328 * DM, r, 1, scr, lane); continue; } r -= S8;
        { const int which = r / S10, rr = r % S10;
          const float* src = (which < 2 ? p->in[I_WDU] : p->in[I_WIU]) + ((size_t)l * 2 + (which & 1)) * 64 * DM;
          bf16* dst = (bf16*)(ws + (which < 2 ? OFF_WDEC : OFF_WIC)) + (size_t)(which & 1) * DM * 64;
          tr_item(src, DM, 64, dst, rr, 32, scr, lane); }
    }
    const int gt = gw * 64 + lane, NGT = NGW * 64;
    if (l == 0) {
        u32x4* z = (u32x4*)(WA + (size_t)3328 * DM); const u32x4 zero = {0u, 0u, 0u, 0u};
        for (int i = gt; i < 256 * DM * 2 / 16; i += NGT) z[i] = zero;
    } else {
        const float* src = p->in[I_WVU] + (size_t)(l - 1) * 32 * DM; bf16* dst = (bf16*)(ws + OFF_WVR);
        for (int i = gt; i < 32 * DM; i += NGT) { const int n = i >> 5, k = i & 31; dst[i] = (bf16)f2bf(src[(size_t)k * DM + n]); }
    }
}

__device__ __forceinline__ void norm_phase(const float* x, const float* gain, bf16* xb, int gw, int NGW, int lane) {
    asm volatile("" : "+s"(NGW), "+s"(gw));
    asm volatile("" : "+v"(lane));
    for (int m0 = gw; m0 < T; m0 += 4 * NGW) {
        f32x4 v[4][4]; float ss[4];
#pragma unroll
        for (int r = 0; r < 4; ++r) { const int m = m0 + r * NGW < T ? m0 + r * NGW : m0; const f32x4* xr = (const f32x4*)(x + (size_t)m * DM) + lane;
#pragma unroll
            for (int j = 0; j < 4; ++j) v[r][j] = xr[64 * j]; }
#pragma unroll
        for (int r = 0; r < 4; ++r) { float q = 0.f;
#pragma unroll
            for (int j = 0; j < 4; ++j) q += (v[r][j].x * v[r][j].x + v[r][j].y * v[r][j].y) + (v[r][j].z * v[r][j].z + v[r][j].w * v[r][j].w);
            ss[r] = q; }
#pragma unroll
        for (int o = 1; o < 64; o <<= 1) {
#pragma unroll
            for (int r = 0; r < 4; ++r) ss[r] += __shfl_xor(ss[r], o); }
#pragma unroll
        for (int r = 0; r < 4; ++r) { const int m = m0 + r * NGW; if (m < T) {
            const float rs = rsqrtf(ss[r] * (1.f / DM) + 1e-6f);
            u32x2* o8 = (u32x2*)(xb + (size_t)m * DM) + lane;
#pragma unroll
            for (int j = 0; j < 4; ++j) { const f32x4 g = ((const f32x4*)gain)[lane + 64 * j]; u32x2 o; o.x = pk2(v[r][j].x * rs * g.x, v[r][j].y * rs * g.y); o.y = pk2(v[r][j].z * rs * g.z, v[r][j].w * rs * g.w); o8[64 * j] = o; } } }
    }
}
__device__ __forceinline__ void final_norm(float* x, const float* gain, int gw, int NGW, int lane) {
    asm volatile("" : "+s"(NGW), "+s"(gw));
    asm volatile("" : "+v"(lane));
    for (int m0 = gw; m0 < T; m0 += 4 * NGW) {
        f32x4 v[4][4]; float ss[4];
#pragma unroll
        for (int r = 0; r < 4; ++r) { const int m = m0 + r * NGW < T ? m0 + r * NGW : m0; const f32x4* xr = (const f32x4*)(x + (size_t)m * DM) + lane;
#pragma unroll
            for (int j = 0; j < 4; ++j) v[r][j] = xr[64 * j]; }
#pragma unroll
        for (int r = 0; r < 4; ++r) { float q = 0.f;
#pragma unroll
            for (int j = 0; j < 4; ++j) q += (v[r][j].x * v[r][j].x + v[r][j].y * v[r][j].y) + (v[r][j].z * v[r][j].z + v[r][j].w * v[r][j].w);
            ss[r] = q; }
#pragma unroll
        for (int o = 1; o < 64; o <<= 1) {
#pragma unroll
            for (int r = 0; r < 4; ++r) ss[r] += __shfl_xor(ss[r], o); }
#pragma unroll
        for (int r = 0; r < 4; ++r) { const int m = m0 + r * NGW; if (m < T) {
            const float rs = rsqrtf(ss[r] * (1.f / DM) + 1e-6f);
            f32x4* xr = (f32x4*)(x + (size_t)m * DM) + lane;
#pragma unroll
            for (int j = 0; j < 4; ++j) { const f32x4 g = ((const f32x4*)gain)[lane + 64 * j]; xr[64 * j] = v[r][j] * rs * g; } } }
    }
}

template <class F> struct EpiGen {
    static constexpr bool PERM = true, AFTER_DRAIN = false;
    F f;
    __device__ __forceinline__ void operator()(const pg8::f32x4 (&acc)[2][2][4][2], const pg8::Unit& u, int wr, int wc, int fr, int fq) const {
        const int row0 = u.pm * 256 + wr * 64 + fr, col0 = u.pn * 256 + wc * 32 + 8 * fq;
#pragma unroll
        for (int ai = 0; ai < 2; ++ai)
#pragma unroll
            for (int m = 0; m < 4; ++m)
#pragma unroll
                for (int bj = 0; bj < 2; ++bj) {
                    float v[8];
#pragma unroll
                    for (int i = 0; i < 4; ++i) { v[i] = acc[ai][bj][m][0][i]; v[4 + i] = acc[ai][bj][m][1][i]; }
                    f(row0 + ai * 128 + m * 16, col0 + bj * 128, v);
                }
    }
};
struct FStoreA { bf16* O; __device__ __forceinline__ void operator()(int row, int col, const float* v) const { if (col < LDA) *(u32x4*)(O + (size_t)row * LDA + col) = pack8u(v); } };
struct FStoreB { bf16* O; __device__ __forceinline__ void operator()(int row, int col, const float* v) const { *(u32x4*)(O + (size_t)row * 2048 + col) = pack8u(v); } };
struct FGates { bf16 *ya, *yb, *sa, *sb;
    __device__ __forceinline__ void operator()(int row, int col, const float* v) const {
        const int reg = col >> 10, c = col & 1023; const size_t off = (size_t)row * DM + c; float o[8];
        if (reg < 2) { bf16* y = reg == 0 ? ya : yb; float yv[8]; unpack8(*(const u32x4*)(y + off), yv);
#pragma unroll
            for (int i = 0; i < 8; ++i) o[i] = yv[i] * v[i] * sigm(v[i]);
            *(u32x4*)(y + off) = pack8u(o);
        } else { bf16* s = reg == 2 ? sa : sb;
#pragma unroll
            for (int i = 0; i < 8; ++i) o[i] = sigm(v[i]);
            *(u32x4*)(s + off) = pack8u(o); }
    } };
struct FGa { const bf16* sg; bf16* m1; __device__ __forceinline__ void operator()(int row, int col, const float* v) const {
        const size_t off = (size_t)row * DM + col; float g[8], o[8]; unpack8(*(const u32x4*)(sg + off), g);
#pragma unroll
        for (int i = 0; i < 8; ++i) o[i] = g[i] * v[i];
        *(u32x4*)(m1 + off) = pack8u(o); } };
struct FGb { const bf16* sg; const bf16* m1; bf16* mg; __device__ __forceinline__ void operator()(int row, int col, const float* v) const {
        const size_t off = (size_t)row * DM + col; float g[8], a[8], o[8]; unpack8(*(const u32x4*)(sg + off), g); unpack8(*(const u32x4*)(m1 + off), a);
#pragma unroll
        for (int i = 0; i < 8; ++i) o[i] = a[i] + g[i] * v[i];
        *(u32x4*)(mg + off) = pack8u(o); } };
struct FGo { const float* xo; float* xn; __device__ __forceinline__ void operator()(int row, int col, const float* v) const {
        const size_t off = (size_t)row * DM + col; const f32x4 a = *(const f32x4*)(xo + off), b = *(const f32x4*)(xo + off + 4);
        f32x4 o0 = {a.x + v[0], a.y + v[1], a.z + v[2], a.w + v[3]}, o1 = {b.x + v[4], b.y + v[5], b.z + v[6], b.w + v[7]};
        *(f32x4*)(xn + off) = o0; *(f32x4*)(xn + off + 4) = o1; } };

template <class F> __device__ __forceinline__ void run_gemm(LAS unsigned char* lds, const bf16* A, const bf16* Bt, int N, const F& f) {
    pg8::Gemm g{A, Bt, T, N, DM}; pg8::StaticOrder S; S.init(T, N, (int)gridDim.x, (int)blockIdx.x);
    EpiGen<F> E{f};
    pg8::gemm_phase<EpiGen<F>, pg8::StaticOrder, PG8_ALIGN, PG8_SP2>(lds, g, S, E);
}
constexpr int CST_OFF = 133120 + 16384;
constexpr int C_CMP = 0, C_CMN = 256;
constexpr int C_RMP = 512, C_RMN = 704;
constexpr int C_DB = 896, C_IB = 1024;
constexpr int C_KK = 1152, C_KA = 1216, C_RK = 1280, C_VB = 1344, C_END = 1408;
__device__ __forceinline__ void prep_consts(int l, int h, LAS float* cst) {
    const CAS Params* p = KARG();
    for (int i = threadIdx.x; i < C_END; i += 512) {
        float v;
        if (i < 512) { const int r = i & 255, type = r >> 7, dir = (r >> 6) & 1, col = r & 63; const int gc = (type ? 3200 : 3072) + 64 * dir + col; v = (i < 256 ? p->in[I_SP] : p->in[I_SN])[(size_t)l * 3328 + gc]; }
        else if (i < 896) { const int r = (i - 512) % 192, which = r >> 6, col = r & 63; v = (i < 704 ? p->in[I_SP] : p->in[I_SN])[(size_t)l * 3328 + which * 1024 + h * 64 + col]; }
        else if (i < 1152) { const int r = (i - 896) & 127, dir = r >> 6, col = r & 63; v = (i < 1024 ? p->in[I_DB] : p->in[I_IB])[((size_t)l * 2 + dir) * DM + h * 64 + col]; }
        else { const int which = (i - 1152) >> 6, col = i & 63; const float* src = which == 0 ? p->in[I_KK] : which == 1 ? p->in[I_KA] : which == 2 ? p->in[I_RK] : p->in[I_VB];
               v = (which == 3 && l == 0) ? 0.f : src[(size_t)(which == 3 ? l - 1 : l) * DM + h * 64 + col]; }
        cst[i] = v;
    }
}
typedef __bf16 bf16x2_t __attribute__((ext_vector_type(2)));
__device__ __forceinline__ unsigned cvtpk(float lo, float hi) { const f32x2 v = {lo, hi}; const bf16x2_t b = __builtin_convertvector(v, bf16x2_t); return __builtin_bit_cast(unsigned, b); }
__device__ __forceinline__ f32x2 mixp(unsigned c, unsigned pv, unsigned nv, f32x2 m1, f32x2 m2) {
    const f32x2 fc = {bflo(c), bfhi(c)}, fp = {bflo(pv), bfhi(pv)}, fn = {bflo(nv), bfhi(nv)};
    return fc + m1 * (fp - fc) + m2 * (fn - fc);
}
__device__ __forceinline__ void mix8p(const u32x4 c, const u32x4 pv, const u32x4 nv, const LAS float* mp, const LAS float* mn, float* o) {
    const f32x4 a0 = *(const LAS f32x4*)mp, a1 = *(const LAS f32x4*)(mp + 4), b0 = *(const LAS f32x4*)mn, b1 = *(const LAS f32x4*)(mn + 4);
    const f32x2 r0 = mixp(c.x, pv.x, nv.x, (f32x2){a0.x, a0.y}, (f32x2){b0.x, b0.y}), r1 = mixp(c.y, pv.y, nv.y, (f32x2){a0.z, a0.w}, (f32x2){b0.z, b0.w});
    const f32x2 r2 = mixp(c.z, pv.z, nv.z, (f32x2){a1.x, a1.y}, (f32x2){b1.x, b1.y}), r3 = mixp(c.w, pv.w, nv.w, (f32x2){a1.z, a1.w}, (f32x2){b1.z, b1.w});
    o[0] = r0.x; o[1] = r0.y; o[2] = r1.x; o[3] = r1.y; o[4] = r2.x; o[5] = r2.y; o[6] = r3.x; o[7] = r3.y;
}
__device__ __forceinline__ void mix4p(const u32x2 c, const u32x2 pv, const u32x2 nv, const LAS float* mp, const LAS float* mn, float* o) {
    const f32x4 a0 = *(const LAS f32x4*)mp, b0 = *(const LAS f32x4*)mn;
    const f32x2 r0 = mixp(c.x, pv.x, nv.x, (f32x2){a0.x, a0.y}, (f32x2){b0.x, b0.y}), r1 = mixp(c.y, pv.y, nv.y, (f32x2){a0.z, a0.w}, (f32x2){b0.z, b0.w});
    o[0] = r0.x; o[1] = r0.y; o[2] = r1.x; o[3] = r1.y;
}
#define PREP_COMMON() \
    const CAS Params* p = KARG(); unsigned char* ws = p->ws; \
    asm volatile("" : "+v"(lane));     \
    const int fr = lane & 15, fq = lane >> 4; \
    const int s = fr, t = dir == 0 ? c * CHS + s : SEQ - 1 - c * CHS - s; \
    const size_t row = (size_t)b * SEQ + t; \
    const bf16* rawA = (const bf16*)(ws + OFF_RAWA) + row * LDA; \
    const int dp = t > 0 ? -LDA : 0, dn = t < SEQ - 1 ? LDA : 0;            \
    const bool pz = t > 0, nz = t < SEQ - 1; \
    LAS float* rs_ = rg + s * RSTEP;
#define ZERO_ENDS4(A) do { if (!pz) A[1] = (u32x4){0u, 0u, 0u, 0u}; if (!nz) A[2] = (u32x4){0u, 0u, 0u, 0u}; } while (0)
#define ZERO_ENDS2(A) do { if (!pz) A[1] = (u32x2){0u, 0u}; if (!nz) A[2] = (u32x2){0u, 0u}; } while (0)

__device__ __forceinline__ void prep_x(int l, int b, int h, int dir, int c, LAS float* rg, const LAS float* cst, int lane) {
    PREP_COMMON();
    const bf16* Wd = (const bf16*)(ws + OFF_WDEC) + (size_t)dir * DM * 64; const bf16* Wv = (const bf16*)(ws + OFF_WVR);
    bf16* vfirst = (bf16*)(ws + OFF_VFIRST) + row * DM; bf16* vfin = (bf16*)(ws + OFF_VFIN) + row * DM;
    u32x4 cdr[2][3];
#pragma unroll
    for (int ks = 0; ks < 2; ++ks) { const bf16* q = rawA + 3072 + 64 * dir + 32 * ks + 8 * fq; cdr[ks][0] = *(const u32x4*)q; cdr[ks][1] = *(const u32x4*)(q + dp); cdr[ks][2] = *(const u32x4*)(q + dn); }
    u32x4 bvr = {0u, 0u, 0u, 0u}; if (l > 0) bvr = *(const u32x4*)(rawA + 3328 + 8 * fq);
    u32x4 wdr[4][2], wvr[4]; u32x2 vr_[4][3], vfr[4];
#pragma unroll
    for (int nb = 0; nb < 4; ++nb) { const int chr = h * 64 + nb * 16 + fr;
#pragma unroll
        for (int ks = 0; ks < 2; ++ks) wdr[nb][ks] = *(const u32x4*)(Wd + (size_t)chr * 64 + 32 * ks + 8 * fq);
        wvr[nb] = (u32x4){0u, 0u, 0u, 0u}; if (l > 0) wvr[nb] = *(const u32x4*)(Wv + (size_t)chr * 32 + 8 * fq);
        const int ch = h * 64 + nb * 16 + 4 * fq; const bf16* q = rawA + 2048 + ch;
        vr_[nb][0] = *(const u32x2*)q; vr_[nb][1] = *(const u32x2*)(q + dp); vr_[nb][2] = *(const u32x2*)(q + dn);
        vfr[nb] = (u32x2){0u, 0u}; if (l > 0) vfr[nb] = *(const u32x2*)(vfirst + ch); }
    __builtin_amdgcn_sched_barrier(0);
    bf16x8 bd[2];
#pragma unroll
    for (int ks = 0; ks < 2; ++ks) {
        float o[8]; const int cc = 64 * dir + 32 * ks + 8 * fq;
        ZERO_ENDS4(cdr[ks]);
        mix8p(cdr[ks][0], cdr[ks][1], cdr[ks][2], cst + C_CMP + cc, cst + C_CMN + cc, o);
#pragma unroll
        for (int i = 0; i < 8; ++i) o[i] = 1.0f - 2.0f * __builtin_amdgcn_rcpf(1.0f + __expf(2.0f * o[i]));
        bd[ks] = pack8(o);
    }
    const bf16x8 bv = __builtin_bit_cast(bf16x8, bvr);
#pragma unroll
    for (int nb = 0; nb < 4; ++nb) {
        f32x4 aD = {0.f, 0.f, 0.f, 0.f}, aV = aD;
#pragma unroll
        for (int ks = 0; ks < 2; ++ks) aD = MFMA16(__builtin_bit_cast(bf16x8, wdr[nb][ks]), bd[ks], aD);
        if (l > 0) aV = MFMA16(__builtin_bit_cast(bf16x8, wvr[nb]), bv, aV);
        const int co = nb * 16 + 4 * fq, ch = h * 64 + co;
        float vv[4];
        ZERO_ENDS2(vr_[nb]);
        mix4p(vr_[nb][0], vr_[nb][1], vr_[nb][2], cst + C_RMP + 128 + co, cst + C_RMN + 128 + co, vv);
        const f32x4 dbias = *(const LAS f32x4*)(cst + C_DB + 64 * dir + co);
        if (l > 0) {
            float vf[4]; unpack4(vfr[nb], vf);
            const f32x4 vbias = *(const LAS f32x4*)(cst + C_VB + co);
#pragma unroll
            for (int i = 0; i < 4; ++i) { const float g = sigm(vbias[i] + aV[i]); vv[i] = vv[i] + (vf[i] - vv[i]) * g; }
        }
        if (dir == 0) { u32x2 o; o.x = pk2(vv[0], vv[1]); o.y = pk2(vv[2], vv[3]); *(u32x2*)((l == 0 ? vfirst : vfin) + ch) = o; }
        f32x4 vw, vvv;
#pragma unroll
        for (int i = 0; i < 4; ++i) { vw[i] = __expf(-0.60653066f * sigm(dbias[i] + aD[i])); vvv[i] = vv[i]; }
        *(LAS f32x4*)(rs_ + co) = vw; *(LAS f32x4*)(rs_ + 64 + co) = vvv;
    }
}
__device__ __forceinline__ void prep_y(int l, int b, int h, int dir, int c, LAS float* rg, const LAS float* cst, int lane) {
    PREP_COMMON();
    const bf16* Wi = (const bf16*)(ws + OFF_WIC) + (size_t)dir * DM * 64;
    u32x4 cir[2][3];
#pragma unroll
    for (int ks = 0; ks < 2; ++ks) { const bf16* q = rawA + 3200 + 64 * dir + 32 * ks + 8 * fq; cir[ks][0] = *(const u32x4*)q; cir[ks][1] = *(const u32x4*)(q + dp); cir[ks][2] = *(const u32x4*)(q + dn); }
    u32x4 wir[4][2]; u32x2 kr[4][3], rr_[4][3];
#pragma unroll
    for (int nb = 0; nb < 4; ++nb) { const int chr = h * 64 + nb * 16 + fr;
#pragma unroll
        for (int ks = 0; ks < 2; ++ks) wir[nb][ks] = *(const u32x4*)(Wi + (size_t)chr * 64 + 32 * ks + 8 * fq);
        const bf16* q = rawA + h * 64 + nb * 16 + 4 * fq;
        rr_[nb][0] = *(const u32x2*)q; rr_[nb][1] = *(const u32x2*)(q + dp); rr_[nb][2] = *(const u32x2*)(q + dn);
        kr[nb][0] = *(const u32x2*)(q + 1024); kr[nb][1] = *(const u32x2*)(q + 1024 + dp); kr[nb][2] = *(const u32x2*)(q + 1024 + dn); }
    __builtin_amdgcn_sched_barrier(0);
    bf16x8 bi[2];
#pragma unroll
    for (int ks = 0; ks < 2; ++ks) {
        float o[8]; const int cc = 128 + 64 * dir + 32 * ks + 8 * fq;
        ZERO_ENDS4(cir[ks]);
        mix8p(cir[ks][0], cir[ks][1], cir[ks][2], cst + C_CMP + cc, cst + C_CMN + cc, o);
        bi[ks] = pack8(o);
    }
    float kk[16]; float ss = 0.f;
#pragma unroll
    for (int nb = 0; nb < 4; ++nb) {
        const int co = nb * 16 + 4 * fq;
        ZERO_ENDS2(kr[nb]);
        mix4p(kr[nb][0], kr[nb][1], kr[nb][2], cst + C_RMP + 64 + co, cst + C_RMN + 64 + co, kk + 4 * nb);
        const f32x4 kkw = *(const LAS f32x4*)(cst + C_KK + co);
#pragma unroll
        for (int i = 0; i < 4; ++i) { const float kr_ = kk[4 * nb + i] * kkw[i]; ss += kr_ * kr_; }
    }
    ss += __shfl_xor(ss, 16); ss += __shfl_xor(ss, 32);
    const float nrm = rsqrtf(ss + 1e-12f);
    float cs = 0.f;
#pragma unroll
    for (int nb = 0; nb < 4; ++nb) {
        f32x4 aI = {0.f, 0.f, 0.f, 0.f};
#pragma unroll
        for (int ks = 0; ks < 2; ++ks) aI = MFMA16(__builtin_bit_cast(bf16x8, wir[nb][ks]), bi[ks], aI);
        const int co = nb * 16 + 4 * fq;
        float rr[4];
        ZERO_ENDS2(rr_[nb]);
        mix4p(rr_[nb][0], rr_[nb][1], rr_[nb][2], cst + C_RMP + co, cst + C_RMN + co, rr);
        const f32x4 ibias = *(const LAS f32x4*)(cst + C_IB + 64 * dir + co);
        const f32x4 kkw = *(const LAS f32x4*)(cst + C_KK + co), kaw = *(const LAS f32x4*)(cst + C_KA + co), rkw = *(const LAS f32x4*)(cst + C_RK + co);
        f32x4 va, vb, vkd, vr;
#pragma unroll
        for (int i = 0; i < 4; ++i) {
            const float al = sigm(ibias[i] + aI[i]);
            const float kraw = kk[4 * nb + i];
            const float kn = kraw * kkw[i] * nrm;
            const float kd = kraw * (1.0f + (al - 1.0f) * kaw[i]);
            va[i] = -kn; vb[i] = kn * al; vkd[i] = kd; vr[i] = rr[i];
            cs += rr[i] * kd * rkw[i];
        }
        *(LAS u32x4*)(rs_ + 128 + co) = (u32x4){cvtpk(0.25f * vb[0], 0.25f * vkd[0]), cvtpk(0.25f * vb[1], 0.25f * vkd[1]), cvtpk(0.25f * vb[2], 0.25f * vkd[2]), cvtpk(0.25f * vb[3], 0.25f * vkd[3])};
        *(LAS u32x2*)(rs_ + 192 + (co >> 1)) = (u32x2){cvtpk(va[0], va[1]), cvtpk(va[2], va[3])};
        *(LAS u32x2*)(rs_ + 224 + (co >> 1)) = (u32x2){cvtpk(vr[0], vr[1]), cvtpk(vr[2], vr[3])};
    }
    cs += __shfl_xor(cs, 16); cs += __shfl_xor(cs, 32);
    if (fq == 0) ((float*)(ws + OFF_COEF))[((size_t)dir * T + row) * 16 + h] = cs;
}
#define PREP_ROLE(jw, cc, slot) do { if (((jw) >> 1) == 0) prep_x(l, b, h, (jw) & 1, (cc), ring + (size_t)((slot) * 2 + ((jw) & 1)) * CHS * RSTEP, cst, lane); \
                                     else prep_y(l, b, h, (jw) & 1, (cc), ring + (size_t)((slot) * 2 + ((jw) & 1)) * CHS * RSTEP, cst, lane); } while (0)

#define SCHEDB() __builtin_amdgcn_sched_barrier(0)
__device__ __forceinline__ void swap16(float& a, float& b) { const auto r = __builtin_amdgcn_permlane16_swap(__builtin_bit_cast(unsigned, a), __builtin_bit_cast(unsigned, b), false, false); a = __builtin_bit_cast(float, (unsigned)r[0]); b = __builtin_bit_cast(float, (unsigned)r[1]); }
__device__ __forceinline__ void swap32(float& a, float& b) { const auto r = __builtin_amdgcn_permlane32_swap(__builtin_bit_cast(unsigned, a), __builtin_bit_cast(unsigned, b), false, false); a = __builtin_bit_cast(float, (unsigned)r[0]); b = __builtin_bit_cast(float, (unsigned)r[1]); }
__device__ __forceinline__ float scatter4(float p0, float p1) { swap16(p0, p1); float z = p0 + p1, z2 = z; swap32(z, z2); return z + z2; }
#define SCAN_DOTS(AH0, AH1, D0, D1) do { \
        const u32x4 b00 = {cvtpk(c[0][0].x, c[0][0].y), cvtpk(c[0][0].z, c[0][0].w), cvtpk(c[1][0].x, c[1][0].y), cvtpk(c[1][0].z, c[1][0].w)}; \
        const u32x4 b01 = {cvtpk(c[2][0].x, c[2][0].y), cvtpk(c[2][0].z, c[2][0].w), cvtpk(c[3][0].x, c[3][0].y), cvtpk(c[3][0].z, c[3][0].w)}; \
        const u32x4 b10 = {cvtpk(c[0][1].x, c[0][1].y), cvtpk(c[0][1].z, c[0][1].w), cvtpk(c[1][1].x, c[1][1].y), cvtpk(c[1][1].z, c[1][1].w)}; \
        const u32x4 b11 = {cvtpk(c[2][1].x, c[2][1].y), cvtpk(c[2][1].z, c[2][1].w), cvtpk(c[3][1].x, c[3][1].y), cvtpk(c[3][1].z, c[3][1].w)}; \
        D0 = MFMA16(__builtin_bit_cast(bf16x8, AH0), __builtin_bit_cast(bf16x8, b00), ((f32x4){0.f, 0.f, 0.f, 0.f})); D0 = MFMA16(__builtin_bit_cast(bf16x8, AH1), __builtin_bit_cast(bf16x8, b01), D0); \
        D1 = MFMA16(__builtin_bit_cast(bf16x8, AH0), __builtin_bit_cast(bf16x8, b10), ((f32x4){0.f, 0.f, 0.f, 0.f})); D1 = MFMA16(__builtin_bit_cast(bf16x8, AH1), __builtin_bit_cast(bf16x8, b11), D1); } while (0)
#define SCAN_LD_AV(AH0, AH1, P) do { const u32x2 q0 = *(const LAS u32x2*)((P) + 0), q1 = *(const LAS u32x2*)((P) + 8), q2 = *(const LAS u32x2*)((P) + 16), q3 = *(const LAS u32x2*)((P) + 24); \
        AH0 = (u32x4){q0.x, q0.y, q1.x, q1.y}; AH1 = (u32x4){q2.x, q2.y, q3.x, q3.y}; } while (0)
#define SCAN_STEP(S_, CW, CBK, NW, NBK) do { \
        const int sn = (S_) + 1 < CHS ? (S_) + 1 : (S_); const LAS float* nstep = sl + sn * RSTEP; \
        const LAS float* avp = (asel ? nstep + 192 : sl + (S_) * RSTEP + 224) + 2 * mg;        \
        u32x4 ah0, ah1; SCAN_LD_AV(ah0, ah1, avp); \
        _Pragma("unroll") for (int kt = 0; kt < 4; ++kt) { NW[kt] = *(const LAS f32x4*)(nstep + 16 * kt + 4 * mg); NBK[kt] = ((const LAS unsigned*)nstep)[128 + 16 * kt + v16]; } \
        const float vn0 = vb[sn * RSTEP], vn1 = vb[sn * RSTEP + 16]; \
        SCHEDB(); \
        { bx0.x = cvtpk(x0, v0); bx1.x = cvtpk(x1, v1);     \
        _Pragma("unroll") for (int kt = 0; kt < 4; ++kt) { \
            at.x = CBK[kt]; \
            const f32x4 i0 = MFMA16(__builtin_bit_cast(bf16x8, at), __builtin_bit_cast(bf16x8, bx0), ((f32x4){0.f, 0.f, 0.f, 0.f})); \
            const f32x4 i1 = MFMA16(__builtin_bit_cast(bf16x8, at), __builtin_bit_cast(bf16x8, bx1), ((f32x4){0.f, 0.f, 0.f, 0.f})); \
            _Pragma("unroll") for (int i = 0; i < 4; ++i) { float r0 = __builtin_fmaf(c[kt][0][i], CW[kt][i], i0[i]), r1 = __builtin_fmaf(c[kt][1][i], CW[kt][i], i1[i]); \
                asm("" : "+v"(r0), "+v"(r1));     \
                c[kt][0][i] = r0; c[kt][1][i] = r1; } } } \
        SCHEDB(); \
        { f32x4 d0, d1; SCAN_DOTS(ah0, ah1, d0, d1); \
        x0 = d0[1]; x1 = d1[1]; \
        if (lane < 32) ybuf[(S_) * 32 + lane] = mg == 0 ? d0[0] : d1[0];     } \
        v0 = vn0; v1 = vn1; \
        SCHEDB(); } while (0)
__device__ __forceinline__ void scan_chunk(f32x4 (&c)[4][2], const LAS float* sl  , int rh, LAS float* ybuf  , int lane) {
    const int mg = lane >> 4, v16 = lane & 15;
    const bool asel = (lane & 3) == 1;
    const LAS float* vb = sl + 64 + 32 * rh + v16;
    f32x4 wA[4], wB[4]; unsigned bkA[4], bkB[4];
    u32x4 at = {0u, 0u, 0u, 0u}, bx0 = {0u, 0u, 0u, 0u}, bx1 = {0u, 0u, 0u, 0u};
    float x0, x1;
    {
        u32x4 ah0, ah1; SCAN_LD_AV(ah0, ah1, sl + 192 + 2 * mg);
#pragma unroll
        for (int kt = 0; kt < 4; ++kt) { wA[kt] = *(const LAS f32x4*)(sl + 16 * kt + 4 * mg); bkA[kt] = ((const LAS unsigned*)sl)[128 + 16 * kt + v16]; }
        f32x4 d0, d1; SCAN_DOTS(ah0, ah1, d0, d1);
        x0 = asel ? d0[1] : d0[0]; x1 = asel ? d1[1] : d1[0];
    }
    float v0 = vb[0], v1 = vb[16];
#pragma unroll 1
    for (int s = 0; s < CHS; s += 2) {
        SCAN_STEP(s, wA, bkA, wB, bkB);
        SCAN_STEP(s + 1, wB, bkB, wA, bkA);
    }
}

#define Y_T(dir_, cc, s) ((dir_) == 0 ? (cc) * CHS + (s) : SEQ - 1 - (cc) * CHS - (s))
__device__ __forceinline__ void yflush_issue(unsigned (&yo)[4], const bf16* yb2  , int dir, int cc, int lane) {
    const int rg = lane >> 4;
    if (cc >= NCH / 2) {
#pragma unroll
        for (int i = 0; i < 4; ++i) yo[i] = *(const unsigned*)(yb2 + (size_t)Y_T(dir, cc, 4 * i + rg) * DM);
    } else {
#pragma unroll
        for (int i = 0; i < 4; ++i) yo[i] = 0u;
    }
}
__device__ __forceinline__ void yflush_finish(const unsigned (&yo)[4], bf16* yb2, const LAS float* ybuf  , int dir, int cc, int lane) {
    const int rg = lane >> 4, cp = lane & 15;
#pragma unroll
    for (int i = 0; i < 4; ++i) { const int s = 4 * i + rg; const f32x2 yv = *(const LAS f32x2*)(ybuf + s * 32 + 2 * cp);
        *(unsigned*)(yb2 + (size_t)Y_T(dir, cc, s) * DM) = pk2(yv.x + bflo(yo[i]), yv.y + bfhi(yo[i])); }
}

__device__ __forceinline__ void scan_phase(int l, LAS unsigned char* lds, int wave, int lane) {
    asm volatile("" : "+v"(lane));
    unsigned char* ws = KARG()->ws;
    LAS float* ring = (LAS float*)(lds + 32768);
    for (int bh = blockIdx.x; bh < BATCH * 16; bh += gridDim.x) {
        const int b = bh >> 4, h = bh & 15;
        LAS f32x4* sts = (LAS f32x4*)lds + (wave & 3) * 512 + lane;
        LAS float* cst = (LAS float*)(lds + CST_OFF);
        LAS float* ybw = (LAS float*)(lds + 133120) + (wave & 3) * 2 * CHS * 32;
        const int dirw = wave & 1, rhw = (wave >> 1) & 1;
        bf16* yb2 = (bf16*)(ws + OFF_YS) + (size_t)b * SEQ * DM + h * 64 + 32 * rhw + 2 * (lane & 15);
        prep_consts(l, h, cst);
        LDS_WAIT(); __syncthreads();
        if (wave < 4) {
#pragma unroll
            for (int k = 0; k < 8; ++k) sts[k * 64] = (f32x4){0.f, 0.f, 0.f, 0.f};
        } else PREP_ROLE(wave - 4, 0, 0);
        LDS_WAIT(); __syncthreads();
#pragma unroll 1
        for (int c = 0; c < NCH; ++c) {
            if (wave < 4) {
                f32x4 st[4][2];
#pragma unroll
                for (int k = 0; k < 8; ++k) st[k >> 1][k & 1] = sts[k * 64];
                scan_chunk(st, ring + (size_t)((c & 1) * 2 + dirw) * CHS * RSTEP, rhw, ybw + (c & 1) * CHS * 32, lane);
#pragma unroll
                for (int k = 0; k < 8; ++k) sts[k * 64] = st[k >> 1][k & 1];
            } else {
                unsigned yo[4];
                if (c > 0) yflush_issue(yo, yb2, dirw, c - 1, lane);
                if (c + 1 < NCH) PREP_ROLE(wave - 4, c + 1, (c + 1) & 1);
                if (c > 0) yflush_finish(yo, yb2, ybw + ((c - 1) & 1) * CHS * 32, dirw, c - 1, lane);
            }
            if (c == NCH / 2) VM_WAIT(); else asm volatile("s_waitcnt vmcnt(4)" ::: "memory");
            LDS_WAIT(); __syncthreads();
        }
        if (wave >= 4) { unsigned yo[4]; yflush_issue(yo, yb2, dirw, NCH - 1, lane); yflush_finish(yo, yb2, ybw + ((NCH - 1) & 1) * CHS * 32, dirw, NCH - 1, lane); }
        VM_WAIT(); __syncthreads();
    }
}

__device__ __forceinline__ void postscan_phase(int l, int gw, int NGW, int lane) {
    asm volatile("" : "+s"(NGW), "+s"(gw));
    asm volatile("" : "+v"(lane));
    const CAS Params* p = KARG(); unsigned char* ws = p->ws;
    const bf16* vcur = (const bf16*)(ws + (l == 0 ? OFF_VFIRST : OFF_VFIN));
    const float* coef = (const float*)(ws + OFF_COEF);
    const int ch = 16 * lane, hd = lane >> 2;
    f32x4 g4[4], b4[4];
#pragma unroll
    for (int i = 0; i < 4; ++i) { g4[i] = *(const f32x4*)(p->in[I_LG] + (size_t)l * DM + ch + 4 * i); b4[i] = *(const f32x4*)(p->in[I_LB] + (size_t)l * DM + ch + 4 * i); }
    for (int m0 = gw; m0 < T; m0 += 2 * NGW) {
        u32x4 yr[2][2], vr[2][2]; float cf[2];
#pragma unroll
        for (int r = 0; r < 2; ++r) { const int m = m0 + r * NGW < T ? m0 + r * NGW : m0;
            const bf16* yp = (const bf16*)(ws + OFF_YS) + (size_t)m * DM + ch; const bf16* vp = vcur + (size_t)m * DM + ch;
            yr[r][0] = *(const u32x4*)yp; yr[r][1] = *(const u32x4*)(yp + 8); vr[r][0] = *(const u32x4*)vp; vr[r][1] = *(const u32x4*)(vp + 8);
            cf[r] = coef[(size_t)m * 16 + hd] + coef[((size_t)T + m) * 16 + hd]; }
#pragma unroll
        for (int r = 0; r < 2; ++r) { const int m = m0 + r * NGW; if (m < T) {
            float y[16], v[16];
            unpack8(yr[r][0], y); unpack8(yr[r][1], y + 8); unpack8(vr[r][0], v); unpack8(vr[r][1], v + 8);
            float sm = 0.f;
#pragma unroll
            for (int i = 0; i < 16; ++i) sm += y[i];
            sm += __shfl_xor(sm, 1); sm += __shfl_xor(sm, 2);
            const float mean = sm * (1.f / 64.f); float q = 0.f;
#pragma unroll
            for (int i = 0; i < 16; ++i) { y[i] -= mean; q += y[i] * y[i]; }
            q += __shfl_xor(q, 1); q += __shfl_xor(q, 2);
            const float rstd = rsqrtf(q * (1.f / 64.f) + 64e-5f);
            float o[16];
#pragma unroll
            for (int i = 0; i < 16; i += 4)
#pragma unroll
                for (int j = 0; j < 4; ++j) o[i + j] = y[i + j] * rstd * g4[i >> 2][j] + b4[i >> 2][j] + cf[r] * v[i + j];
            bf16* yp = (bf16*)(ws + OFF_YS) + (size_t)m * DM + ch;
            *(u32x4*)yp = pack8u(o); *(u32x4*)(yp + 8) = pack8u(o + 8); } }
    }
}

__device__ __forceinline__ float ret_log2g(int h) { const float e = exp2f(-5.0f - (float)h); return -1.4426950408889634f * (e + e * e * (0.5f + e * (0.33333333f + e * 0.25f))); }
constexpr int KP = 136;
constexpr int QP = 72;
__device__ __forceinline__ void stage_vt(const bf16* rawB, int b, int h, int j, LAS bf16* Vt, int tid) {
    const int m = tid >> 2, part = tid & 3;
    const bf16* src = rawB + ((size_t)b * SEQ + j * RC + m) * 2048 + 1024 + h * 128 + 32 * part;
#pragma unroll
    for (int q = 0; q < 4; ++q) { float f[8]; const u32x4 u = *(const u32x4*)(src + 8 * q);
        const unsigned w[4] = {u.x, u.y, u.z, u.w};
#pragma unroll
        for (int i = 0; i < 4; ++i) { Vt[(32 * part + 8 * q + 2 * i) * KP + m] = (bf16)(w[i] & 0xffffu); Vt[(32 * part + 8 * q + 2 * i + 1) * KP + m] = (bf16)(w[i] >> 16); }
        (void)f; }
}
__device__ __forceinline__ void rot8(const bf16* src, const float* rot, int pos, int part, float scale, float* o1, float* o2) {
    float x1[8], x2[8]; unpack8(*(const u32x4*)(src + 8 * part), x1); unpack8(*(const u32x4*)(src + 32 + 8 * part), x2);
    const float* cs = rot + (size_t)pos * 32 + 8 * part; const float* sn = rot + (size_t)2048 * 32 + (size_t)pos * 32 + 8 * part;
    const f32x4 c0 = *(const f32x4*)cs, c1 = *(const f32x4*)(cs + 4), s0 = *(const f32x4*)sn, s1 = *(const f32x4*)(sn + 4);
    const float cv[8] = {c0.x, c0.y, c0.z, c0.w, c1.x, c1.y, c1.z, c1.w}, sv[8] = {s0.x, s0.y, s0.z, s0.w, s1.x, s1.y, s1.z, s1.w};
#pragma unroll
    for (int i = 0; i < 8; ++i) { o1[i] = (x1[i] * cv[i] - x2[i] * sv[i]) * scale; o2[i] = (x1[i] * sv[i] + x2[i] * cv[i]) * scale; }
}
__device__ __forceinline__ void ret_states_phase(LAS unsigned char* lds, int wave, int lane_) {
    int tid = threadIdx.x; asm volatile("" : "+v"(tid)); const int lane = tid & 63;
    const CAS Params* p = KARG(); unsigned char* ws = p->ws; const int fr = lane & 15, fq = lane >> 4;
    const bf16* rawB = (const bf16*)(ws + OFF_RAWB); const float* rot = (const float*)(ws + OFF_ROT);
    LAS bf16* Kt = (LAS bf16*)lds; LAS bf16* Vt = (LAS bf16*)(lds + 64 * KP * 2);
    const int m = tid >> 2, part = tid & 3;
    for (int it = blockIdx.x; it < BATCH * 8 * 2; it += gridDim.x) {
        const int dir = it & 1, bh = it >> 1, b = bh >> 3, h = bh & 7;
        const float l2g = ret_log2g(h), dC = exp2f(l2g * (float)RC);
        const float z = exp2f(l2g * (float)(dir == 0 ? RC - 1 - m : m));
        f32x4 acc[4];
#pragma unroll
        for (int nb = 0; nb < 4; ++nb) acc[nb] = (f32x4){0.f, 0.f, 0.f, 0.f};
        u32x4 kx1, kx2, vraw[4]; f32x4 c0, c1, s0, s1;
#define R1_LOAD(J_) do { const int pos_ = (J_) * RC + m; const bf16* row_ = rawB + ((size_t)b * SEQ + pos_) * 2048; \
            kx1 = *(const u32x4*)(row_ + 512 + h * 64 + 8 * part); kx2 = *(const u32x4*)(row_ + 512 + h * 64 + 32 + 8 * part); \
            _Pragma("unroll") for (int q = 0; q < 4; ++q) vraw[q] = *(const u32x4*)(row_ + 1024 + h * 128 + 32 * part + 8 * q); \
            const float* cs_ = rot + (size_t)pos_ * 32 + 8 * part; const float* sn_ = cs_ + (size_t)2048 * 32; \
            c0 = *(const f32x4*)cs_; c1 = *(const f32x4*)(cs_ + 4); s0 = *(const f32x4*)sn_; s1 = *(const f32x4*)(sn_ + 4); } while (0)
        R1_LOAD(dir == 0 ? 0 : NRC - 1);
#pragma unroll 1
        for (int jj = 0; jj < NRC; ++jj) {
            const int j = dir == 0 ? jj : NRC - 1 - jj;
            bf16* so = (bf16*)(ws + OFF_ST) + ((size_t)(bh * NRC + j) * 2 + dir) * 8192;
#pragma unroll
            for (int nb = 0; nb < 4; ++nb)
#pragma unroll
                for (int i = 0; i < 4; ++i) { so[(16 * wave + 4 * fq + i) * 64 + nb * 16 + fr] = (bf16)f2bf(acc[nb][i]); acc[nb][i] *= dC; }
            {
                float x1[8], x2[8]; unpack8(kx1, x1); unpack8(kx2, x2);
                const float cv[8] = {c0.x, c0.y, c0.z, c0.w, c1.x, c1.y, c1.z, c1.w}, sv[8] = {s0.x, s0.y, s0.z, s0.w, s1.x, s1.y, s1.z, s1.w};
#pragma unroll
                for (int i = 0; i < 8; ++i) { Kt[(8 * part + i) * KP + m] = (bf16)f2bf((x1[i] * cv[i] - x2[i] * sv[i]) * z); Kt[(32 + 8 * part + i) * KP + m] = (bf16)f2bf((x1[i] * sv[i] + x2[i] * cv[i]) * z); }
#pragma unroll
                for (int q = 0; q < 4; ++q) { const unsigned w[4] = {vraw[q].x, vraw[q].y, vraw[q].z, vraw[q].w};
#pragma unroll
                    for (int i = 0; i < 4; ++i) { Vt[(32 * part + 8 * q + 2 * i) * KP + m] = (bf16)(w[i] & 0xffffu); Vt[(32 * part + 8 * q + 2 * i + 1) * KP + m] = (bf16)(w[i] >> 16); } }
            }
            LDS_WAIT(); __syncthreads();
            if (jj + 1 < NRC) R1_LOAD(dir == 0 ? jj + 1 : NRC - 2 - jj);
#pragma unroll
            for (int ks = 0; ks < 4; ++ks) {
                const bf16x8 av = *(const LAS bf16x8*)(Vt + (16 * wave + fr) * KP + 32 * ks + 8 * fq);
#pragma unroll
                for (int nb = 0; nb < 4; ++nb) { const bf16x8 bk = *(const LAS bf16x8*)(Kt + (nb * 16 + fr) * KP + 32 * ks + 8 * fq); acc[nb] = MFMA16(av, bk, acc[nb]); }
            }
            LDS_WAIT(); __syncthreads();
        }
#undef R1_LOAD
    }
}
__device__ __forceinline__ void ret_out_phase(int l, LAS unsigned char* lds, int wave, int lane_) {
    int tid = threadIdx.x; asm volatile("" : "+v"(tid)); const int lane = tid & 63;
    const CAS Params* p = KARG(); unsigned char* ws = p->ws; const int fr = lane & 15, fq = lane >> 4;
    const bf16* rawB = (const bf16*)(ws + OFF_RAWB); const float* rot = (const float*)(ws + OFF_ROT);
    LAS bf16* Qs = (LAS bf16*)lds; LAS bf16* Ks = (LAS bf16*)(lds + 128 * QP * 2); LAS bf16* Vt = (LAS bf16*)(lds + 2 * 128 * QP * 2); LAS bf16* Pw = (LAS bf16*)(lds + 2 * 128 * QP * 2 + 128 * KP * 2) + wave * 16 * KP;
    for (int it = blockIdx.x; it < BATCH * 8 * NRC; it += gridDim.x) {
        const int j = it % NRC, bh = it / NRC, b = bh >> 3, h = bh & 7;
        const float l2g = ret_log2g(h);
        const __amdgpu_buffer_rsrc_t strs = __builtin_amdgcn_make_buffer_rsrc((void*)(ws + OFF_ST), 0, 0x7fffffff, 0x00027000);
        const unsigned sfo = (unsigned)(((bh * NRC + j) * 2 + 0) * 8192 * 2);
        u32x4 sfv[4][2], sbv[4][2];
#define RET_LD_STATES(g) do { _Pragma("unroll") for (int o4 = 0; o4 < 4; ++o4) _Pragma("unroll") for (int ks = 0; ks < 2; ++ks) { \
            const unsigned eo = sfo + (unsigned)((((4 * (g) + o4) * 16 + fr) * 64 + 32 * ks + 8 * fq) * 2); \
            sfv[o4][ks] = __builtin_amdgcn_raw_buffer_load_b128(strs, eo, 0, 0x11); sbv[o4][ks] = __builtin_amdgcn_raw_buffer_load_b128(strs, eo + 16384u, 0, 0x11); } } while (0)
        RET_LD_STATES(0);
        {
            const int m = tid >> 2, part = tid & 3; const int pos = j * RC + m;
            const bf16* src = rawB + ((size_t)b * SEQ + pos) * 2048 + h * 64;
            float o1[8], o2[8];
            rot8(src, rot, pos, part, 0.125f, o1, o2);
            *(LAS u32x4*)(Qs + m * QP + 8 * part) = pack8u(o1); *(LAS u32x4*)(Qs + m * QP + 32 + 8 * part) = pack8u(o2);
            rot8(src + 512, rot, pos, part, 1.0f, o1, o2);
            *(LAS u32x4*)(Ks + m * QP + 8 * part) = pack8u(o1); *(LAS u32x4*)(Ks + m * QP + 32 + 8 * part) = pack8u(o2);
            stage_vt(rawB, b, h, j, Vt, tid);
        }
        LDS_WAIT(); __syncthreads();
        bf16x8 aq[2];
#pragma unroll
        for (int ks = 0; ks < 2; ++ks) aq[ks] = *(const LAS bf16x8*)(Qs + (16 * wave + fr) * QP + 32 * ks + 8 * fq);
#pragma unroll
        for (int nb = 0; nb < 8; ++nb) {
            f32x4 sc = {0.f, 0.f, 0.f, 0.f};
#pragma unroll
            for (int ks = 0; ks < 2; ++ks) { const bf16x8 bk = *(const LAS bf16x8*)(Ks + (nb * 16 + fr) * QP + 32 * ks + 8 * fq); sc = MFMA16(aq[ks], bk, sc); }
#pragma unroll
            for (int i = 0; i < 4; ++i) { const int n = 16 * wave + 4 * fq + i, mk = nb * 16 + fr; const int d = n > mk ? n - mk : mk - n;
                Pw[(4 * fq + i) * KP + mk] = (bf16)f2bf(sc[i] * exp2f(l2g * (float)d)); }
        }
        LDS_WAIT(); asm volatile("" ::: "memory");
        f32x4 y1[8];
        f32x4 xfv, xbv;
#pragma unroll
        for (int i = 0; i < 4; ++i) { const int nl = 16 * wave + 4 * fq + i; xfv[i] = exp2f(l2g * (float)(nl + 1)); xbv[i] = exp2f(l2g * (float)(RC - nl)); }
        bf16x8 ap[4];
#pragma unroll
        for (int ks = 0; ks < 4; ++ks) ap[ks] = *(const LAS bf16x8*)(Pw + fr * KP + 32 * ks + 8 * fq);
#pragma unroll
        for (int g = 0; g < 2; ++g) {
            if (g == 1) { RET_LD_STATES(1); }
#pragma unroll
            for (int o4 = 0; o4 < 4; ++o4) {
                const int ob = 4 * g + o4;
                f32x4 y2 = {0.f, 0.f, 0.f, 0.f}, y3 = y2; y1[ob] = y2;
#pragma unroll
                for (int ks = 0; ks < 4; ++ks) { const bf16x8 bvv = *(const LAS bf16x8*)(Vt + (ob * 16 + fr) * KP + 32 * ks + 8 * fq); y1[ob] = MFMA16(ap[ks], bvv, y1[ob]); }
#pragma unroll
                for (int ks = 0; ks < 2; ++ks) { y2 = MFMA16(aq[ks], __builtin_bit_cast(bf16x8, sfv[o4][ks]), y2); y3 = MFMA16(aq[ks], __builtin_bit_cast(bf16x8, sbv[o4][ks]), y3); }
                y1[ob] = y1[ob] + xfv * y2 + xbv * y3;
            }
            asm volatile("" ::: "memory");
        }
#pragma unroll
        for (int i = 0; i < 4; ++i) {
            const int nl = 16 * wave + 4 * fq + i;
            float v[8]; float s = 0.f;
#pragma unroll
            for (int ob = 0; ob < 8; ++ob) { v[ob] = y1[ob][i]; s += v[ob]; }
            s += __shfl_xor(s, 1); s += __shfl_xor(s, 2); s += __shfl_xor(s, 4); s += __shfl_xor(s, 8);
            const float mean = s * (1.f / 128.f); float q = 0.f;
#pragma unroll
            for (int ob = 0; ob < 8; ++ob) { v[ob] -= mean; q += v[ob] * v[ob]; }
            q += __shfl_xor(q, 1); q += __shfl_xor(q, 2); q += __shfl_xor(q, 4); q += __shfl_xor(q, 8);
            const float rstd = rsqrtf(q * (1.f / 128.f) + 1e-6f);
            bf16* yo = (bf16*)(ws + OFF_YB) + ((size_t)b * SEQ + j * RC + nl) * DM + h * 128;
            const float* gn = p->in[I_RG] + (size_t)l * DM + h * 128;
#pragma unroll
            for (int ob = 0; ob < 8; ++ob) yo[ob * 16 + fr] = (bf16)f2bf(v[ob] * rstd * gn[ob * 16 + fr]);
        }
        __syncthreads();
    }
}

#define XB_TMO      128
#define XB_XCNT(j)  (256  + 64 * (j))
#define XB_XSUB(j)  (1280 + 64 * (j))
#define XB_XGEN(j)  (2304 + 64 * (j))
#define XB_TOP      3328
#define XB_TOPGEN   3392
#define XCD_BAR_WORDS 3456
#define XB_SPIN_CAP (1u << 18)

__device__ __forceinline__ unsigned xb_ld(unsigned* p)              { return __hip_atomic_load(p, __ATOMIC_RELAXED, __HIP_MEMORY_SCOPE_AGENT); }
__device__ __forceinline__ unsigned xb_add(unsigned* p, unsigned v) { return __hip_atomic_fetch_add(p, v, __ATOMIC_RELAXED, __HIP_MEMORY_SCOPE_AGENT); }
__device__ __forceinline__ unsigned xb_xcc_id() { return (unsigned)__builtin_amdgcn_s_getreg((3 << 11) | 20) & 0xFu; }
#define XB_SPIN(cond, bar) do { unsigned _sp = 0; while (cond) { __builtin_amdgcn_s_sleep(1); \
    if ((++_sp & 255u) == 0u) { if (xb_ld(&(bar)[XB_TMO])) break; if (_sp > XB_SPIN_CAP) { atomicAdd(&(bar)[XB_TMO], 1u); break; } } } } while (0)

struct XcdBarrier {
    unsigned* bar; unsigned x;
    volatile LAS unsigned* st;
};

__device__ __forceinline__ XcdBarrier xcd_barrier_post(unsigned* bar, volatile LAS unsigned* st) {
    XcdBarrier b; b.bar = bar; b.x = xb_xcc_id(); b.st = st;
    if (threadIdx.x == 0) (void)xb_add(&bar[XB_XCNT(b.x)], 1u);
    return b;
}
__device__ __forceinline__ void xcd_barrier_complete(unsigned* bar, unsigned x, unsigned& nloc, unsigned& nx) {
    const unsigned G = gridDim.x * gridDim.y * gridDim.z;
    unsigned sum, cnt, mine, sp = 0u;
    for (;;) {
        sum = 0u; cnt = 0u; mine = 0u;
#pragma unroll
        for (unsigned j = 0; j < 16; ++j) { const unsigned c = xb_ld(&bar[XB_XCNT(j)]); sum += c; cnt += (c > 0u) ? 1u : 0u; mine = (j == x) ? c : mine; }
        if (sum == G) break;
        __builtin_amdgcn_s_sleep(1);
        if ((++sp & 255u) == 0u) { if (xb_ld(&bar[XB_TMO])) break; if (sp > XB_SPIN_CAP) { atomicAdd(&bar[XB_TMO], 1u); break; } }
    }
    nloc = mine > 0u ? mine : 1u; nx = cnt > 0u ? cnt : 1u;
}

__device__ __forceinline__ void xcd_barrier(const XcdBarrier& b) {
    asm volatile("s_waitcnt vmcnt(0)" ::: "memory");
    __syncthreads();
    if (threadIdx.x == 0) {
        unsigned* bar = b.bar;
        __builtin_amdgcn_s_waitcnt(0);
        unsigned nloc = b.st[0], nx = b.st[1];
        if (nloc == 0u) { xcd_barrier_complete(bar, b.x, nloc, nx); b.st[0] = nloc; b.st[1] = nx; }
        const unsigned old = xb_add(&bar[XB_XSUB(b.x)], 1u);
        const unsigned gen = old / nloc;
        if (old + 1u == (gen + 1u) * nloc) {
            __builtin_amdgcn_fence(__ATOMIC_RELEASE, "agent");
            asm volatile("s_waitcnt vmcnt(0)" ::: "memory");
            const unsigned og = xb_add(&bar[XB_TOP], 1u);
            const unsigned tg = og / nx;
            if (og + 1u == (tg + 1u) * nx) xb_add(&bar[XB_TOPGEN], 1u);
            else XB_SPIN(xb_ld(&bar[XB_TOPGEN]) == tg, bar);
            __builtin_amdgcn_fence(__ATOMIC_ACQUIRE, "agent");
            xb_add(&bar[XB_XGEN(b.x)], 1u);
            asm volatile("s_waitcnt vmcnt(0)" ::: "memory");
        } else {
            XB_SPIN(xb_ld(&bar[XB_XGEN(b.x)]) == gen, bar);
            __builtin_amdgcn_fence(__ATOMIC_ACQUIRE, "agent");
            asm volatile("s_waitcnt vmcnt(0)" ::: "memory");
        }
    }
    __syncthreads();
}

#ifndef PHMASK
#define PHMASK 0xFFFF
#endif
#define PH(n) if constexpr ((PHMASK >> (n)) & 1)
#define GSYNC_CG() do { asm volatile("s_waitcnt vmcnt(0) lgkmcnt(0)" ::: "memory"); __syncthreads(); grid.sync(); __builtin_amdgcn_fence(__ATOMIC_ACQUIRE, "agent"); asm volatile("s_waitcnt vmcnt(0)" ::: "memory"); } while (0)
#define GSYNC() xcd_barrier(xbar)
__global__ void __launch_bounds__(512, 2) hybrid_fwd(Params p_unused) {
    extern __shared__ __attribute__((aligned(16))) unsigned char lds_raw[];
    LAS unsigned char* lds = (LAS unsigned char*)lds_raw;
    cg::grid_group grid = cg::this_grid();
    const int tid = threadIdx.x, lane = tid & 63, wave = __builtin_amdgcn_readfirstlane(tid >> 6);
    const int gw = blockIdx.x * 8 + wave, NGW = gridDim.x * 8;
    { volatile LAS unsigned* stw = (volatile LAS unsigned*)(lds + XB_LDS_OFF); if (threadIdx.x < 2) stw[threadIdx.x] = 0u; }
    __syncthreads();
    XcdBarrier xbar = xcd_barrier_post((unsigned*)KARG()->ws, (volatile LAS unsigned*)(lds + XB_LDS_OFF));
    GSYNC_CG();
    {
        float* rot = (float*)(KARG()->ws + OFF_ROT);
        for (int i = gw * 64 + lane; i < 2048 * 32; i += NGW * 64) { const int pos = i >> 5, jf = i & 31;
            const float fr_ = exp2f(-(float)jf * (13.287712379549449f / 32.0f)); float rev = (float)pos * fr_ * 0.15915494309189535f; rev -= rintf(rev);
            rot[i] = __builtin_amdgcn_cosf(rev); rot[2048 * 32 + i] = __builtin_amdgcn_sinf(rev); }
    }
#pragma unroll 1
    for (int l = 0; l < DEPTH; ++l) {
#define XIN (l == 0 ? KARG()->in[I_X] : (const float*)KARG()->out)
#define WSP(off) (KARG()->ws + (off))
        PH(0) convert_weights(l, lds, gw, NGW, wave, lane);
        PH(1) norm_phase(XIN, KARG()->in[I_NG] + (size_t)l * DM, (bf16*)WSP(OFF_XB), gw, NGW, lane);
        GSYNC();
        PH(2) run_gemm(lds, (const bf16*)WSP(OFF_XB), (const bf16*)WSP(OFF_WA), NA, FStoreA{(bf16*)WSP(OFF_RAWA)});
        GSYNC();
        PH(3) scan_phase(l, lds, wave, lane);
        GSYNC();
        PH(4) postscan_phase(l, gw, NGW, lane);
        PH(5) run_gemm(lds, (const bf16*)WSP(OFF_XB), (const bf16*)WSP(OFF_WB), 2048, FStoreB{(bf16*)WSP(OFF_RAWB)});
        GSYNC();
        PH(6) ret_states_phase(lds, wave, lane);
        GSYNC();
        PH(7) ret_out_phase(l, lds, wave, lane);
        GSYNC();
        PH(8) run_gemm(lds, (const bf16*)WSP(OFF_XB), (const bf16*)WSP(OFF_WG), 4096, FGates{(bf16*)WSP(OFF_YS), (bf16*)WSP(OFF_YB), (bf16*)WSP(OFF_SIGA), (bf16*)WSP(OFF_SIGB)});
        GSYNC();
        PH(9) run_gemm(lds, (const bf16*)WSP(OFF_YS), (const bf16*)WSP(OFF_Wa), DM, FGa{(const bf16*)WSP(OFF_SIGA), (bf16*)WSP(OFF_M1)});
        GSYNC();
        PH(10) run_gemm(lds, (const bf16*)WSP(OFF_YB), (const bf16*)WSP(OFF_Wb), DM, FGb{(const bf16*)WSP(OFF_SIGB), (const bf16*)WSP(OFF_M1), (bf16*)WSP(OFF_MG)});
        GSYNC();
        PH(11) run_gemm(lds, (const bf16*)WSP(OFF_MG), (const bf16*)WSP(OFF_Wo), DM, FGo{XIN, KARG()->out});
        GSYNC();
    }
    final_norm(KARG()->out, KARG()->in[I_FG], gw, NGW, lane);
}

extern "C" void kernel_launch(void* const* d_in, const int* in_sizes, int n_in, void* d_out, int out_size, void* d_ws, size_t ws_size, hipStream_t stream) {
    static int grid = 0;
    if (grid == 0) {
        if (n_in != 22 || ws_size < WS_END) { fprintf(stderr, "kernel_launch: unexpected n_in %d / ws_size %zu (need %zu)\n", n_in, ws_size, (size_t)WS_END); grid = -1; return; }
        int dev = 0, cus = 0, per_cu = 0;
        (void)hipGetDevice(&dev); (void)hipDeviceGetAttribute(&cus, hipDeviceAttributeMultiprocessorCount, dev);
        (void)hipFuncSetAttribute((const void*)hybrid_fwd, hipFuncAttributeMaxDynamicSharedMemorySize, LDS_BYTES);
        (void)hipOccupancyMaxActiveBlocksPerMultiprocessor(&per_cu, (const void*)hybrid_fwd, 512, LDS_BYTES);
        if (per_cu < 1) per_cu = 1;
        grid = cus * per_cu;
        (void)hipGetLastError();
    }
    if (grid < 0) return;
    Params p{};
    for (int i = 0; i < 22; ++i) p.in[i] = (const float*)d_in[i];
    p.out = (float*)d_out; p.ws = (unsigned char*)d_ws;
    if (hipMemsetAsync(d_ws, 0, 16384, stream) != hipSuccess) { fprintf(stderr, "kernel_launch: hipMemsetAsync of the barrier words failed\n"); return; }
    void* args[] = {&p};
    hipError_t e = hipLaunchCooperativeKernel((const void*)hybrid_fwd, dim3(grid), dim3(512), args, LDS_BYTES, stream);
    if (e != hipSuccess) fprintf(stderr, "cooperative launch failed: %s (grid %d)\n", hipGetErrorString(e), grid);
}
```

```cpp
#include <hip/hip_runtime.h>
#include <hip/hip_cooperative_groups.h>
#include <cstdio>
#include <cstdint>
namespace cg = cooperative_groups;
namespace pg8 {
#define PG8_LAS __attribute__((address_space(3)))
typedef unsigned short bf16_t;
typedef short bf16x8 __attribute__((ext_vector_type(8)));
typedef float f32x4 __attribute__((ext_vector_type(4)));
typedef unsigned u32x4 __attribute__((ext_vector_type(4)));
constexpr int BM = 256, BK = 64, HALF = 128, HTB = HALF * BK * 2  , STAGE_BYTES = 8 * HTB, NXCD = 8, WGM = 8;

__host__ __device__ __forceinline__ int lds_byte(int r, int c) { const int st = (r >> 4) * 2 + (c >> 5), rr = r & 15, cc = c & 31, ob = rr * 64 + cc * 2; return st * 1024 + (ob ^ (((ob >> 9) & 1) << 5)); }
__host__ __device__ __forceinline__ void stage_rc(int b, int& R, int& C) { const int st = b / 1024, sb = b % 1024, swz = sb ^ (((sb >> 9) & 1) << 5); R = (st >> 1) * 16 + swz / 64; C = (st & 1) * 32 + (swz % 64) / 2; }
__host__ __device__ __forceinline__ int perm32(int rho) { const int n = rho >> 4, i = rho & 15; return 8 * (i >> 2) + 4 * n + (i & 3); }

struct Unit { int pm, pn; };
struct Gemm { const bf16_t* A; const bf16_t* Bt; int M, N, K; };

struct StaticOrder {
    int nM, nN, nwg, G, c;
    __host__ __device__ void init(int M, int N, int G_, int c_) { nM = M / BM; nN = N / BM; nwg = nM * nN; G = G_; c = c_; }
    __host__ __device__ bool next(int i, Unit& u) const {
        const long L = (long)i * G + c; if (L >= nwg) return false;
        int wgid = (int)L; { const int q = nwg / NXCD, r = nwg % NXCD, xcd = wgid % NXCD, off = wgid / NXCD; wgid = (xcd < r ? xcd * (q + 1) : r * (q + 1) + (xcd - r) * q) + off; }
        const int nig = WGM * nN, gid = wgid / nig, fm = gid * WGM, gsz = (nM - fm) < WGM ? (nM - fm) : WGM;
        u.pm = fm + ((wgid % nig) % gsz); u.pn = (wgid % nig) / gsz; return true;
    }
    __device__ __forceinline__ void a_ready(const Unit&) const {}
    __device__ __forceinline__ void done(const Unit&) const {}
};
__device__ __forceinline__ unsigned cvt_pk_bf16(float lo, float hi) { unsigned r; asm volatile("v_cvt_pk_bf16_f32 %0, %1, %2" : "=v"(r) : "v"(lo), "v"(hi)); return r; }
typedef float f32x2 __attribute__((ext_vector_type(2)));
template <class Epi, class Sched, bool ALIGN_EPI = false, bool SP2 = false>
__device__ __forceinline__ void gemm_phase(PG8_LAS unsigned char* lds, const Gemm g, const Sched& S, const Epi& E) {
    int tid_ = threadIdx.x; asm volatile("" : "+v"(tid_));
    const int tid = tid_, wid = __builtin_amdgcn_readfirstlane(tid >> 6), lane = tid & 63, wr = wid >> 2, wc = wid & 3, fr = lane & 15, fq = lane >> 4;
    const int K = g.K, nt = K / BK;
    unsigned voffA[2], voffB[2];
#pragma unroll
    for (int i = 0; i < 2; ++i) { int R, C; stage_rc(tid * 16 + i * 8192, R, C); const int Rb = Epi::PERM ? ((R & ~31) + perm32(R & 31)) : R;
        voffA[i] = (unsigned)(R * K + C) * 2u; voffB[i] = (unsigned)(Rb * K + C) * 2u; }
    const size_t kstep = (size_t)(BK * 2);
    const size_t hstep = (size_t)HALF * K * 2;
    const size_t tstep = 2 * hstep;
    const unsigned ldsw = (unsigned)wid * 1024u;
    const int aoff = lds_byte(wr * 64 + fr, fq * 8), boff = lds_byte(wc * 32 + fr, fq * 8);
#define PG8_SA(b, h) (((b) * 2 + (h)) * HTB)
#define PG8_SB(b, h) ((4 + (b) * 2 + (h)) * HTB)
#define PG8_STAGE(bufoff, gbase, voff) do { _Pragma("unroll") for (int _i = 0; _i < 2; ++_i) \
        __builtin_amdgcn_global_load_lds((const unsigned*)((const char*)(gbase) + (voff)[_i]), (PG8_LAS unsigned*)(lds + (bufoff) + ldsw + _i * 8192), 16, 0, 0); } while (0)
#define PG8_LDA(dst, b, h) do { _Pragma("unroll") for (int m = 0; m < 4; ++m) _Pragma("unroll") for (int k = 0; k < 2; ++k) dst[m][k] = *(const PG8_LAS bf16x8*)(lds + PG8_SA(b, h) + aoff + m * 2048 + k * 1024); } while (0)
#define PG8_LDB(dst, b, h) do { _Pragma("unroll") for (int n = 0; n < 2; ++n) _Pragma("unroll") for (int k = 0; k < 2; ++k) dst[n][k] = *(const PG8_LAS bf16x8*)(lds + PG8_SB(b, h) + boff + n * 2048 + k * 1024); } while (0)
#define PG8_MMA(ai, bj, At, Bt) do { __builtin_amdgcn_s_setprio(1); _Pragma("unroll") for (int m = 0; m < 4; ++m) _Pragma("unroll") for (int n = 0; n < 2; ++n) _Pragma("unroll") for (int k = 0; k < 2; ++k) \
        acc[ai][bj][m][n] = __builtin_amdgcn_mfma_f32_16x16x32_bf16(Bt[n][k], At[m][k], acc[ai][bj][m][n], 0, 0, 0); __builtin_amdgcn_s_setprio(0); } while (0)
#define PG8_WAIT_V(n) asm volatile("s_waitcnt vmcnt(" #n ")" ::: "memory")
#define PG8_WAIT_L(n) asm volatile("s_waitcnt lgkmcnt(" #n ")" ::: "memory")
#define PG8_BAR __builtin_amdgcn_s_barrier()
#define PG8_SCHED __builtin_amdgcn_sched_barrier(0)
    Unit cur, nxt; int ui = 0;
    if (!S.next(0, cur)) return;
    f32x4 acc[2][2][4][2];
#pragma unroll
    for (int a = 0; a < 2; ++a)
#pragma unroll
        for (int b = 0; b < 2; ++b)
#pragma unroll
            for (int m = 0; m < 4; ++m)
#pragma unroll
                for (int n = 0; n < 2; ++n) acc[a][b][m][n] = (f32x4){0.f, 0.f, 0.f, 0.f};
    bf16x8 At[4][2], B0[2][2], B1[2][2];
    const char* cA = (const char*)g.A + (size_t)cur.pm * tstep; const char* cB = (const char*)g.Bt + (size_t)cur.pn * tstep;
    S.a_ready(cur);
    if constexpr (SP2) {
        PG8_STAGE(PG8_SB(0, 0), cB, voffB); PG8_STAGE(PG8_SB(0, 1), cB + hstep, voffB); PG8_STAGE(PG8_SA(0, 0), cA, voffA); PG8_STAGE(PG8_SA(0, 1), cA + hstep, voffA);
        if (wr == 1) PG8_BAR;
        PG8_WAIT_V(2); PG8_BAR;
        PG8_STAGE(PG8_SB(1, 0), cB + kstep, voffB); PG8_STAGE(PG8_SA(1, 0), cA + kstep, voffA); PG8_STAGE(PG8_SB(1, 1), cB + hstep + kstep, voffB);
        PG8_WAIT_V(6); PG8_BAR;
    } else {
        PG8_STAGE(PG8_SB(0, 0), cB, voffB); PG8_STAGE(PG8_SA(0, 0), cA, voffA); PG8_STAGE(PG8_SB(0, 1), cB + hstep, voffB); PG8_STAGE(PG8_SA(0, 1), cA + hstep, voffA);
        if (wr == 1) PG8_BAR;
        PG8_WAIT_V(4); PG8_BAR;
        PG8_STAGE(PG8_SB(1, 0), cB + kstep, voffB); PG8_STAGE(PG8_SA(1, 0), cA + kstep, voffA); PG8_STAGE(PG8_SB(1, 1), cB + hstep + kstep, voffB);
        PG8_WAIT_V(6); PG8_BAR;
    }
    for (;;) {
        const bool has_next = S.next(ui + 1, nxt);
        const char* nA = has_next ? (const char*)g.A + (size_t)nxt.pm * tstep : cA; const char* nB = has_next ? (const char*)g.Bt + (size_t)nxt.pn * tstep : cB;
        for (int t = 0; t < nt; t += 2) {
            const bool last = (t == nt - 2);
            const char* a1 = cA + (size_t)(t + 1) * kstep;
            const char* a2 = last ? nA : cA + (size_t)(t + 2) * kstep; const char* b2 = last ? nB : cB + (size_t)(t + 2) * kstep;
            const char* a3 = a2 + kstep; const char* b3 = b2 + kstep;
            if (last && has_next) S.a_ready(nxt);
            if constexpr (SP2) {
            PG8_LDB(B0, 0, 0); PG8_LDB(B1, 0, 1); PG8_SCHED; PG8_LDA(At, 0, 0); PG8_STAGE(PG8_SA(1, 1), a1 + hstep, voffA);
            PG8_WAIT_V(8); PG8_WAIT_L(0); PG8_BAR; PG8_MMA(0, 0, At, B0); PG8_MMA(0, 1, At, B1); PG8_BAR; PG8_SCHED;
            PG8_LDA(At, 0, 1); PG8_STAGE(PG8_SB(0, 0), b2, voffB); PG8_STAGE(PG8_SB(0, 1), b2 + hstep, voffB); PG8_STAGE(PG8_SA(0, 0), a2, voffA);
            PG8_WAIT_V(8); PG8_WAIT_L(0); PG8_BAR; PG8_MMA(1, 0, At, B0); PG8_MMA(1, 1, At, B1); PG8_BAR; PG8_SCHED;
            PG8_LDB(B0, 1, 0); PG8_LDB(B1, 1, 1); PG8_SCHED; PG8_LDA(At, 1, 0); PG8_STAGE(PG8_SA(0, 1), a2 + hstep, voffA);
            PG8_WAIT_V(8); PG8_WAIT_L(0); PG8_BAR; PG8_MMA(0, 0, At, B0); PG8_MMA(0, 1, At, B1); PG8_BAR; PG8_SCHED;
            PG8_LDA(At, 1, 1); PG8_STAGE(PG8_SB(1, 0), b3, voffB); PG8_STAGE(PG8_SB(1, 1), b3 + hstep, voffB); PG8_STAGE(PG8_SA(1, 0), a3, voffA);
            PG8_WAIT_V(8); PG8_WAIT_L(0); PG8_BAR; PG8_MMA(1, 0, At, B0); PG8_MMA(1, 1, At, B1); PG8_BAR; PG8_SCHED;
            } else {
            PG8_LDB(B0, 0, 0); PG8_SCHED; PG8_LDA(At, 0, 0); PG8_STAGE(PG8_SA(1, 1), a1 + hstep, voffA);
            PG8_WAIT_L(8); PG8_BAR; PG8_WAIT_L(0); PG8_MMA(0, 0, At, B0); PG8_BAR; PG8_SCHED;
            PG8_LDB(B1, 0, 1); PG8_STAGE(PG8_SB(0, 0), b2, voffB);
            PG8_BAR; PG8_WAIT_L(0); PG8_MMA(0, 1, At, B1); PG8_BAR;
            PG8_LDA(At, 0, 1); PG8_STAGE(PG8_SA(0, 0), a2, voffA);
            PG8_BAR; PG8_WAIT_L(0); PG8_MMA(1, 0, At, B0); PG8_BAR; PG8_SCHED;
            PG8_STAGE(PG8_SB(0, 1), b2 + hstep, voffB);
            PG8_WAIT_V(6); PG8_BAR; PG8_MMA(1, 1, At, B1); PG8_BAR;
            PG8_LDB(B0, 1, 0); PG8_SCHED; PG8_LDA(At, 1, 0); PG8_STAGE(PG8_SA(0, 1), a2 + hstep, voffA);
            PG8_WAIT_L(8); PG8_BAR; PG8_WAIT_L(0); PG8_MMA(0, 0, At, B0); PG8_BAR; PG8_SCHED;
            PG8_LDB(B1, 1, 1); PG8_STAGE(PG8_SB(1, 0), b3, voffB);
            PG8_BAR; PG8_WAIT_L(0); PG8_MMA(0, 1, At, B1); PG8_BAR;
            PG8_LDA(At, 1, 1); PG8_STAGE(PG8_SA(1, 0), a3, voffA);
            PG8_BAR; PG8_WAIT_L(0); PG8_MMA(1, 0, At, B0); PG8_BAR; PG8_SCHED;
            PG8_STAGE(PG8_SB(1, 1), b3 + hstep, voffB);
            PG8_WAIT_V(6); PG8_BAR; PG8_MMA(1, 1, At, B1); PG8_BAR;
            }
        }
        if constexpr (ALIGN_EPI) { if (wr == 0) PG8_BAR; }
        if constexpr (!Epi::AFTER_DRAIN) { E(acc, cur, wr, wc, fr, fq); S.done(cur); }
        if (!has_next) break;
#pragma unroll
        for (int a = 0; a < 2; ++a)
#pragma unroll
            for (int b = 0; b < 2; ++b)
#pragma unroll
                for (int m = 0; m < 4; ++m)
#pragma unroll
                    for (int n = 0; n < 2; ++n) acc[a][b][m][n] = (f32x4){0.f, 0.f, 0.f, 0.f};
        cur = nxt; cA = nA; cB = nB; ++ui;
        if constexpr (ALIGN_EPI) { if (wr == 1) PG8_BAR; }
    }
    PG8_WAIT_V(0);
    if constexpr (!ALIGN_EPI) { if (wr == 0) PG8_BAR; }
    PG8_BAR;
    if constexpr (Epi::AFTER_DRAIN) { E.fused(acc, cur, wr, wc, fr, fq, lds, wid, lane); S.done(cur); }
#undef PG8_SA
#undef PG8_SB
#undef PG8_STAGE
#undef PG8_LDA
#undef PG8_LDB
#undef PG8_MMA
#undef PG8_WAIT_V
#undef PG8_WAIT_L
#undef PG8_BAR
#undef PG8_SCHED
}
}
#define PG8_SP2 true
#define PG8_ALIGN true
#define GAS __attribute__((address_space(1)))
#define LAS __attribute__((address_space(3)))
#define CAS __attribute__((address_space(4)))
typedef unsigned short bf16;
typedef unsigned u32x4 __attribute__((ext_vector_type(4)));
typedef unsigned u32x2 __attribute__((ext_vector_type(2)));
typedef float f32x4 __attribute__((ext_vector_type(4)));
typedef float f32x2 __attribute__((ext_vector_type(2)));
typedef short bf16x8 __attribute__((ext_vector_type(8)));
#define LDS_WAIT() asm volatile("s_waitcnt lgkmcnt(0)" ::: "memory")
#define VM_WAIT() asm volatile("s_waitcnt vmcnt(0)" ::: "memory")

constexpr int BATCH = 16, SEQ = 2048, DM = 1024, DEPTH = 4, T = BATCH * SEQ;
constexpr int NIN = 9472;
constexpr int NA = 3584, LDA = 3360;
constexpr int CHS = 16, NCH = SEQ / CHS;
constexpr int RSTEP = 260;
constexpr int RC = 128, NRC = SEQ / RC;
constexpr size_t MiB = 1u << 20;
constexpr size_t OFF_WA = 2 * MiB, OFF_WB = 9 * MiB, OFF_WG = 13 * MiB, OFF_Wa = 21 * MiB, OFF_Wb = 23 * MiB, OFF_Wo = 25 * MiB;
constexpr size_t OFF_WDEC = 27 * MiB, OFF_WIC = OFF_WDEC + 256 * 1024, OFF_WVR = OFF_WIC + 256 * 1024, OFF_ROT = OFF_WVR + 64 * 1024;
constexpr size_t OFF_VFIRST = 29 * MiB, OFF_VFIN = 93 * MiB, OFF_YS = 157 * MiB, OFF_COEF = 221 * MiB, OFF_XB = 225 * MiB, OFF_RAWA = 289 * MiB;
constexpr size_t OFF_YB = OFF_VFIN;
constexpr size_t OFF_RAWB = OFF_RAWA, OFF_ST = OFF_RAWA + 128 * MiB;
constexpr size_t OFF_SIGA = OFF_RAWA, OFF_SIGB = OFF_RAWA + 64 * MiB, OFF_M1 = OFF_ST, OFF_MG = OFF_XB;
constexpr size_t OFF_COEF2 = 499 * MiB;
constexpr size_t WS_END = 503 * MiB;
static_assert(OFF_ROT + 2 * 2048 * 32 * 4 <= OFF_VFIRST, "small region");
static_assert(32768 + 2 * 2 * CHS * RSTEP * 4 <= 133120, "scan LDS map");
static_assert(OFF_RAWA + (size_t)T * LDA * 2 <= WS_END, "rawA");
constexpr int XB_LDS_OFF = 133120 + 16384 + 6144;
constexpr int LDS_BYTES = XB_LDS_OFF + 64;

enum { I_X = 0, I_NG, I_WIN, I_WVD, I_SP, I_SN, I_WDU, I_DB, I_WIU, I_IB, I_WVU, I_VB, I_KK, I_KA, I_RK, I_LG, I_LB, I_WBA, I_RG, I_WBB, I_WO, I_FG };
struct Params { const float* in[22]; float* out; unsigned char* ws; };
#define KARG() ({ const CAS Params* kp_ = (const CAS Params*)__builtin_amdgcn_kernarg_segment_ptr(); asm volatile("" : "+s"(kp_)); kp_; })

typedef __bf16 bf16x2_t __attribute__((ext_vector_type(2)));
__device__ __forceinline__ unsigned cvtpk(float lo, float hi) { const f32x2 v = {lo, hi}; const bf16x2_t b = __builtin_convertvector(v, bf16x2_t); return __builtin_bit_cast(unsigned, b); }
__device__ __forceinline__ unsigned pk2(float lo, float hi) { return cvtpk(lo, hi); }
__device__ __forceinline__ unsigned f2bf(float f) { return cvtpk(f, 0.f) & 0xffffu; }
__device__ __forceinline__ float bflo(unsigned u) { return __builtin_bit_cast(float, u << 16); }
__device__ __forceinline__ float bfhi(unsigned u) { return __builtin_bit_cast(float, u & 0xffff0000u); }
__device__ __forceinline__ float bf1(bf16 h) { return __builtin_bit_cast(float, (unsigned)h << 16); }
__device__ __forceinline__ void unpack8(u32x4 u, float* o) { o[0] = bflo(u.x); o[1] = bfhi(u.x); o[2] = bflo(u.y); o[3] = bfhi(u.y); o[4] = bflo(u.z); o[5] = bfhi(u.z); o[6] = bflo(u.w); o[7] = bfhi(u.w); }
__device__ __forceinline__ void unpack4(u32x2 u, float* o) { o[0] = bflo(u.x); o[1] = bfhi(u.x); o[2] = bflo(u.y); o[3] = bfhi(u.y); }
__device__ __forceinline__ u32x4 pack8u(const float* f) { u32x4 u; u.x = pk2(f[0], f[1]); u.y = pk2(f[2], f[3]); u.z = pk2(f[4], f[5]); u.w = pk2(f[6], f[7]); return u; }
__device__ __forceinline__ bf16x8 pack8(const float* f) { return __builtin_bit_cast(bf16x8, pack8u(f)); }
__device__ __forceinline__ float sigm(float x) { return __builtin_amdgcn_rcpf(1.0f + __expf(-x)); }
__device__ __forceinline__ float wave_sum(float v) {
#pragma unroll
    for (int o = 1; o < 64; o <<= 1) v += __shfl_xor(v, o);
    return v;
}
#define MFMA16(a, b, c) __builtin_amdgcn_mfma_f32_16x16x32_bf16((a), (b), (c), 0, 0, 0)

__device__ __forceinline__ void tr_item(const float* W, int ldw, int K, bf16* WT, int item, int nblk, LAS float* scr, int lane) {
    const int kb = item / nblk, nb = item % nblk, k0 = 64 * kb, n0 = 32 * nb;
    float wv[32];
#pragma unroll
    for (int i = 0; i < 32; ++i) wv[i] = W[(size_t)(k0 + 2 * i + (lane >> 5)) * ldw + n0 + (lane & 31)];
#pragma unroll
    for (int i = 0; i < 32; ++i) scr[(2 * i + (lane >> 5)) * 33 + (lane & 31)] = wv[i];
    LDS_WAIT(); asm volatile("" ::: "memory");
    const int c = lane & 7;
#pragma unroll
    for (int j = 0; j < 4; ++j) { const int n = (lane >> 3) + 8 * j; const LAS float* s = scr + (8 * c) * 33 + n;
        u32x4 o; o.x = pk2(s[0 * 33], s[1 * 33]); o.y = pk2(s[2 * 33], s[3 * 33]); o.z = pk2(s[4 * 33], s[5 * 33]); o.w = pk2(s[6 * 33], s[7 * 33]);
        *(u32x4*)(WT + (size_t)(n0 + n) * K + k0 + 8 * c) = o; }
    LDS_WAIT(); asm volatile("" ::: "memory");
}

__device__ __forceinline__ void convert_weights(int l, LAS unsigned char* lds, int gw, int NGW, int wave, int lane) {
    asm volatile("" : "+s"(NGW), "+s"(gw));
    asm volatile("" : "+v"(lane));
    const CAS Params* p = KARG(); unsigned char* ws = p->ws;
    LAS float* scr = (LAS float*)(lds + wave * 16384);
    const float* win = p->in[I_WIN] + (size_t)l * DM * NIN;
    bf16* WA = (bf16*)(ws + OFF_WA); bf16* WB = (bf16*)(ws + OFF_WB); bf16* WG = (bf16*)(ws + OFF_WG);
    constexpr int S1 = 16 * 104, S2 = 16 * 64, S3 = 16 * 32, S4 = 16 * 96, S5 = 512, S8 = 16, S10 = 32;
    constexpr int NIT = S1 + S2 + S3 + S4 + 3 * S5 + S8 + 4 * S10;
    for (int it = gw; it < NIT; it += NGW) {
        int r = it;
        if (r < S1) { tr_item(win, NIN, DM, WA, r, 104, scr, lane); continue; } r -= S1;
        if (r < S2) { tr_item(win + 4352, NIN, DM, WB, r, 64, scr, lane); continue; } r -= S2;
        if (r < S3) { tr_item(win + 3328, NIN, DM, WG, r, 32, scr, lane); continue; } r -= S3;
        if (r < S4) { tr_item(win + 6400, NIN, DM, WG + (size_t)1024 * DM, r, 96, scr, lane); continue; } r -= S4;
        if (r < S5) { tr_item(p->in[I_WBA] + (size_t)l * DM * DM, DM, DM, (bf16*)(ws + OFF_Wa), r, 32, scr, lane); continue; } r -= S5;
        if (r < S5) { tr_item(p->in[I_WBB] + (size_t)l * DM * DM, DM, DM, (bf16*)(ws + OFF_Wb), r, 32, scr, lane); continue; } r -= S5;
        if (r < S5) { tr_item(p->in[I_WO] + (size_t)l * DM * DM, DM, DM, (bf16*)(ws + OFF_Wo), r, 32, scr, lane); continue; } r -= S5;
        if (r < S8) { if (l > 0) tr_item(p->in[I_WVD] + (size_t)(l - 1) * DM * 32, 32, DM, WA + (size_t)3328 * DM, r, 1, scr, lane); continue; } r -= S8;
        { const int which = r / S10, rr = r % S10;
          const float* src = (which < 2 ? p->in[I_WDU] : p->in[I_WIU]) + ((size_t)l * 2 + (which & 1)) * 64 * DM;
          bf16* dst = (bf16*)(ws + (which < 2 ? OFF_WDEC : OFF_WIC)) + (size_t)(which & 1) * DM * 64;
          tr_item(src, DM, 64, dst, rr, 32, scr, lane); }
    }
    const int gt = gw * 64 + lane, NGT = NGW * 64;
    if (l == 0) {
        u32x4* z = (u32x4*)(WA + (size_t)3328 * DM); const u32x4 zero = {0u, 0u, 0u, 0u};
        for (int i = gt; i < 256 * DM * 2 / 16; i += NGT) z[i] = zero;
    } else {
        const float* src = p->in[I_WVU] + (size_t)(l - 1) * 32 * DM; bf16* dst = (bf16*)(ws + OFF_WVR);
        for (int i = gt; i < 32 * DM; i += NGT) { const int n = i >> 5, k = i & 31; dst[i] = (bf16)f2bf(src[(size_t)k * DM + n]); }
    }
}

__device__ __forceinline__ void norm_phase(const float* x, const float* gain, bf16* xb, int gw, int NGW, int lane) {
    asm volatile("" : "+s"(NGW), "+s"(gw));
    asm volatile("" : "+v"(lane));
    for (int m0 = gw; m0 < T; m0 += 4 * NGW) {
        f32x4 v[4][4]; float ss[4];
#pragma unroll
        for (int r = 0; r < 4; ++r) { const int m = m0 + r * NGW < T ? m0 + r * NGW : m0; const f32x4* xr = (const f32x4*)(x + (size_t)m * DM) + lane;
#pragma unroll
            for (int j = 0; j < 4; ++j) v[r][j] = xr[64 * j]; }
#pragma unroll
        for (int r = 0; r < 4; ++r) { float q = 0.f;
#pragma unroll
            for (int j = 0; j < 4; ++j) q += (v[r][j].x * v[r][j].x + v[r][j].y * v[r][j].y) + (v[r][j].z * v[r][j].z + v[r][j].w * v[r][j].w);
            ss[r] = q; }
#pragma unroll
        for (int o = 1; o < 64; o <<= 1) {
#pragma unroll
            for (int r = 0; r < 4; ++r) ss[r] += __shfl_xor(ss[r], o); }
#pragma unroll
        for (int r = 0; r < 4; ++r) { const int m = m0 + r * NGW; if (m < T) {
            const float rs = rsqrtf(ss[r] * (1.f / DM) + 1e-6f);
            u32x2* o8 = (u32x2*)(xb + (size_t)m * DM) + lane;
#pragma unroll
            for (int j = 0; j < 4; ++j) { const f32x4 g = ((const f32x4*)gain)[lane + 64 * j]; u32x2 o; o.x = pk2(v[r][j].x * rs * g.x, v[r][j].y * rs * g.y); o.y = pk2(v[r][j].z * rs * g.z, v[r][j].w * rs * g.w); o8[64 * j] = o; } } }
    }
}
__device__ __forceinline__ void final_norm(float* x, const float* gain, int gw, int NGW, int lane) {
    asm volatile("" : "+s"(NGW), "+s"(gw));
    asm volatile("" : "+v"(lane));
    for (int m0 = gw; m0 < T; m0 += 4 * NGW) {
        f32x4 v[4][4]; float ss[4];
#pragma unroll
        for (int r = 0; r < 4; ++r) { const int m = m0 + r * NGW < T ? m0 + r * NGW : m0; const f32x4* xr = (const f32x4*)(x + (size_t)m * DM) + lane;
#pragma unroll
            for (int j = 0; j < 4; ++j) v[r][j] = xr[64 * j]; }
#pragma unroll
        for (int r = 0; r < 4; ++r) { float q = 0.f;
#pragma unroll
            for (int j = 0; j < 4; ++j) q += (v[r][j].x * v[r][j].x + v[r][j].y * v[r][j].y) + (v[r][j].z * v[r][j].z + v[r][j].w * v[r][j].w);
            ss[r] = q; }
#pragma unroll
        for (int o = 1; o < 64; o <<= 1) {
#pragma unroll
            for (int r = 0; r < 4; ++r) ss[r] += __shfl_xor(ss[r], o); }
#pragma unroll
        for (int r = 0; r < 4; ++r) { const int m = m0 + r * NGW; if (m < T) {
            const float rs = rsqrtf(ss[r] * (1.f / DM) + 1e-6f);
            f32x4* xr = (f32x4*)(x + (size_t)m * DM) + lane;
#pragma unroll
            for (int j = 0; j < 4; ++j) { const f32x4 g = ((const f32x4*)gain)[lane + 64 * j]; xr[64 * j] = v[r][j] * rs * g; } } }
    }
}

template <class F> struct EpiGen {
    static constexpr bool PERM = true, AFTER_DRAIN = false;
    F f;
    __device__ __forceinline__ void operator()(const pg8::f32x4 (&acc)[2][2][4][2], const pg8::Unit& u, int wr, int wc, int fr, int fq) const {
        const int row0 = u.pm * 256 + wr * 64 + fr, col0 = u.pn * 256 + wc * 32 + 8 * fq;
#pragma unroll
        for (int ai = 0; ai < 2; ++ai)
#pragma unroll
            for (int m = 0; m < 4; ++m)
#pragma unroll
                for (int bj = 0; bj < 2; ++bj) {
                    float v[8];
#pragma unroll
                    for (int i = 0; i < 4; ++i) { v[i] = acc[ai][bj][m][0][i]; v[4 + i] = acc[ai][bj][m][1][i]; }
                    f(row0 + ai * 128 + m * 16, col0 + bj * 128, v);
                }
    }
};
struct FStoreA { bf16* O; __device__ __forceinline__ void operator()(int row, int col, const float* v) const { if (col < LDA) *(u32x4*)(O + (size_t)row * LDA + col) = pack8u(v); } };
struct FStoreB { bf16* O; __device__ __forceinline__ void operator()(int row, int col, const float* v) const { *(u32x4*)(O + (size_t)row * 2048 + col) = pack8u(v); } };
struct FGates { bf16 *ya, *yb, *sa, *sb;
    __device__ __forceinline__ void operator()(int row, int col, const float* v) const {
        const int reg = col >> 10, c = col & 1023; const size_t off = (size_t)row * DM + c; float o[8];
        if (reg < 2) { bf16* y = reg == 0 ? ya : yb; float yv[8]; unpack8(*(const u32x4*)(y + off), yv);
#pragma unroll
            for (int i = 0; i < 8; ++i) o[i] = yv[i] * v[i] * sigm(v[i]);
            *(u32x4*)(y + off) = pack8u(o);
        } else { bf16* s = reg == 2 ? sa : sb;
#pragma unroll
            for (int i = 0; i < 8; ++i) o[i] = sigm(v[i]);
            *(u32x4*)(s + off) = pack8u(o); }
    } };
struct FGa { const bf16* sg; bf16* m1; __device__ __forceinline__ void operator()(int row, int col, const float* v) const {
        const size_t off = (size_t)row * DM + col; float g[8], o[8]; unpack8(*(const u32x4*)(sg + off), g);
#pragma unroll
        for (int i = 0; i < 8; ++i) o[i] = g[i] * v[i];
        *(u32x4*)(m1 + off) = pack8u(o); } };
struct FGb { const bf16* sg; const bf16* m1; bf16* mg; __device__ __forceinline__ void operator()(int row, int col, const float* v) const {
        const size_t off = (size_t)row * DM + col; float g[8], a[8], o[8]; unpack8(*(const u32x4*)(sg + off), g); unpack8(*(const u32x4*)(m1 + off), a);
#pragma unroll
        for (int i = 0; i < 8; ++i) o[i] = a[i] + g[i] * v[i];
        *(u32x4*)(mg + off) = pack8u(o); } };
struct FGo { const float* xo; float* xn; __device__ __forceinline__ void operator()(int row, int col, const float* v) const {
        const size_t off = (size_t)row * DM + col; const f32x4 a = *(const f32x4*)(xo + off), b = *(const f32x4*)(xo + off + 4);
        f32x4 o0 = {a.x + v[0], a.y + v[1], a.z + v[2], a.w + v[3]}, o1 = {b.x + v[4], b.y + v[5], b.z + v[6], b.w + v[7]};
        *(f32x4*)(xn + off) = o0; *(f32x4*)(xn + off + 4) = o1; } };

template <class F> __device__ __forceinline__ void run_gemm(LAS unsigned char* lds, const bf16* A, const bf16* Bt, int N, const F& f) {
    pg8::Gemm g{A, Bt, T, N, DM}; pg8::StaticOrder S; S.init(T, N, (int)gridDim.x, (int)blockIdx.x);
    EpiGen<F> E{f};
    pg8::gemm_phase<EpiGen<F>, pg8::StaticOrder, PG8_ALIGN, PG8_SP2>(lds, g, S, E);
}
constexpr int CST_OFF = 133120 + 16384;
constexpr int C_CMP = 0, C_CMN = 256;
constexpr int C_RMP = 512, C_RMN = 704;
constexpr int C_DB = 896, C_IB = 1024;
constexpr int C_KK = 1152, C_KA = 1216, C_RK = 1280, C_VB = 1344, C_END = 1408;
__device__ __forceinline__ void prep_consts(int l, int h, LAS float* cst) {
    const CAS Params* p = KARG();
    for (int i = threadIdx.x; i < C_END; i += 512) {
        float v;
        if (i < 512) { const int r = i & 255, type = r >> 7, dir = (r >> 6) & 1, col = r & 63; const int gc = (type ? 3200 : 3072) + 64 * dir + col; v = (i < 256 ? p->in[I_SP] : p->in[I_SN])[(size_t)l * 3328 + gc]; }
        else if (i < 896) { const int r = (i - 512) % 192, which = r >> 6, col = r & 63; v = (i < 704 ? p->in[I_SP] : p->in[I_SN])[(size_t)l * 3328 + which * 1024 + h * 64 + col]; }
        else if (i < 1152) { const int r = (i - 896) & 127, dir = r >> 6, col = r & 63; v = (i < 1024 ? p->in[I_DB] : p->in[I_IB])[((size_t)l * 2 + dir) * DM + h * 64 + col]; }
        else { const int which = (i - 1152) >> 6, col = i & 63; const float* src = which == 0 ? p->in[I_KK] : which == 1 ? p->in[I_KA] : which == 2 ? p->in[I_RK] : p->in[I_VB];
               v = (which == 3 && l == 0) ? 0.f : src[(size_t)(which == 3 ? l - 1 : l) * DM + h * 64 + col]; }
        cst[i] = v;
    }
}
__device__ __forceinline__ f32x2 mixp(unsigned c, unsigned pv, unsigned nv, f32x2 m1, f32x2 m2) {
    const float c0 = bflo(c), c1 = bfhi(c);
    float r0 = __builtin_fmaf(m2.x, bflo(nv) - c0, __builtin_fmaf(m1.x, bflo(pv) - c0, c0)), r1 = __builtin_fmaf(m2.y, bfhi(nv) - c1, __builtin_fmaf(m1.y, bfhi(pv) - c1, c1));
    asm("" : "+v"(r0), "+v"(r1));
    return (f32x2){r0, r1};
}
__device__ __forceinline__ void mix8p(const u32x4 c, const u32x4 pv, const u32x4 nv, const LAS float* mp, const LAS float* mn, float* o) {
    const f32x4 a0 = *(const LAS f32x4*)mp, a1 = *(const LAS f32x4*)(mp + 4), b0 = *(const LAS f32x4*)mn, b1 = *(const LAS f32x4*)(mn + 4);
    const f32x2 r0 = mixp(c.x, pv.x, nv.x, (f32x2){a0.x, a0.y}, (f32x2){b0.x, b0.y}), r1 = mixp(c.y, pv.y, nv.y, (f32x2){a0.z, a0.w}, (f32x2){b0.z, b0.w});
    const f32x2 r2 = mixp(c.z, pv.z, nv.z, (f32x2){a1.x, a1.y}, (f32x2){b1.x, b1.y}), r3 = mixp(c.w, pv.w, nv.w, (f32x2){a1.z, a1.w}, (f32x2){b1.z, b1.w});
    o[0] = r0.x; o[1] = r0.y; o[2] = r1.x; o[3] = r1.y; o[4] = r2.x; o[5] = r2.y; o[6] = r3.x; o[7] = r3.y;
}
__device__ __forceinline__ void mix4p(const u32x2 c, const u32x2 pv, const u32x2 nv, const LAS float* mp, const LAS float* mn, float* o) {
    const f32x4 a0 = *(const LAS f32x4*)mp, b0 = *(const LAS f32x4*)mn;
    const f32x2 r0 = mixp(c.x, pv.x, nv.x, (f32x2){a0.x, a0.y}, (f32x2){b0.x, b0.y}), r1 = mixp(c.y, pv.y, nv.y, (f32x2){a0.z, a0.w}, (f32x2){b0.z, b0.w});
    o[0] = r0.x; o[1] = r0.y; o[2] = r1.x; o[3] = r1.y;
}
#define PREP_COMMON() \
    const CAS Params* p = KARG(); unsigned char* ws = p->ws; \
    asm volatile("" : "+v"(lane));     \
    const int fr = lane & 15, fq = lane >> 4; \
    const int s = fr, t = dir == 0 ? c * CHS + s : SEQ - 1 - c * CHS - s; \
    const size_t row = (size_t)b * SEQ + t; \
    const bf16* rawA = (const bf16*)(ws + OFF_RAWA) + row * LDA; \
    const int dp = t > 0 ? -LDA : 0, dn = t < SEQ - 1 ? LDA : 0;            \
    const bool pz = t > 0, nz = t < SEQ - 1; \
    LAS float* rs_ = rg + s * RSTEP;
#define ZERO_ENDS4(A) do { if (!pz) A[1] = (u32x4){0u, 0u, 0u, 0u}; if (!nz) A[2] = (u32x4){0u, 0u, 0u, 0u}; } while (0)
#define ZERO_ENDS2(A) do { if (!pz) A[1] = (u32x2){0u, 0u}; if (!nz) A[2] = (u32x2){0u, 0u}; } while (0)

__device__ __forceinline__ void prep_x(int l, int b, int h, int dir, int c, LAS float* rg, const LAS float* cst, int lane) {
    PREP_COMMON();
    const bf16* Wd = (const bf16*)(ws + OFF_WDEC) + (size_t)dir * DM * 64; const bf16* Wv = (const bf16*)(ws + OFF_WVR);
    bf16* vfirst = (bf16*)(ws + OFF_VFIRST) + row * DM; bf16* vfin = (bf16*)(ws + OFF_VFIN) + row * DM;
    u32x4 cdr[2][3];
#pragma unroll
    for (int ks = 0; ks < 2; ++ks) { const bf16* q = rawA + 3072 + 64 * dir + 32 * ks + 8 * fq; cdr[ks][0] = *(const u32x4*)q; cdr[ks][1] = *(const u32x4*)(q + dp); cdr[ks][2] = *(const u32x4*)(q + dn); }
    u32x4 bvr = {0u, 0u, 0u, 0u}; if (l > 0) bvr = *(const u32x4*)(rawA + 3328 + 8 * fq);
    u32x4 wdr[4][2], wvr[4]; u32x2 vr_[4][3], vfr[4];
#pragma unroll
    for (int nb = 0; nb < 4; ++nb) { const int chr = h * 64 + nb * 16 + fr;
#pragma unroll
        for (int ks = 0; ks < 2; ++ks) wdr[nb][ks] = *(const u32x4*)(Wd + (size_t)chr * 64 + 32 * ks + 8 * fq);
        wvr[nb] = (u32x4){0u, 0u, 0u, 0u}; if (l > 0) wvr[nb] = *(const u32x4*)(Wv + (size_t)chr * 32 + 8 * fq);
        const int ch = h * 64 + nb * 16 + 4 * fq; const bf16* q = rawA + 2048 + ch;
        vr_[nb][0] = *(const u32x2*)q; vr_[nb][1] = *(const u32x2*)(q + dp); vr_[nb][2] = *(const u32x2*)(q + dn);
        vfr[nb] = (u32x2){0u, 0u}; if (l > 0) vfr[nb] = *(const u32x2*)(vfirst + ch); }
    __builtin_amdgcn_sched_barrier(0);
    bf16x8 bd[2];
#pragma unroll
    for (int ks = 0; ks < 2; ++ks) {
        float o[8]; const int cc = 64 * dir + 32 * ks + 8 * fq;
        ZERO_ENDS4(cdr[ks]);
        mix8p(cdr[ks][0], cdr[ks][1], cdr[ks][2], cst + C_CMP + cc, cst + C_CMN + cc, o);
#pragma unroll
        for (int i = 0; i < 8; ++i) o[i] = 1.0f - 2.0f * __builtin_amdgcn_rcpf(1.0f + __expf(2.0f * o[i]));
        bd[ks] = pack8(o);
    }
    const bf16x8 bv = __builtin_bit_cast(bf16x8, bvr);
#pragma unroll
    for (int nb = 0; nb < 4; ++nb) {
        f32x4 aD = {0.f, 0.f, 0.f, 0.f}, aV = aD;
#pragma unroll
        for (int ks = 0; ks < 2; ++ks) aD = MFMA16(__builtin_bit_cast(bf16x8, wdr[nb][ks]), bd[ks], aD);
        if (l > 0) aV = MFMA16(__builtin_bit_cast(bf16x8, wvr[nb]), bv, aV);
        const int co = nb * 16 + 4 * fq, ch = h * 64 + co;
        float vv[4];
        ZERO_ENDS2(vr_[nb]);
        mix4p(vr_[nb][0], vr_[nb][1], vr_[nb][2], cst + C_RMP + 128 + co, cst + C_RMN + 128 + co, vv);
        const f32x4 dbias = *(const LAS f32x4*)(cst + C_DB + 64 * dir + co);
        if (l > 0) {
            float vf[4]; unpack4(vfr[nb], vf);
            const f32x4 vbias = *(const LAS f32x4*)(cst + C_VB + co);
#pragma unroll
            for (int i = 0; i < 4; ++i) { const float g = sigm(vbias[i] + aV[i]); vv[i] = vv[i] + (vf[i] - vv[i]) * g; }
        }
        if (dir == 0) { u32x2 o; o.x = pk2(vv[0], vv[1]); o.y = pk2(vv[2], vv[3]); *(u32x2*)((l == 0 ? vfirst : vfin) + ch) = o; }
        f32x4 vw, vvv;
#pragma unroll
        for (int i = 0; i < 4; ++i) { vw[i] = __expf(-0.60653066f * sigm(dbias[i] + aD[i])); vvv[i] = vv[i]; }
        *(LAS f32x4*)(rs_ + co) = vw; *(LAS f32x4*)(rs_ + 64 + co) = vvv;
    }
}
__device__ __forceinline__ void prep_y(int l, int b, int h, int dir, int c, LAS float* rg, const LAS float* cst, int lane) {
    PREP_COMMON();
    const bf16* Wi = (const bf16*)(ws + OFF_WIC) + (size_t)dir * DM * 64;
    u32x4 cir[2][3];
#pragma unroll
    for (int ks = 0; ks < 2; ++ks) { const bf16* q = rawA + 3200 + 64 * dir + 32 * ks + 8 * fq; cir[ks][0] = *(const u32x4*)q; cir[ks][1] = *(const u32x4*)(q + dp); cir[ks][2] = *(const u32x4*)(q + dn); }
    u32x4 wir[4][2]; u32x2 kr[4][3], rr_[4][3];
#pragma unroll
    for (int nb = 0; nb < 4; ++nb) { const int chr = h * 64 + nb * 16 + fr;
#pragma unroll
        for (int ks = 0; ks < 2; ++ks) wir[nb][ks] = *(const u32x4*)(Wi + (size_t)chr * 64 + 32 * ks + 8 * fq);
        const bf16* q = rawA + h * 64 + nb * 16 + 4 * fq;
        rr_[nb][0] = *(const u32x2*)q; rr_[nb][1] = *(const u32x2*)(q + dp); rr_[nb][2] = *(const u32x2*)(q + dn);
        kr[nb][0] = *(const u32x2*)(q + 1024); kr[nb][1] = *(const u32x2*)(q + 1024 + dp); kr[nb][2] = *(const u32x2*)(q + 1024 + dn); }
    __builtin_amdgcn_sched_barrier(0);
    bf16x8 bi[2];
#pragma unroll
    for (int ks = 0; ks < 2; ++ks) {
        float o[8]; const int cc = 128 + 64 * dir + 32 * ks + 8 * fq;
        ZERO_ENDS4(cir[ks]);
        mix8p(cir[ks][0], cir[ks][1], cir[ks][2], cst + C_CMP + cc, cst + C_CMN + cc, o);
        bi[ks] = pack8(o);
    }
    float kk[16]; float ss = 0.f;
#pragma unroll
    for (int nb = 0; nb < 4; ++nb) {
        const int co = nb * 16 + 4 * fq;
        ZERO_ENDS2(kr[nb]);
        mix4p(kr[nb][0], kr[nb][1], kr[nb][2], cst + C_RMP + 64 + co, cst + C_RMN + 64 + co, kk + 4 * nb);
        const f32x4 kkw = *(const LAS f32x4*)(cst + C_KK + co);
#pragma unroll
        for (int i = 0; i < 4; ++i) { const float kr_ = kk[4 * nb + i] * kkw[i]; ss += kr_ * kr_; }
    }
    ss += __shfl_xor(ss, 16); ss += __shfl_xor(ss, 32);
    const float nrm = rsqrtf(ss + 1e-12f);
    float cs = 0.f;
#pragma unroll
    for (int nb = 0; nb < 4; ++nb) {
        f32x4 aI = {0.f, 0.f, 0.f, 0.f};
#pragma unroll
        for (int ks = 0; ks < 2; ++ks) aI = MFMA16(__builtin_bit_cast(bf16x8, wir[nb][ks]), bi[ks], aI);
        const int co = nb * 16 + 4 * fq;
        float rr[4];
        ZERO_ENDS2(rr_[nb]);
        mix4p(rr_[nb][0], rr_[nb][1], rr_[nb][2], cst + C_RMP + co, cst + C_RMN + co, rr);
        const f32x4 ibias = *(const LAS f32x4*)(cst + C_IB + 64 * dir + co);
        const f32x4 kkw = *(const LAS f32x4*)(cst + C_KK + co), kaw = *(const LAS f32x4*)(cst + C_KA + co), rkw = *(const LAS f32x4*)(cst + C_RK + co);
        f32x4 va, vb, vkd, vr;
#pragma unroll
        for (int i = 0; i < 4; ++i) {
            const float al = sigm(ibias[i] + aI[i]);
            const float kraw = kk[4 * nb + i];
            const float kn = kraw * kkw[i] * nrm;
            const float kd = kraw * (1.0f + (al - 1.0f) * kaw[i]);
            va[i] = -kn; vb[i] = kn * al; vkd[i] = kd; vr[i] = rr[i];
            cs += rr[i] * kd * rkw[i];
        }
        *(LAS u32x4*)(rs_ + 128 + co) = (u32x4){cvtpk(0.25f * vb[0], 0.25f * vkd[0]), cvtpk(0.25f * vb[1], 0.25f * vkd[1]), cvtpk(0.25f * vb[2], 0.25f * vkd[2]), cvtpk(0.25f * vb[3], 0.25f * vkd[3])};
        *(LAS u32x2*)(rs_ + 192 + (co >> 1)) = (u32x2){cvtpk(va[0], va[1]), cvtpk(va[2], va[3])};
        *(LAS u32x2*)(rs_ + 224 + (co >> 1)) = (u32x2){cvtpk(vr[0], vr[1]), cvtpk(vr[2], vr[3])};
    }
    cs += __shfl_xor(cs, 16); cs += __shfl_xor(cs, 32);
    if (fq == 0) ((float*)(ws + OFF_COEF))[((size_t)dir * T + row) * 16 + h] = cs;
}
#define PREP_ROLE(jw, cc, slot) do { if (((jw) >> 1) == 0) prep_x(l, b, h, (jw) & 1, (cc), ring + (size_t)((slot) * 2 + ((jw) & 1)) * CHS * RSTEP, cst, lane); \
                                     else prep_y(l, b, h, (jw) & 1, (cc), ring + (size_t)((slot) * 2 + ((jw) & 1)) * CHS * RSTEP, cst, lane); } while (0)

#define SCHEDB() __builtin_amdgcn_sched_barrier(0)
__device__ __forceinline__ void swap16(float& a, float& b) { const auto r = __builtin_amdgcn_permlane16_swap(__builtin_bit_cast(unsigned, a), __builtin_bit_cast(unsigned, b), false, false); a = __builtin_bit_cast(float, (unsigned)r[0]); b = __builtin_bit_cast(float, (unsigned)r[1]); }
__device__ __forceinline__ void swap32(float& a, float& b) { const auto r = __builtin_amdgcn_permlane32_swap(__builtin_bit_cast(unsigned, a), __builtin_bit_cast(unsigned, b), false, false); a = __builtin_bit_cast(float, (unsigned)r[0]); b = __builtin_bit_cast(float, (unsigned)r[1]); }
__device__ __forceinline__ float scatter4(float p0, float p1) { swap16(p0, p1); float z = p0 + p1, z2 = z; swap32(z, z2); return z + z2; }
#define SCAN_DOTS(AH0, AH1, D0, D1) do { \
        const u32x4 b00 = {cvtpk(c[0][0].x, c[0][0].y), cvtpk(c[0][0].z, c[0][0].w), cvtpk(c[1][0].x, c[1][0].y), cvtpk(c[1][0].z, c[1][0].w)}; \
        const u32x4 b01 = {cvtpk(c[2][0].x, c[2][0].y), cvtpk(c[2][0].z, c[2][0].w), cvtpk(c[3][0].x, c[3][0].y), cvtpk(c[3][0].z, c[3][0].w)}; \
        const u32x4 b10 = {cvtpk(c[0][1].x, c[0][1].y), cvtpk(c[0][1].z, c[0][1].w), cvtpk(c[1][1].x, c[1][1].y), cvtpk(c[1][1].z, c[1][1].w)}; \
        const u32x4 b11 = {cvtpk(c[2][1].x, c[2][1].y), cvtpk(c[2][1].z, c[2][1].w), cvtpk(c[3][1].x, c[3][1].y), cvtpk(c[3][1].z, c[3][1].w)}; \
        D0 = MFMA16(__builtin_bit_cast(bf16x8, AH0), __builtin_bit_cast(bf16x8, b00), ((f32x4){0.f, 0.f, 0.f, 0.f})); D0 = MFMA16(__builtin_bit_cast(bf16x8, AH1), __builtin_bit_cast(bf16x8, b01), D0); \
        D1 = MFMA16(__builtin_bit_cast(bf16x8, AH0), __builtin_bit_cast(bf16x8, b10), ((f32x4){0.f, 0.f, 0.f, 0.f})); D1 = MFMA16(__builtin_bit_cast(bf16x8, AH1), __builtin_bit_cast(bf16x8, b11), D1); } while (0)
#define SCAN_LD_AV(AH0, AH1, P) do { const u32x2 q0 = *(const LAS u32x2*)((P) + 0), q1 = *(const LAS u32x2*)((P) + 8), q2 = *(const LAS u32x2*)((P) + 16), q3 = *(const LAS u32x2*)((P) + 24); \
        AH0 = (u32x4){q0.x, q0.y, q1.x, q1.y}; AH1 = (u32x4){q2.x, q2.y, q3.x, q3.y}; } while (0)
#define SCAN_STEP(S_, CW, CBK, NW, NBK) do { \
        const int sn = (S_) + 1 < CHS ? (S_) + 1 : (S_); const LAS float* nstep = sl + sn * RSTEP; \
        const LAS float* avp = (asel ? nstep + 192 : sl + (S_) * RSTEP + 224) + 2 * mg;        \
        u32x4 ah0, ah1; SCAN_LD_AV(ah0, ah1, avp); \
        _Pragma("unroll") for (int kt = 0; kt < 4; ++kt) { NW[kt] = *(const LAS f32x4*)(nstep + 16 * kt + 4 * mg); NBK[kt] = ((const LAS unsigned*)nstep)[128 + 16 * kt + v16]; } \
        const float vn0 = vb[sn * RSTEP], vn1 = vb[sn * RSTEP + 16]; \
        SCHEDB(); \
        { bx0.x = cvtpk(x0, v0); bx1.x = cvtpk(x1, v1);     \
        _Pragma("unroll") for (int kt = 0; kt < 4; ++kt) { \
            at.x = CBK[kt]; \
            const f32x4 i0 = MFMA16(__builtin_bit_cast(bf16x8, at), __builtin_bit_cast(bf16x8, bx0), ((f32x4){0.f, 0.f, 0.f, 0.f})); \
            const f32x4 i1 = MFMA16(__builtin_bit_cast(bf16x8, at), __builtin_bit_cast(bf16x8, bx1), ((f32x4){0.f, 0.f, 0.f, 0.f})); \
            _Pragma("unroll") for (int i = 0; i < 4; ++i) { float r0 = __builtin_fmaf(c[kt][0][i], CW[kt][i], i0[i]), r1 = __builtin_fmaf(c[kt][1][i], CW[kt][i], i1[i]); \
                asm("" : "+v"(r0), "+v"(r1));     \
                c[kt][0][i] = r0; c[kt][1][i] = r1; } } } \
        SCHEDB(); \
        { f32x4 d0, d1; SCAN_DOTS(ah0, ah1, d0, d1); \
        x0 = d0[1]; x1 = d1[1]; \
        if (lane < 32) ybuf[(S_) * 32 + lane] = mg == 0 ? d0[0] : d1[0];     } \
        v0 = vn0; v1 = vn1; \
        SCHEDB(); } while (0)
__device__ __forceinline__ void scan_chunk(f32x4 (&c)[4][2], const LAS float* sl  , int rh, LAS float* ybuf  , int lane) {
    const int mg = lane >> 4, v16 = lane & 15;
    const bool asel = (lane & 3) == 1;
    const LAS float* vb = sl + 64 + 32 * rh + v16;
    f32x4 wA[4], wB[4]; unsigned bkA[4], bkB[4];
    u32x4 at = {0u, 0u, 0u, 0u}, bx0 = {0u, 0u, 0u, 0u}, bx1 = {0u, 0u, 0u, 0u};
    float x0, x1;
    {
        u32x4 ah0, ah1; SCAN_LD_AV(ah0, ah1, sl + 192 + 2 * mg);
#pragma unroll
        for (int kt = 0; kt < 4; ++kt) { wA[kt] = *(const LAS f32x4*)(sl + 16 * kt + 4 * mg); bkA[kt] = ((const LAS unsigned*)sl)[128 + 16 * kt + v16]; }
        f32x4 d0, d1; SCAN_DOTS(ah0, ah1, d0, d1);
        x0 = asel ? d0[1] : d0[0]; x1 = asel ? d1[1] : d1[0];
    }
    float v0 = vb[0], v1 = vb[16];
#pragma unroll 1
    for (int s = 0; s < CHS; s += 2) {
        SCAN_STEP(s, wA, bkA, wB, bkB);
        SCAN_STEP(s + 1, wB, bkB, wA, bkA);
    }
}

#define Y_T(dir_, cc, s) ((dir_) == 0 ? (cc) * CHS + (s) : SEQ - 1 - (cc) * CHS - (s))
__device__ __forceinline__ void yflush_issue(unsigned (&yo)[4], const bf16* yb2  , int dir, int cc, int lane) {
    const int rg = lane >> 4;
    if (cc >= NCH / 2) {
#pragma unroll
        for (int i = 0; i < 4; ++i) yo[i] = *(const unsigned*)(yb2 + (size_t)Y_T(dir, cc, 4 * i + rg) * DM);
    } else {
#pragma unroll
        for (int i = 0; i < 4; ++i) yo[i] = 0u;
    }
}
__device__ __forceinline__ void yflush_finish(const unsigned (&yo)[4], bf16* yb2, const LAS float* ybuf  , int dir, int cc, int lane) {
    const int rg = lane >> 4, cp = lane & 15;
#pragma unroll
    for (int i = 0; i < 4; ++i) { const int s = 4 * i + rg; const f32x2 yv = *(const LAS f32x2*)(ybuf + s * 32 + 2 * cp);
        *(unsigned*)(yb2 + (size_t)Y_T(dir, cc, s) * DM) = pk2(yv.x + bflo(yo[i]), yv.y + bfhi(yo[i])); }
}

__device__ __forceinline__ void scan_phase(int l, LAS unsigned char* lds, int wave, int lane) {
    asm volatile("" : "+v"(lane));
    unsigned char* ws = KARG()->ws;
    LAS float* ring = (LAS float*)(lds + 32768);
    for (int bh = blockIdx.x; bh < BATCH * 16; bh += gridDim.x) {
        const int b = bh >> 4, h = bh & 15;
        LAS f32x4* sts = (LAS f32x4*)lds + (wave & 3) * 512 + lane;
        LAS float* cst = (LAS float*)(lds + CST_OFF);
        LAS float* ybw = (LAS float*)(lds + 133120) + (wave & 3) * 2 * CHS * 32;
        const int dirw = wave & 1, rhw = (wave >> 1) & 1;
        bf16* yb2 = (bf16*)(ws + OFF_YS) + (size_t)b * SEQ * DM + h * 64 + 32 * rhw + 2 * (lane & 15);
        prep_consts(l, h, cst);
        LDS_WAIT(); __syncthreads();
        f32x4 st[4][2];
#pragma unroll
        for (int k = 0; k < 8; ++k) st[k >> 1][k & 1] = (f32x4){0.f, 0.f, 0.f, 0.f};
        if (wave >= 4) PREP_ROLE(wave - 4, 0, 0);
        LDS_WAIT(); __syncthreads();
#pragma unroll 1
        for (int c = 0; c < NCH; ++c) {
            if (wave < 4) {
                scan_chunk(st, ring + (size_t)((c & 1) * 2 + dirw) * CHS * RSTEP, rhw, ybw + (c & 1) * CHS * 32, lane);
            } else {
                unsigned yo[4];
                if (c > 0) yflush_issue(yo, yb2, dirw, c - 1, lane);
                if (c + 1 < NCH) PREP_ROLE(wave - 4, c + 1, (c + 1) & 1);
                if (c > 0) yflush_finish(yo, yb2, ybw + ((c - 1) & 1) * CHS * 32, dirw, c - 1, lane);
            }
            if (c == NCH / 2) VM_WAIT(); else asm volatile("s_waitcnt vmcnt(4)" ::: "memory");
            LDS_WAIT(); __syncthreads();
        }
        if (wave >= 4) { unsigned yo[4]; yflush_issue(yo, yb2, dirw, NCH - 1, lane); yflush_finish(yo, yb2, ybw + ((NCH - 1) & 1) * CHS * 32, dirw, NCH - 1, lane); }
        VM_WAIT(); __syncthreads();
    }
}

__device__ __forceinline__ void postscan_phase(int l, int gw, int NGW, int lane) {
    asm volatile("" : "+s"(NGW), "+s"(gw));
    asm volatile("" : "+v"(lane));
    const CAS Params* p = KARG(); unsigned char* ws = p->ws;
    const bf16* vcur = (const bf16*)(ws + (l == 0 ? OFF_VFIRST : OFF_VFIN));
    const float* coef = (const float*)(ws + OFF_COEF);
    const int ch = 16 * lane, hd = lane >> 2;
    f32x4 g4[4], b4[4];
#pragma unroll
    for (int i = 0; i < 4; ++i) { g4[i] = *(const f32x4*)(p->in[I_LG] + (size_t)l * DM + ch + 4 * i); b4[i] = *(const f32x4*)(p->in[I_LB] + (size_t)l * DM + ch + 4 * i); }
    for (int m0 = gw; m0 < T; m0 += 2 * NGW) {
        u32x4 yr[2][2], vr[2][2]; float cf[2];
#pragma unroll
        for (int r = 0; r < 2; ++r) { const int m = m0 + r * NGW < T ? m0 + r * NGW : m0;
            const bf16* yp = (const bf16*)(ws + OFF_YS) + (size_t)m * DM + ch; const bf16* vp = vcur + (size_t)m * DM + ch;
            yr[r][0] = *(const u32x4*)yp; yr[r][1] = *(const u32x4*)(yp + 8); vr[r][0] = *(const u32x4*)vp; vr[r][1] = *(const u32x4*)(vp + 8);
            cf[r] = coef[(size_t)m * 16 + hd] + coef[((size_t)T + m) * 16 + hd]; }
#pragma unroll
        for (int r = 0; r < 2; ++r) { const int m = m0 + r * NGW; if (m < T) {
            float y[16], v[16];
            unpack8(yr[r][0], y); unpack8(yr[r][1], y + 8); unpack8(vr[r][0], v); unpack8(vr[r][1], v + 8);
            float sm = 0.f;
#pragma unroll
            for (int i = 0; i < 16; ++i) sm += y[i];
            sm += __shfl_xor(sm, 1); sm += __shfl_xor(sm, 2);
            const float mean = sm * (1.f / 64.f); float q = 0.f;
#pragma unroll
            for (int i = 0; i < 16; ++i) { y[i] -= mean; q += y[i] * y[i]; }
            q += __shfl_xor(q, 1); q += __shfl_xor(q, 2);
            const float rstd = rsqrtf(q * (1.f / 64.f) + 64e-5f);
            float o[16];
#pragma unroll
            for (int i = 0; i < 16; i += 4)
#pragma unroll
                for (int j = 0; j < 4; ++j) o[i + j] = y[i + j] * rstd * g4[i >> 2][j] + b4[i >> 2][j] + cf[r] * v[i + j];
            bf16* yp = (bf16*)(ws + OFF_YS) + (size_t)m * DM + ch;
            *(u32x4*)yp = pack8u(o); *(u32x4*)(yp + 8) = pack8u(o + 8); } }
    }
}

__device__ __forceinline__ float ret_log2g(int h) { const float e = exp2f(-5.0f - (float)h); return -1.4426950408889634f * (e + e * e * (0.5f + e * (0.33333333f + e * 0.25f))); }
constexpr int KP = 136;
constexpr int QP = 72;
__device__ __forceinline__ void stage_vt(const bf16* rawB, int b, int h, int j, LAS bf16* Vt, int tid) {
    const int m = tid >> 2, part = tid & 3;
    const bf16* src = rawB + ((size_t)b * SEQ + j * RC + m) * 2048 + 1024 + h * 128 + 32 * part;
#pragma unroll
    for (int q = 0; q < 4; ++q) { float f[8]; const u32x4 u = *(const u32x4*)(src + 8 * q);
        const unsigned w[4] = {u.x, u.y, u.z, u.w};
#pragma unroll
        for (int i = 0; i < 4; ++i) { Vt[(32 * part + 8 * q + 2 * i) * KP + m] = (bf16)(w[i] & 0xffffu); Vt[(32 * part + 8 * q + 2 * i + 1) * KP + m] = (bf16)(w[i] >> 16); }
        (void)f; }
}
__device__ __forceinline__ void rot8(const bf16* src, const float* rot, int pos, int part, float scale, float* o1, float* o2) {
    float x1[8], x2[8]; unpack8(*(const u32x4*)(src + 8 * part), x1); unpack8(*(const u32x4*)(src + 32 + 8 * part), x2);
    const float* cs = rot + (size_t)pos * 32 + 8 * part; const float* sn = rot + (size_t)2048 * 32 + (size_t)pos * 32 + 8 * part;
    const f32x4 c0 = *(const f32x4*)cs, c1 = *(const f32x4*)(cs + 4), s0 = *(const f32x4*)sn, s1 = *(const f32x4*)(sn + 4);
    const float cv[8] = {c0.x, c0.y, c0.z, c0.w, c1.x, c1.y, c1.z, c1.w}, sv[8] = {s0.x, s0.y, s0.z, s0.w, s1.x, s1.y, s1.z, s1.w};
#pragma unroll
    for (int i = 0; i < 8; ++i) { o1[i] = (x1[i] * cv[i] - x2[i] * sv[i]) * scale; o2[i] = (x1[i] * sv[i] + x2[i] * cv[i]) * scale; }
}
__device__ __forceinline__ void ret_states_phase(LAS unsigned char* lds, int wave, int lane_) {
    int tid = threadIdx.x; asm volatile("" : "+v"(tid)); const int lane = tid & 63;
    const CAS Params* p = KARG(); unsigned char* ws = p->ws; const int fr = lane & 15, fq = lane >> 4;
    const bf16* rawB = (const bf16*)(ws + OFF_RAWB); const float* rot = (const float*)(ws + OFF_ROT);
    LAS bf16* Kt = (LAS bf16*)lds; LAS bf16* Vt = (LAS bf16*)(lds + 64 * KP * 2);
    const int m = tid >> 2, part = tid & 3;
    for (int it = blockIdx.x; it < BATCH * 8 * 2; it += gridDim.x) {
        const int dir = it & 1, bh = it >> 1, b = bh >> 3, h = bh & 7;
        const float l2g = ret_log2g(h), dC = exp2f(l2g * (float)RC);
        const float z = exp2f(l2g * (float)(dir == 0 ? RC - 1 - m : m));
        f32x4 acc[4];
#pragma unroll
        for (int nb = 0; nb < 4; ++nb) acc[nb] = (f32x4){0.f, 0.f, 0.f, 0.f};
        u32x4 kx1, kx2, vraw[4]; f32x4 c0, c1, s0, s1;
#define R1_LOAD(J_) do { const int pos_ = (J_) * RC + m; const bf16* row_ = rawB + ((size_t)b * SEQ + pos_) * 2048; \
            kx1 = *(const u32x4*)(row_ + 512 + h * 64 + 8 * part); kx2 = *(const u32x4*)(row_ + 512 + h * 64 + 32 + 8 * part); \
            _Pragma("unroll") for (int q = 0; q < 4; ++q) vraw[q] = *(const u32x4*)(row_ + 1024 + h * 128 + 32 * part + 8 * q); \
            const float* cs_ = rot + (size_t)pos_ * 32 + 8 * part; const float* sn_ = cs_ + (size_t)2048 * 32; \
            c0 = *(const f32x4*)cs_; c1 = *(const f32x4*)(cs_ + 4); s0 = *(const f32x4*)sn_; s1 = *(const f32x4*)(sn_ + 4); } while (0)
        R1_LOAD(dir == 0 ? 0 : NRC - 1);
#pragma unroll 1
        for (int jj = 0; jj < NRC; ++jj) {
            const int j = dir == 0 ? jj : NRC - 1 - jj;
            bf16* so = (bf16*)(ws + OFF_ST) + ((size_t)(bh * NRC + j) * 2 + dir) * 8192;
#pragma unroll
            for (int nb = 0; nb < 4; ++nb)
#pragma unroll
                for (int i = 0; i < 4; ++i) { so[(16 * wave + 4 * fq + i) * 64 + nb * 16 + fr] = (bf16)f2bf(acc[nb][i]); acc[nb][i] *= dC; }
            {
                float x1[8], x2[8]; unpack8(kx1, x1); unpack8(kx2, x2);
                const float cv[8] = {c0.x, c0.y, c0.z, c0.w, c1.x, c1.y, c1.z, c1.w}, sv[8] = {s0.x, s0.y, s0.z, s0.w, s1.x, s1.y, s1.z, s1.w};
#pragma unroll
                for (int i = 0; i < 8; ++i) { Kt[(8 * part + i) * KP + m] = (bf16)f2bf((x1[i] * cv[i] - x2[i] * sv[i]) * z); Kt[(32 + 8 * part + i) * KP + m] = (bf16)f2bf((x1[i] * sv[i] + x2[i] * cv[i]) * z); }
#pragma unroll
                for (int q = 0; q < 4; ++q) { const unsigned w[4] = {vraw[q].x, vraw[q].y, vraw[q].z, vraw[q].w};
#pragma unroll
                    for (int i = 0; i < 4; ++i) { Vt[(32 * part + 8 * q + 2 * i) * KP + m] = (bf16)(w[i] & 0xffffu); Vt[(32 * part + 8 * q + 2 * i + 1) * KP + m] = (bf16)(w[i] >> 16); } }
            }
            LDS_WAIT(); __syncthreads();
            if (jj + 1 < NRC) R1_LOAD(dir == 0 ? jj + 1 : NRC - 2 - jj);
#pragma unroll
            for (int ks = 0; ks < 4; ++ks) {
                const bf16x8 av = *(const LAS bf16x8*)(Vt + (16 * wave + fr) * KP + 32 * ks + 8 * fq);
#pragma unroll
                for (int nb = 0; nb < 4; ++nb) { const bf16x8 bk = *(const LAS bf16x8*)(Kt + (nb * 16 + fr) * KP + 32 * ks + 8 * fq); acc[nb] = MFMA16(av, bk, acc[nb]); }
            }
            LDS_WAIT(); __syncthreads();
        }
#undef R1_LOAD
    }
}
__device__ __forceinline__ void ret_out_phase(int l, LAS unsigned char* lds, int wave, int lane_) {
    int tid = threadIdx.x; asm volatile("" : "+v"(tid)); const int lane = tid & 63;
    const CAS Params* p = KARG(); unsigned char* ws = p->ws; const int fr = lane & 15, fq = lane >> 4;
    const bf16* rawB = (const bf16*)(ws + OFF_RAWB); const float* rot = (const float*)(ws + OFF_ROT);
    LAS bf16* Qs = (LAS bf16*)lds; LAS bf16* Ks = (LAS bf16*)(lds + 128 * QP * 2); LAS bf16* Vt = (LAS bf16*)(lds + 2 * 128 * QP * 2); LAS bf16* Pw = (LAS bf16*)(lds + 2 * 128 * QP * 2 + 128 * KP * 2) + wave * 16 * KP;
    for (int it = blockIdx.x; it < BATCH * 8 * NRC; it += gridDim.x) {
        const int j = it % NRC, bh = it / NRC, b = bh >> 3, h = bh & 7;
        const float l2g = ret_log2g(h);
        const __amdgpu_buffer_rsrc_t strs = __builtin_amdgcn_make_buffer_rsrc((void*)(ws + OFF_ST), 0, 0x7fffffff, 0x00027000);
        const unsigned sfo = (unsigned)(((bh * NRC + j) * 2 + 0) * 8192 * 2);
        u32x4 sfv[4][2], sbv[4][2];
#define RET_LD_STATES(g) do { _Pragma("unroll") for (int o4 = 0; o4 < 4; ++o4) _Pragma("unroll") for (int ks = 0; ks < 2; ++ks) { \
            const unsigned eo = sfo + (unsigned)((((4 * (g) + o4) * 16 + fr) * 64 + 32 * ks + 8 * fq) * 2); \
            sfv[o4][ks] = __builtin_amdgcn_raw_buffer_load_b128(strs, eo, 0, 0x11); sbv[o4][ks] = __builtin_amdgcn_raw_buffer_load_b128(strs, eo + 16384u, 0, 0x11); } } while (0)
        RET_LD_STATES(0);
        {
            const int m = tid >> 2, part = tid & 3; const int pos = j * RC + m;
            const bf16* src = rawB + ((size_t)b * SEQ + pos) * 2048 + h * 64;
            float o1[8], o2[8];
            rot8(src, rot, pos, part, 0.125f, o1, o2);
            *(LAS u32x4*)(Qs + m * QP + 8 * part) = pack8u(o1); *(LAS u32x4*)(Qs + m * QP + 32 + 8 * part) = pack8u(o2);
            rot8(src + 512, rot, pos, part, 1.0f, o1, o2);
            *(LAS u32x4*)(Ks + m * QP + 8 * part) = pack8u(o1); *(LAS u32x4*)(Ks + m * QP + 32 + 8 * part) = pack8u(o2);
            stage_vt(rawB, b, h, j, Vt, tid);
        }
        LDS_WAIT(); __syncthreads();
        bf16x8 aq[2];
#pragma unroll
        for (int ks = 0; ks < 2; ++ks) aq[ks] = *(const LAS bf16x8*)(Qs + (16 * wave + fr) * QP + 32 * ks + 8 * fq);
#pragma unroll
        for (int nb = 0; nb < 8; ++nb) {
            f32x4 sc = {0.f, 0.f, 0.f, 0.f};
#pragma unroll
            for (int ks = 0; ks < 2; ++ks) { const bf16x8 bk = *(const LAS bf16x8*)(Ks + (nb * 16 + fr) * QP + 32 * ks + 8 * fq); sc = MFMA16(aq[ks], bk, sc); }
#pragma unroll
            for (int i = 0; i < 4; ++i) { const int n = 16 * wave + 4 * fq + i, mk = nb * 16 + fr; const int d = n > mk ? n - mk : mk - n;
                Pw[(4 * fq + i) * KP + mk] = (bf16)f2bf(sc[i] * exp2f(l2g * (float)d)); }
        }
        LDS_WAIT(); asm volatile("" ::: "memory");
        f32x4 y1[8];
        f32x4 xfv, xbv;
#pragma unroll
        for (int i = 0; i < 4; ++i) { const int nl = 16 * wave + 4 * fq + i; xfv[i] = exp2f(l2g * (float)(nl + 1)); xbv[i] = exp2f(l2g * (float)(RC - nl)); }
        bf16x8 ap[4];
#pragma unroll
        for (int ks = 0; ks < 4; ++ks) ap[ks] = *(const LAS bf16x8*)(Pw + fr * KP + 32 * ks + 8 * fq);
#pragma unroll
        for (int g = 0; g < 2; ++g) {
            if (g == 1) { RET_LD_STATES(1); }
#pragma unroll
            for (int o4 = 0; o4 < 4; ++o4) {
                const int ob = 4 * g + o4;
                f32x4 y2 = {0.f, 0.f, 0.f, 0.f}, y3 = y2; y1[ob] = y2;
#pragma unroll
                for (int ks = 0; ks < 4; ++ks) { const bf16x8 bvv = *(const LAS bf16x8*)(Vt + (ob * 16 + fr) * KP + 32 * ks + 8 * fq); y1[ob] = MFMA16(ap[ks], bvv, y1[ob]); }
#pragma unroll
                for (int ks = 0; ks < 2; ++ks) { y2 = MFMA16(aq[ks], __builtin_bit_cast(bf16x8, sfv[o4][ks]), y2); y3 = MFMA16(aq[ks], __builtin_bit_cast(bf16x8, sbv[o4][ks]), y3); }
                y1[ob] = y1[ob] + xfv * y2 + xbv * y3;
            }
            asm volatile("" ::: "memory");
        }
#pragma unroll
        for (int i = 0; i < 4; ++i) {
            const int nl = 16 * wave + 4 * fq + i;
            float v[8]; float s = 0.f;
#pragma unroll
            for (int ob = 0; ob < 8; ++ob) { v[ob] = y1[ob][i]; s += v[ob]; }
            s += __shfl_xor(s, 1); s += __shfl_xor(s, 2); s += __shfl_xor(s, 4); s += __shfl_xor(s, 8);
            const float mean = s * (1.f / 128.f); float q = 0.f;
#pragma unroll
            for (int ob = 0; ob < 8; ++ob) { v[ob] -= mean; q += v[ob] * v[ob]; }
            q += __shfl_xor(q, 1); q += __shfl_xor(q, 2); q += __shfl_xor(q, 4); q += __shfl_xor(q, 8);
            const float rstd = rsqrtf(q * (1.f / 128.f) + 1e-6f);
            bf16* yo = (bf16*)(ws + OFF_YB) + ((size_t)b * SEQ + j * RC + nl) * DM + h * 128;
            const float* gn = p->in[I_RG] + (size_t)l * DM + h * 128;
#pragma unroll
            for (int ob = 0; ob < 8; ++ob) yo[ob * 16 + fr] = (bf16)f2bf(v[ob] * rstd * gn[ob * 16 + fr]);
        }
        __syncthreads();
    }
}

#define XB_TMO      128
#define XB_XCNT(j)  (256  + 64 * (j))
#define XB_XSUB(j)  (1280 + 64 * (j))
#define XB_XGEN(j)  (2304 + 64 * (j))
#define XB_TOP      3328
#define XB_TOPGEN   3392
#define XCD_BAR_WORDS 3456
#define XB_SPIN_CAP (1u << 18)

__device__ __forceinline__ unsigned xb_ld(unsigned* p)              { return __hip_atomic_load(p, __ATOMIC_RELAXED, __HIP_MEMORY_SCOPE_AGENT); }
__device__ __forceinline__ unsigned xb_add(unsigned* p, unsigned v) { return __hip_atomic_fetch_add(p, v, __ATOMIC_RELAXED, __HIP_MEMORY_SCOPE_AGENT); }
__device__ __forceinline__ unsigned xb_xcc_id() { return (unsigned)__builtin_amdgcn_s_getreg((3 << 11) | 20) & 0xFu; }
#define XB_SPIN(cond, bar) do { unsigned _sp = 0; while (cond) { __builtin_amdgcn_s_sleep(1); \
    if ((++_sp & 255u) == 0u) { if (xb_ld(&(bar)[XB_TMO])) break; if (_sp > XB_SPIN_CAP) { atomicAdd(&(bar)[XB_TMO], 1u); break; } } } } while (0)

struct XcdBarrier {
    unsigned* bar; unsigned x;
    volatile LAS unsigned* st;
};

__device__ __forceinline__ XcdBarrier xcd_barrier_post(unsigned* bar, volatile LAS unsigned* st) {
    XcdBarrier b; b.bar = bar; b.x = xb_xcc_id(); b.st = st;
    if (threadIdx.x == 0) (void)xb_add(&bar[XB_XCNT(b.x)], 1u);
    return b;
}
__device__ __forceinline__ void xcd_barrier_complete(unsigned* bar, unsigned x, unsigned& nloc, unsigned& nx) {
    const unsigned G = gridDim.x * gridDim.y * gridDim.z;
    unsigned sum, cnt, mine, sp = 0u;
    for (;;) {
        sum = 0u; cnt = 0u; mine = 0u;
#pragma unroll
        for (unsigned j = 0; j < 16; ++j) { const unsigned c = xb_ld(&bar[XB_XCNT(j)]); sum += c; cnt += (c > 0u) ? 1u : 0u; mine = (j == x) ? c : mine; }
        if (sum == G) break;
        __builtin_amdgcn_s_sleep(1);
        if ((++sp & 255u) == 0u) { if (xb_ld(&bar[XB_TMO])) break; if (sp > XB_SPIN_CAP) { atomicAdd(&bar[XB_TMO], 1u); break; } }
    }
    nloc = mine > 0u ? mine : 1u; nx = cnt > 0u ? cnt : 1u;
}

__device__ __forceinline__ void xcd_barrier(const XcdBarrier& b) {
    asm volatile("s_waitcnt vmcnt(0)" ::: "memory");
    __syncthreads();
    if (threadIdx.x == 0) {
        unsigned* bar = b.bar;
        __builtin_amdgcn_s_waitcnt(0);
        unsigned nloc = b.st[0], nx = b.st[1];
        if (nloc == 0u) { xcd_barrier_complete(bar, b.x, nloc, nx); b.st[0] = nloc; b.st[1] = nx; }
        const unsigned old = xb_add(&bar[XB_XSUB(b.x)], 1u);
        const unsigned gen = old / nloc;
        if (old + 1u == (gen + 1u) * nloc) {
            __builtin_amdgcn_fence(__ATOMIC_RELEASE, "agent");
            asm volatile("s_waitcnt vmcnt(0)" ::: "memory");
            const unsigned og = xb_add(&bar[XB_TOP], 1u);
            const unsigned tg = og / nx;
            if (og + 1u == (tg + 1u) * nx) xb_add(&bar[XB_TOPGEN], 1u);
            else XB_SPIN(xb_ld(&bar[XB_TOPGEN]) == tg, bar);
            __builtin_amdgcn_fence(__ATOMIC_ACQUIRE, "agent");
            xb_add(&bar[XB_XGEN(b.x)], 1u);
            asm volatile("s_waitcnt vmcnt(0)" ::: "memory");
        } else {
            XB_SPIN(xb_ld(&bar[XB_XGEN(b.x)]) == gen, bar);
            __builtin_amdgcn_fence(__ATOMIC_ACQUIRE, "agent");
            asm volatile("s_waitcnt vmcnt(0)" ::: "memory");
        }
    }
    __syncthreads();
}

#ifndef PHMASK
#define PHMASK 0xFFFF
#endif
#define PH(n) if constexpr ((PHMASK >> (n)) & 1)
#define GSYNC_CG() do { asm volatile("s_waitcnt vmcnt(0) lgkmcnt(0)" ::: "memory"); __syncthreads(); grid.sync(); __builtin_amdgcn_fence(__ATOMIC_ACQUIRE, "agent"); asm volatile("s_waitcnt vmcnt(0)" ::: "memory"); } while (0)
#define GSYNC() xcd_barrier(xbar)
__global__ void __launch_bounds__(512, 2) hybrid_fwd(Params p_unused) {
    extern __shared__ __attribute__((aligned(16))) unsigned char lds_raw[];
    LAS unsigned char* lds = (LAS unsigned char*)lds_raw;
    cg::grid_group grid = cg::this_grid();
    const int tid = threadIdx.x, lane = tid & 63, wave = __builtin_amdgcn_readfirstlane(tid >> 6);
    const int gw = blockIdx.x * 8 + wave, NGW = gridDim.x * 8;
    { volatile LAS unsigned* stw = (volatile LAS unsigned*)(lds + XB_LDS_OFF); if (threadIdx.x < 2) stw[threadIdx.x] = 0u; }
    __syncthreads();
    XcdBarrier xbar = xcd_barrier_post((unsigned*)KARG()->ws, (volatile LAS unsigned*)(lds + XB_LDS_OFF));
    GSYNC_CG();
    {
        float* rot = (float*)(KARG()->ws + OFF_ROT);
        for (int i = gw * 64 + lane; i < 2048 * 32; i += NGW * 64) { const int pos = i >> 5, jf = i & 31;
            const float fr_ = exp2f(-(float)jf * (13.287712379549449f / 32.0f)); float rev = (float)pos * fr_ * 0.15915494309189535f; rev -= rintf(rev);
            rot[i] = __builtin_amdgcn_cosf(rev); rot[2048 * 32 + i] = __builtin_amdgcn_sinf(rev); }
    }
#pragma unroll 1
    for (int l = 0; l < DEPTH; ++l) {
#define XIN (l == 0 ? KARG()->in[I_X] : (const float*)KARG()->out)
#define WSP(off) (KARG()->ws + (off))
        PH(0) convert_weights(l, lds, gw, NGW, wave, lane);
        PH(1) norm_phase(XIN, KARG()->in[I_NG] + (size_t)l * DM, (bf16*)WSP(OFF_XB), gw, NGW, lane);
        GSYNC();
        PH(2) run_gemm(lds, (const bf16*)WSP(OFF_XB), (const bf16*)WSP(OFF_WA), NA, FStoreA{(bf16*)WSP(OFF_RAWA)});
        GSYNC();
        PH(3) scan_phase(l, lds, wave, lane);
        GSYNC();
        PH(4) postscan_phase(l, gw, NGW, lane);
        PH(5) run_gemm(lds, (const bf16*)WSP(OFF_XB), (const bf16*)WSP(OFF_WB), 2048, FStoreB{(bf16*)WSP(OFF_RAWB)});
        GSYNC();
        PH(6) ret_states_phase(lds, wave, lane);
        GSYNC();
        PH(7) ret_out_phase(l, lds, wave, lane);
        GSYNC();
        PH(8) run_gemm(lds, (const bf16*)WSP(OFF_XB), (const bf16*)WSP(OFF_WG), 4096, FGates{(bf16*)WSP(OFF_YS), (bf16*)WSP(OFF_YB), (bf16*)WSP(OFF_SIGA), (bf16*)WSP(OFF_SIGB)});
        GSYNC();
        PH(9) run_gemm(lds, (const bf16*)WSP(OFF_YS), (const bf16*)WSP(OFF_Wa), DM, FGa{(const bf16*)WSP(OFF_SIGA), (bf16*)WSP(OFF_M1)});
        GSYNC();
        PH(10) run_gemm(lds, (const bf16*)WSP(OFF_YB), (const bf16*)WSP(OFF_Wb), DM, FGb{(const bf16*)WSP(OFF_SIGB), (const bf16*)WSP(OFF_M1), (bf16*)WSP(OFF_MG)});
        GSYNC();
        PH(11) run_gemm(lds, (const bf16*)WSP(OFF_MG), (const bf16*)WSP(OFF_Wo), DM, FGo{XIN, KARG()->out});
        GSYNC();
    }
    final_norm(KARG()->out, KARG()->in[I_FG], gw, NGW, lane);
}

extern "C" void kernel_launch(void* const* d_in, const int* in_sizes, int n_in, void* d_out, int out_size, void* d_ws, size_t ws_size, hipStream_t stream) {
    static int grid = 0;
    if (grid == 0) {
        if (n_in != 22 || ws_size < WS_END) { fprintf(stderr, "kernel_launch: unexpected n_in %d / ws_size %zu (need %zu)\n", n_in, ws_size, (size_t)WS_END); grid = -1; return; }
        int dev = 0, cus = 0, per_cu = 0;
        (void)hipGetDevice(&dev); (void)hipDeviceGetAttribute(&cus, hipDeviceAttributeMultiprocessorCount, dev);
        (void)hipFuncSetAttribute((const void*)hybrid_fwd, hipFuncAttributeMaxDynamicSharedMemorySize, LDS_BYTES);
        (void)hipOccupancyMaxActiveBlocksPerMultiprocessor(&per_cu, (const void*)hybrid_fwd, 512, LDS_BYTES);
        if (per_cu < 1) per_cu = 1;
        grid = cus * per_cu;
        (void)hipGetLastError();
    }
    if (grid < 0) return;
    Params p{};
    for (int i = 0; i < 22; ++i) p.in[i] = (const float*)d_in[i];
    p.out = (float*)d_out; p.ws = (unsigned char*)d_ws;
    if (hipMemsetAsync(d_ws, 0, 16384, stream) != hipSuccess) { fprintf(stderr, "kernel_launch: hipMemsetAsync of the barrier words failed\n"); return; }
    void* args[] = {&p};
    hipError_t e = hipLaunchCooperativeKernel((const void*)hybrid_fwd, dim3(grid), dim3(512), args, LDS_BYTES, stream);
    if (e != hipSuccess) fprintf(stderr, "cooperative launch failed: %s (grid %d)\n", hipGetErrorString(e), grid);
}
```

```cpp
#include <hip/hip_runtime.h>
#include <hip/hip_cooperative_groups.h>
#include <cstdio>
#include <cstdint>
namespace cg = cooperative_groups;
namespace pg8 {
#define PG8_LAS __attribute__((address_space(3)))
typedef unsigned short bf16_t;
typedef short bf16x8 __attribute__((ext_vector_type(8)));
typedef float f32x4 __attribute__((ext_vector_type(4)));
typedef unsigned u32x4 __attribute__((ext_vector_type(4)));
constexpr int BM = 256, BK = 64, HALF = 128, HTB = HALF * BK * 2  , STAGE_BYTES = 8 * HTB, NXCD = 8, WGM = 8;

__host__ __device__ __forceinline__ int lds_byte(int r, int c) { const int st = (r >> 4) * 2 + (c >> 5), rr = r & 15, cc = c & 31, ob = rr * 64 + cc * 2; return st * 1024 + (ob ^ (((ob >> 9) & 1) << 5)); }
__host__ __device__ __forceinline__ void stage_rc(int b, int& R, int& C) { const int st = b / 1024, sb = b % 1024, swz = sb ^ (((sb >> 9) & 1) << 5); R = (st >> 1) * 16 + swz / 64; C = (st & 1) * 32 + (swz % 64) / 2; }
__host__ __device__ __forceinline__ int perm32(int rho) { const int n = rho >> 4, i = rho & 15; return 8 * (i >> 2) + 4 * n + (i & 3); }

struct Unit { int pm, pn; };
struct Gemm { const bf16_t* A; const bf16_t* Bt; int M, N, K; };

struct StaticOrder {
    int nM, nN, nwg, G, c;
    __host__ __device__ void init(int M, int N, int G_, int c_) { nM = M / BM; nN = N / BM; nwg = nM * nN; G = G_; c = c_; }
    __host__ __device__ bool next(int i, Unit& u) const {
        const long L = (long)i * G + c; if (L >= nwg) return false;
        int wgid = (int)L; { const int q = nwg / NXCD, r = nwg % NXCD, xcd = wgid % NXCD, off = wgid / NXCD; wgid = (xcd < r ? xcd * (q + 1) : r * (q + 1) + (xcd - r) * q) + off; }
        const int nig = WGM * nN, gid = wgid / nig, fm = gid * WGM, gsz = (nM - fm) < WGM ? (nM - fm) : WGM;
        u.pm = fm + ((wgid % nig) % gsz); u.pn = (wgid % nig) / gsz; return true;
    }
    __device__ __forceinline__ void a_ready(const Unit&) const {}
    __device__ __forceinline__ void done(const Unit&) const {}
};
__device__ __forceinline__ unsigned cvt_pk_bf16(float lo, float hi) { unsigned r; asm volatile("v_cvt_pk_bf16_f32 %0, %1, %2" : "=v"(r) : "v"(lo), "v"(hi)); return r; }
typedef float f32x2 __attribute__((ext_vector_type(2)));
template <class Epi, class Sched, bool ALIGN_EPI = false, bool SP2 = false>
__device__ __forceinline__ void gemm_phase(PG8_LAS unsigned char* lds, const Gemm g, const Sched& S, const Epi& E) {
    int tid_ = threadIdx.x; asm volatile("" : "+v"(tid_));
    const int tid = tid_, wid = __builtin_amdgcn_readfirstlane(tid >> 6), lane = tid & 63, wr = wid >> 2, wc = wid & 3, fr = lane & 15, fq = lane >> 4;
    const int K = g.K, nt = K / BK;
    unsigned voffA[2], voffB[2];
#pragma unroll
    for (int i = 0; i < 2; ++i) { int R, C; stage_rc(tid * 16 + i * 8192, R, C); const int Rb = Epi::PERM ? ((R & ~31) + perm32(R & 31)) : R;
        voffA[i] = (unsigned)(R * K + C) * 2u; voffB[i] = (unsigned)(Rb * K + C) * 2u; }
    const size_t kstep = (size_t)(BK * 2);
    const size_t hstep = (size_t)HALF * K * 2;
    const size_t tstep = 2 * hstep;
    const unsigned ldsw = (unsigned)wid * 1024u;
    const int aoff = lds_byte(wr * 64 + fr, fq * 8), boff = lds_byte(wc * 32 + fr, fq * 8);
#define PG8_SA(b, h) (((b) * 2 + (h)) * HTB)
#define PG8_SB(b, h) ((4 + (b) * 2 + (h)) * HTB)
#define PG8_STAGE(bufoff, gbase, voff) do { _Pragma("unroll") for (int _i = 0; _i < 2; ++_i) \
        __builtin_amdgcn_global_load_lds((const unsigned*)((const char*)(gbase) + (voff)[_i]), (PG8_LAS unsigned*)(lds + (bufoff) + ldsw + _i * 8192), 16, 0, 0); } while (0)
#define PG8_LDA(dst, b, h) do { _Pragma("unroll") for (int m = 0; m < 4; ++m) _Pragma("unroll") for (int k = 0; k < 2; ++k) dst[m][k] = *(const PG8_LAS bf16x8*)(lds + PG8_SA(b, h) + aoff + m * 2048 + k * 1024); } while (0)
#define PG8_LDB(dst, b, h) do { _Pragma("unroll") for (int n = 0; n < 2; ++n) _Pragma("unroll") for (int k = 0; k < 2; ++k) dst[n][k] = *(const PG8_LAS bf16x8*)(lds + PG8_SB(b, h) + boff + n * 2048 + k * 1024); } while (0)
#define PG8_MMA(ai, bj, At, Bt) do { __builtin_amdgcn_s_setprio(1); _Pragma("unroll") for (int m = 0; m < 4; ++m) _Pragma("unroll") for (int n = 0; n < 2; ++n) _Pragma("unroll") for (int k = 0; k < 2; ++k) \
        acc[ai][bj][m][n] = __builtin_amdgcn_mfma_f32_16x16x32_bf16(Bt[n][k], At[m][k], acc[ai][bj][m][n], 0, 0, 0); __builtin_amdgcn_s_setprio(0); } while (0)
#define PG8_WAIT_V(n) asm volatile("s_waitcnt vmcnt(" #n ")" ::: "memory")
#define PG8_WAIT_L(n) asm volatile("s_waitcnt lgkmcnt(" #n ")" ::: "memory")
#define PG8_BAR __builtin_amdgcn_s_barrier()
#define PG8_SCHED __builtin_amdgcn_sched_barrier(0)
    Unit cur, nxt; int ui = 0;
    if (!S.next(0, cur)) return;
    f32x4 acc[2][2][4][2];
#pragma unroll
    for (int a = 0; a < 2; ++a)
#pragma unroll
        for (int b = 0; b < 2; ++b)
#pragma unroll
            for (int m = 0; m < 4; ++m)
#pragma unroll
                for (int n = 0; n < 2; ++n) acc[a][b][m][n] = (f32x4){0.f, 0.f, 0.f, 0.f};
    bf16x8 At[4][2], B0[2][2], B1[2][2];
    const char* cA = (const char*)g.A + (size_t)cur.pm * tstep; const char* cB = (const char*)g.Bt + (size_t)cur.pn * tstep;
    S.a_ready(cur);
    if constexpr (SP2) {
        PG8_STAGE(PG8_SB(0, 0), cB, voffB); PG8_STAGE(PG8_SB(0, 1), cB + hstep, voffB); PG8_STAGE(PG8_SA(0, 0), cA, voffA); PG8_STAGE(PG8_SA(0, 1), cA + hstep, voffA);
        if (wr == 1) PG8_BAR;
        PG8_WAIT_V(2); PG8_BAR;
        PG8_STAGE(PG8_SB(1, 0), cB + kstep, voffB); PG8_STAGE(PG8_SA(1, 0), cA + kstep, voffA); PG8_STAGE(PG8_SB(1, 1), cB + hstep + kstep, voffB);
        PG8_WAIT_V(6); PG8_BAR;
    } else {
        PG8_STAGE(PG8_SB(0, 0), cB, voffB); PG8_STAGE(PG8_SA(0, 0), cA, voffA); PG8_STAGE(PG8_SB(0, 1), cB + hstep, voffB); PG8_STAGE(PG8_SA(0, 1), cA + hstep, voffA);
        if (wr == 1) PG8_BAR;
        PG8_WAIT_V(4); PG8_BAR;
        PG8_STAGE(PG8_SB(1, 0), cB + kstep, voffB); PG8_STAGE(PG8_SA(1, 0), cA + kstep, voffA); PG8_STAGE(PG8_SB(1, 1), cB + hstep + kstep, voffB);
        PG8_WAIT_V(6); PG8_BAR;
    }
    for (;;) {
        const bool has_next = S.next(ui + 1, nxt);
        const char* nA = has_next ? (const char*)g.A + (size_t)nxt.pm * tstep : cA; const char* nB = has_next ? (const char*)g.Bt + (size_t)nxt.pn * tstep : cB;
        for (int t = 0; t < nt; t += 2) {
            const bool last = (t == nt - 2);
            const char* a1 = cA + (size_t)(t + 1) * kstep;
            const char* a2 = last ? nA : cA + (size_t)(t + 2) * kstep; const char* b2 = last ? nB : cB + (size_t)(t + 2) * kstep;
            const char* a3 = a2 + kstep; const char* b3 = b2 + kstep;
            if (last && has_next) S.a_ready(nxt);
            if constexpr (SP2) {
            PG8_LDB(B0, 0, 0); PG8_LDB(B1, 0, 1); PG8_SCHED; PG8_LDA(At, 0, 0); PG8_STAGE(PG8_SA(1, 1), a1 + hstep, voffA);
            PG8_WAIT_V(8); PG8_WAIT_L(0); PG8_BAR; PG8_MMA(0, 0, At, B0); PG8_MMA(0, 1, At, B1); PG8_BAR; PG8_SCHED;
            PG8_LDA(At, 0, 1); PG8_STAGE(PG8_SB(0, 0), b2, voffB); PG8_STAGE(PG8_SB(0, 1), b2 + hstep, voffB); PG8_STAGE(PG8_SA(0, 0), a2, voffA);
            PG8_WAIT_V(8); PG8_WAIT_L(0); PG8_BAR; PG8_MMA(1, 0, At, B0); PG8_MMA(1, 1, At, B1); PG8_BAR; PG8_SCHED;
            PG8_LDB(B0, 1, 0); PG8_LDB(B1, 1, 1); PG8_SCHED; PG8_LDA(At, 1, 0); PG8_STAGE(PG8_SA(0, 1), a2 + hstep, voffA);
            PG8_WAIT_V(8); PG8_WAIT_L(0); PG8_BAR; PG8_MMA(0, 0, At, B0); PG8_MMA(0, 1, At, B1); PG8_BAR; PG8_SCHED;
            PG8_LDA(At, 1, 1); PG8_STAGE(PG8_SB(1, 0), b3, voffB); PG8_STAGE(PG8_SB(1, 1), b3 + hstep, voffB); PG8_STAGE(PG8_SA(1, 0), a3, voffA);
            PG8_WAIT_V(8); PG8_WAIT_L(0); PG8_BAR; PG8_MMA(1, 0, At, B0); PG8_MMA(1, 1, At, B1); PG8_BAR; PG8_SCHED;
            } else {
            PG8_LDB(B0, 0, 0); PG8_SCHED; PG8_LDA(At, 0, 0); PG8_STAGE(PG8_SA(1, 1), a1 + hstep, voffA);
            PG8_WAIT_L(8); PG8_BAR; PG8_WAIT_L(0); PG8_MMA(0, 0, At, B0); PG8_BAR; PG8_SCHED;
            PG8_LDB(B1, 0, 1); PG8_STAGE(PG8_SB(0, 0), b2, voffB);
            PG8_BAR; PG8_WAIT_L(0); PG8_MMA(0, 1, At, B1); PG8_BAR;
            PG8_LDA(At, 0, 1); PG8_STAGE(PG8_SA(0, 0), a2, voffA);
            PG8_BAR; PG8_WAIT_L(0); PG8_MMA(1, 0, At, B0); PG8_BAR; PG8_SCHED;
            PG8_STAGE(PG8_SB(0, 1), b2 + hstep, voffB);
            PG8_WAIT_V(6); PG8_BAR; PG8_MMA(1, 1, At, B1); PG8_BAR;
            PG8_LDB(B0, 1, 0); PG8_SCHED; PG8_LDA(At, 1, 0); PG8_STAGE(PG8_SA(0, 1), a2 + hstep, voffA);
            PG8_WAIT_L(8); PG8_BAR; PG8_WAIT_L(0); PG8_MMA(0, 0, At, B0); PG8_BAR; PG8_SCHED;
            PG8_LDB(B1, 1, 1); PG8_STAGE(PG8_SB(1, 0), b3, voffB);
            PG8_BAR; PG8_WAIT_L(0); PG8_MMA(0, 1, At, B1); PG8_BAR;
            PG8_LDA(At, 1, 1); PG8_STAGE(PG8_SA(1, 0), a3, voffA);
            PG8_BAR; PG8_WAIT_L(0); PG8_MMA(1, 0, At, B0); PG8_BAR; PG8_SCHED;
            PG8_STAGE(PG8_SB(1, 1), b3 + hstep, voffB);
            PG8_WAIT_V(6); PG8_BAR; PG8_MMA(1, 1, At, B1); PG8_BAR;
            }
        }
        if constexpr (ALIGN_EPI) { if (wr == 0) PG8_BAR; }
        if constexpr (!Epi::AFTER_DRAIN) { E(acc, cur, wr, wc, fr, fq); S.done(cur); }
        if (!has_next) break;
#pragma unroll
        for (int a = 0; a < 2; ++a)
#pragma unroll
            for (int b = 0; b < 2; ++b)
#pragma unroll
                for (int m = 0; m < 4; ++m)
#pragma unroll
                    for (int n = 0; n < 2; ++n) acc[a][b][m][n] = (f32x4){0.f, 0.f, 0.f, 0.f};
        cur = nxt; cA = nA; cB = nB; ++ui;
        if constexpr (ALIGN_EPI) { if (wr == 1) PG8_BAR; }
    }
    PG8_WAIT_V(0);
    if constexpr (!ALIGN_EPI) { if (wr == 0) PG8_BAR; }
    PG8_BAR;
    if constexpr (Epi::AFTER_DRAIN) { E.fused(acc, cur, wr, wc, fr, fq, lds, wid, lane); S.done(cur); }
#undef PG8_SA
#undef PG8_SB
#undef PG8_STAGE
#undef PG8_LDA
#undef PG8_LDB
#undef PG8_MMA
#undef PG8_WAIT_V
#undef PG8_WAIT_L
#undef PG8_BAR
#undef PG8_SCHED
}
}
#define PG8_SP2 true
#define PG8_ALIGN true
#define GAS __attribute__((address_space(1)))
#define LAS __attribute__((address_space(3)))
#define CAS __attribute__((address_space(4)))
typedef unsigned short bf16;
typedef unsigned u32x4 __attribute__((ext_vector_type(4)));
typedef unsigned u32x2 __attribute__((ext_vector_type(2)));
typedef float f32x4 __attribute__((ext_vector_type(4)));
typedef float f32x2 __attribute__((ext_vector_type(2)));
typedef short bf16x8 __attribute__((ext_vector_type(8)));
#define LDS_WAIT() asm volatile("s_waitcnt lgkmcnt(0)" ::: "memory")
#define VM_WAIT() asm volatile("s_waitcnt vmcnt(0)" ::: "memory")

constexpr int BATCH = 16, SEQ = 2048, DM = 1024, DEPTH = 4, T = BATCH * SEQ;
constexpr int NIN = 9472;
constexpr int NA = 3584, LDA = 3360;
constexpr int CHS = 16, NCH = SEQ / CHS;
constexpr int RSTEP = 260;
constexpr int RC = 128, NRC = SEQ / RC;
constexpr size_t MiB = 1u << 20;
constexpr size_t OFF_WA = 2 * MiB, OFF_WB = 9 * MiB, OFF_WG = 13 * MiB, OFF_Wa = 21 * MiB, OFF_Wb = 23 * MiB, OFF_Wo = 25 * MiB;
constexpr size_t OFF_WDEC = 27 * MiB, OFF_WIC = OFF_WDEC + 256 * 1024, OFF_WVR = OFF_WIC + 256 * 1024, OFF_ROT = OFF_WVR + 64 * 1024;
constexpr size_t OFF_VFIRST = 29 * MiB, OFF_VFIN = 93 * MiB, OFF_YS = 157 * MiB, OFF_COEF = 221 * MiB, OFF_XB = 225 * MiB, OFF_RAWA = 289 * MiB;
constexpr size_t OFF_YB = OFF_VFIN;
constexpr size_t OFF_RAWB = OFF_RAWA, OFF_ST = OFF_RAWA + 128 * MiB;
constexpr size_t OFF_SIGA = OFF_RAWA, OFF_SIGB = OFF_RAWA + 64 * MiB, OFF_M1 = OFF_ST, OFF_MG = OFF_XB;
constexpr size_t OFF_COEF2 = 499 * MiB;
constexpr size_t WS_END = 503 * MiB;
static_assert(OFF_ROT + 2 * 2048 * 32 * 4 <= OFF_VFIRST, "small region");
static_assert(32768 + 2 * 2 * CHS * RSTEP * 4 <= 133120, "scan LDS map");
static_assert(OFF_RAWA + (size_t)T * LDA * 2 <= WS_END, "rawA");
constexpr int XB_LDS_OFF = 133120 + 16384 + 6144;
constexpr int LDS_BYTES = XB_LDS_OFF + 64;

enum { I_X = 0, I_NG, I_WIN, I_WVD, I_SP, I_SN, I_WDU, I_DB, I_WIU, I_IB, I_WVU, I_VB, I_KK, I_KA, I_RK, I_LG, I_LB, I_WBA, I_RG, I_WBB, I_WO, I_FG };
struct Params { const float* in[22]; float* out; unsigned char* ws; };
#define KARG() ({ const CAS Params* kp_ = (const CAS Params*)__builtin_amdgcn_kernarg_segment_ptr(); asm volatile("" : "+s"(kp_)); kp_; })

typedef __bf16 bf16x2_t __attribute__((ext_vector_type(2)));
__device__ __forceinline__ unsigned cvtpk(float lo, float hi) { const f32x2 v = {lo, hi}; const bf16x2_t b = __builtin_convertvector(v, bf16x2_t); return __builtin_bit_cast(unsigned, b); }
__device__ __forceinline__ unsigned pk2(float lo, float hi) { return cvtpk(lo, hi); }
__device__ __forceinline__ unsigned f2bf(float f) { return cvtpk(f, 0.f) & 0xffffu; }
__device__ __forceinline__ float bflo(unsigned u) { return __builtin_bit_cast(float, u << 16); }
__device__ __forceinline__ float bfhi(unsigned u) { return __builtin_bit_cast(float, u & 0xffff0000u); }
__device__ __forceinline__ float bf1(bf16 h) { return __builtin_bit_cast(float, (unsigned)h << 16); }
__device__ __forceinline__ void unpack8(u32x4 u, float* o) { o[0] = bflo(u.x); o[1] = bfhi(u.x); o[2] = bflo(u.y); o[3] = bfhi(u.y); o[4] = bflo(u.z); o[5] = bfhi(u.z); o[6] = bflo(u.w); o[7] = bfhi(u.w); }
__device__ __forceinline__ void unpack4(u32x2 u, float* o) { o[0] = bflo(u.x); o[1] = bfhi(u.x); o[2] = bflo(u.y); o[3] = bfhi(u.y); }
__device__ __forceinline__ u32x4 pack8u(const float* f) { u32x4 u; u.x = pk2(f[0], f[1]); u.y = pk2(f[2], f[3]); u.z = pk2(f[4], f[5]); u.w = pk2(f[6], f[7]); return u; }
__device__ __forceinline__ bf16x8 pack8(const float* f) { return __builtin_bit_cast(bf16x8, pack8u(f)); }
__device__ __forceinline__ float sigm(float x) { return __builtin_amdgcn_rcpf(1.0f + __expf(-x)); }
__device__ __forceinline__ float wave_sum(float v) {
#pragma unroll
    for (int o = 1; o < 64; o <<= 1) v += __shfl_xor(v, o);
    return v;
}
#define MFMA16(a, b, c) __builtin_amdgcn_mfma_f32_16x16x32_bf16((a), (b), (c), 0, 0, 0)

__device__ __forceinline__ void tr_item(const float* W, int ldw, int K, bf16* WT, int item, int nblk, LAS float* scr, int lane) {
    const int kb = item / nblk, nb = item % nblk, k0 = 64 * kb, n0 = 32 * nb;
    float wv[32];
#pragma unroll
    for (int i = 0; i < 32; ++i) wv[i] = W[(size_t)(k0 + 2 * i + (lane >> 5)) * ldw + n0 + (lane & 31)];
#pragma unroll
    for (int i = 0; i < 32; ++i) scr[(2 * i + (lane >> 5)) * 33 + (lane & 31)] = wv[i];
    LDS_WAIT(); asm volatile("" ::: "memory");
    const int c = lane & 7;
#pragma unroll
    for (int j = 0; j < 4; ++j) { const int n = (lane >> 3) + 8 * j; const LAS float* s = scr + (8 * c) * 33 + n;
        u32x4 o; o.x = pk2(s[0 * 33], s[1 * 33]); o.y = pk2(s[2 * 33], s[3 * 33]); o.z = pk2(s[4 * 33], s[5 * 33]); o.w = pk2(s[6 * 33], s[7 * 33]);
        *(u32x4*)(WT + (size_t)(n0 + n) * K + k0 + 8 * c) = o; }
    LDS_WAIT(); asm volatile("" ::: "memory");
}

__device__ __forceinline__ void convert_weights(int l, LAS unsigned char* lds, int gw, int NGW, int wave, int lane) {
    asm volatile("" : "+s"(NGW), "+s"(gw));
    asm volatile("" : "+v"(lane));
    const CAS Params* p = KARG(); unsigned char* ws = p->ws;
    LAS float* scr = (LAS float*)(lds + wave * 16384);
    const float* win = p->in[I_WIN] + (size_t)l * DM * NIN;
    bf16* WA = (bf16*)(ws + OFF_WA); bf16* WB = (bf16*)(ws + OFF_WB); bf16* WG = (bf16*)(ws + OFF_WG);
    constexpr int S1 = 16 * 104, S2 = 16 * 64, S3 = 16 * 32, S4 = 16 * 96, S5 = 512, S8 = 16, S10 = 32;
    constexpr int NIT = S1 + S2 + S3 + S4 + 3 * S5 + S8 + 4 * S10;
    for (int it = gw; it < NIT; it += NGW) {
        int r = it;
        if (r < S1) { tr_item(win, NIN, DM, WA, r, 104, scr, lane); continue; } r -= S1;
        if (r < S2) { tr_item(win + 4352, NIN, DM, WB, r, 64, scr, lane); continue; } r -= S2;
        if (r < S3) { tr_item(win + 3328, NIN, DM, WG, r, 32, scr, lane); continue; } r -= S3;
        if (r < S4) { tr_item(win + 6400, NIN, DM, WG + (size_t)1024 * DM, r, 96, scr, lane); continue; } r -= S4;
        if (r < S5) { tr_item(p->in[I_WBA] + (size_t)l * DM * DM, DM, DM, (bf16*)(ws + OFF_Wa), r, 32, scr, lane); continue; } r -= S5;
        if (r < S5) { tr_item(p->in[I_WBB] + (size_t)l * DM * DM, DM, DM, (bf16*)(ws + OFF_Wb), r, 32, scr, lane); continue; } r -= S5;
        if (r < S5) { tr_item(p->in[I_WO] + (size_t)l * DM * DM, DM, DM, (bf16*)(ws + OFF_Wo), r, 32, scr, lane); continue; } r -= S5;
        if (r < S8) { if (l > 0) tr_item(p->in[I_WVD] + (size_t)(l - 1) * DM * 32, 32, DM, WA + (size_t)3328 * DM, r, 1, scr, lane); continue; } r -= S8;
        { const int which = r / S10, rr = r % S10;
          const float* src = (which < 2 ? p->in[I_WDU] : p->in[I_WIU]) + ((size_t)l * 2 + (which & 1)) * 64 * DM;
          bf16* dst = (bf16*)(ws + (which < 2 ? OFF_WDEC : OFF_WIC)) + (size_t)(which & 1) * DM * 64;
          tr_item(src, DM, 64, dst, rr, 32, scr, lane); }
    }
    const int gt = gw * 64 + lane, NGT = NGW * 64;
    if (l == 0) {
        u32x4* z = (u32x4*)(WA + (size_t)3328 * DM); const u32x4 zero = {0u, 0u, 0u, 0u};
        for (int i = gt; i < 256 * DM * 2 / 16; i += NGT) z[i] = zero;
    } else {
        const float* src = p->in[I_WVU] + (size_t)(l - 1) * 32 * DM; bf16* dst = (bf16*)(ws + OFF_WVR);
        for (int i = gt; i < 32 * DM; i += NGT) { const int n = i >> 5, k = i & 31; dst[i] = (bf16)f2bf(src[(size_t)k * DM + n]); }
    }
}

__device__ __forceinline__ void norm_phase(const float* x, const float* gain, bf16* xb, int gw, int NGW, int lane) {
    asm volatile("" : "+s"(NGW), "+s"(gw));
    asm volatile("" : "+v"(lane));
    for (int m0 = gw; m0 < T; m0 += 4 * NGW) {
        f32x4 v[4][4]; float ss[4];
#pragma unroll
        for (int r = 0; r < 4; ++r) { const int m = m0 + r * NGW < T ? m0 + r * NGW : m0; const f32x4* xr = (const f32x4*)(x + (size_t)m * DM) + lane;
#pragma unroll
            for (int j = 0; j < 4; ++j) v[r][j] = xr[64 * j]; }
#pragma unroll
        for (int r = 0; r < 4; ++r) { float q = 0.f;
#pragma unroll
            for (int j = 0; j < 4; ++j) q += (v[r][j].x * v[r][j].x + v[r][j].y * v[r][j].y) + (v[r][j].z * v[r][j].z + v[r][j].w * v[r][j].w);
            ss[r] = q; }
#pragma unroll
        for (int o = 1; o < 64; o <<= 1) {
#pragma unroll
            for (int r = 0; r < 4; ++r) ss[r] += __shfl_xor(ss[r], o); }
#pragma unroll
        for (int r = 0; r < 4; ++r) { const int m = m0 + r * NGW; if (m < T) {
            const float rs = rsqrtf(ss[r] * (1.f / DM) + 1e-6f);
            u32x2* o8 = (u32x2*)(xb + (size_t)m * DM) + lane;
#pragma unroll
            for (int j = 0; j < 4; ++j) { const f32x4 g = ((const f32x4*)gain)[lane + 64 * j]; u32x2 o; o.x = pk2(v[r][j].x * rs * g.x, v[r][j].y * rs * g.y); o.y = pk2(v[r][j].z * rs * g.z, v[r][j].w * rs * g.w); o8[64 * j] = o; } } }
    }
}
__device__ __forceinline__ void final_norm(float* x, const float* gain, int gw, int NGW, int lane) {
    asm volatile("" : "+s"(NGW), "+s"(gw));
    asm volatile("" : "+v"(lane));
    for (int m0 = gw; m0 < T; m0 += 4 * NGW) {
        f32x4 v[4][4]; float ss[4];
#pragma unroll
        for (int r = 0; r < 4; ++r) { const int m = m0 + r * NGW < T ? m0 + r * NGW : m0; const f32x4* xr = (const f32x4*)(x + (size_t)m * DM) + lane;
#pragma unroll
            for (int j = 0; j < 4; ++j) v[r][j] = xr[64 * j]; }
#pragma unroll
        for (int r = 0; r < 4; ++r) { float q = 0.f;
#pragma unroll
            for (int j = 0; j < 4; ++j) q += (v[r][j].x * v[r][j].x + v[r][j].y * v[r][j].y) + (v[r][j].z * v[r][j].z + v[r][j].w * v[r][j].w);
            ss[r] = q; }
#pragma unroll
        for (int o = 1; o < 64; o <<= 1) {
#pragma unroll
            for (int r = 0; r < 4; ++r) ss[r] += __shfl_xor(ss[r], o); }
#pragma unroll
        for (int r = 0; r < 4; ++r) { const int m = m0 + r * NGW; if (m < T) {
            const float rs = rsqrtf(ss[r] * (1.f / DM) + 1e-6f);
            f32x4* xr = (f32x4*)(x + (size_t)m * DM) + lane;
#pragma unroll
            for (int j = 0; j < 4; ++j) { const f32x4 g = ((const f32x4*)gain)[lane + 64 * j]; xr[64 * j] = v[r][j] * rs * g; } } }
    }
}

template <class F> struct EpiGen {
    static constexpr bool PERM = true, AFTER_DRAIN = false;
    F f;
    __device__ __forceinline__ void operator()(const pg8::f32x4 (&acc)[2][2][4][2], const pg8::Unit& u, int wr, int wc, int fr, int fq) const {
        const int row0 = u.pm * 256 + wr * 64 + fr, col0 = u.pn * 256 + wc * 32 + 8 * fq;
#pragma unroll
        for (int ai = 0; ai < 2; ++ai)
#pragma unroll
            for (int m = 0; m < 4; ++m)
#pragma unroll
                for (int bj = 0; bj < 2; ++bj) {
                    float v[8];
#pragma unroll
                    for (int i = 0; i < 4; ++i) { v[i] = acc[ai][bj][m][0][i]; v[4 + i] = acc[ai][bj][m][1][i]; }
                    f(row0 + ai * 128 + m * 16, col0 + bj * 128, v);
                }
    }
};
struct FStoreA { bf16* O; __device__ __forceinline__ void operator()(int row, int col, const float* v) const { if (col < LDA) *(u32x4*)(O + (size_t)row * LDA + col) = pack8u(v); } };
struct FStoreB { bf16* O; __device__ __forceinline__ void operator()(int row, int col, const float* v) const { *(u32x4*)(O + (size_t)row * 2048 + col) = pack8u(v); } };
struct FGates { bf16 *ya, *yb, *sa, *sb;
    __device__ __forceinline__ void operator()(int row, int col, const float* v) const {
        const int reg = col >> 10, c = col & 1023; const size_t off = (size_t)row * DM + c; float o[8];
        if (reg < 2) { bf16* y = reg == 0 ? ya : yb; float yv[8]; unpack8(*(const u32x4*)(y + off), yv);
#pragma unroll
            for (int i = 0; i < 8; ++i) o[i] = yv[i] * v[i] * sigm(v[i]);
            *(u32x4*)(y + off) = pack8u(o);
        } else { bf16* s = reg == 2 ? sa : sb;
#pragma unroll
            for (int i = 0; i < 8; ++i) o[i] = sigm(v[i]);
            *(u32x4*)(s + off) = pack8u(o); }
    } };
struct FGa { const bf16* sg; bf16* m1; __device__ __forceinline__ void operator()(int row, int col, const float* v) const {
        const size_t off = (size_t)row * DM + col; float g[8], o[8]; unpack8(*(const u32x4*)(sg + off), g);
#pragma unroll
        for (int i = 0; i < 8; ++i) o[i] = g[i] * v[i];
        *(u32x4*)(m1 + off) = pack8u(o); } };
struct FGb { const bf16* sg; const bf16* m1; bf16* mg; __device__ __forceinline__ void operator()(int row, int col, const float* v) const {
        const size_t off = (size_t)row * DM + col; float g[8], a[8], o[8]; unpack8(*(const u32x4*)(sg + off), g); unpack8(*(const u32x4*)(m1 + off), a);
#pragma unroll
        for (int i = 0; i < 8; ++i) o[i] = a[i] + g[i] * v[i];
        *(u32x4*)(mg + off) = pack8u(o); } };
struct FGo { const float* xo; float* xn; __device__ __forceinline__ void operator()(int row, int col, const float* v) const {
        const size_t off = (size_t)row * DM + col; const f32x4 a = *(const f32x4*)(xo + off), b = *(const f32x4*)(xo + off + 4);
        f32x4 o0 = {a.x + v[0], a.y + v[1], a.z + v[2], a.w + v[3]}, o1 = {b.x + v[4], b.y + v[5], b.z + v[6], b.w + v[7]};
        *(f32x4*)(xn + off) = o0; *(f32x4*)(xn + off + 4) = o1; } };

template <class F> __device__ __forceinline__ void run_gemm(LAS unsigned char* lds, const bf16* A, const bf16* Bt, int N, const F& f) {
    pg8::Gemm g{A, Bt, T, N, DM}; pg8::StaticOrder S; S.init(T, N, (int)gridDim.x, (int)blockIdx.x);
    EpiGen<F> E{f};
    pg8::gemm_phase<EpiGen<F>, pg8::StaticOrder, PG8_ALIGN, PG8_SP2>(lds, g, S, E);
}
constexpr int CST_OFF = 133120 + 16384;
constexpr int C_CMP = 0, C_CMN = 256;
constexpr int C_RMP = 512, C_RMN = 704;
constexpr int C_DB = 896, C_IB = 1024;
constexpr int C_KK = 1152, C_KA = 1216, C_RK = 1280, C_VB = 1344, C_END = 1408;
__device__ __forceinline__ void prep_consts(int l, int h, LAS float* cst) {
    const CAS Params* p = KARG();
    for (int i = threadIdx.x; i < C_END; i += 512) {
        float v;
        if (i < 512) { const int r = i & 255, type = r >> 7, dir = (r >> 6) & 1, col = r & 63; const int gc = (type ? 3200 : 3072) + 64 * dir + col; v = (i < 256 ? p->in[I_SP] : p->in[I_SN])[(size_t)l * 3328 + gc]; }
        else if (i < 896) { const int r = (i - 512) % 192, which = r >> 6, col = r & 63; v = (i < 704 ? p->in[I_SP] : p->in[I_SN])[(size_t)l * 3328 + which * 1024 + h * 64 + col]; }
        else if (i < 1152) { const int r = (i - 896) & 127, dir = r >> 6, col = r & 63; v = (i < 1024 ? p->in[I_DB] : p->in[I_IB])[((size_t)l * 2 + dir) * DM + h * 64 + col]; }
        else { const int which = (i - 1152) >> 6, col = i & 63; const float* src = which == 0 ? p->in[I_KK] : which == 1 ? p->in[I_KA] : which == 2 ? p->in[I_RK] : p->in[I_VB];
               v = (which == 3 && l == 0) ? 0.f : src[(size_t)(which == 3 ? l - 1 : l) * DM + h * 64 + col]; }
        cst[i] = v;
    }
}
__device__ __forceinline__ f32x2 mixp(unsigned c, unsigned pv, unsigned nv, f32x2 m1, f32x2 m2) {
    const float c0 = bflo(c), c1 = bfhi(c);
    float r0 = __builtin_fmaf(m2.x, bflo(nv) - c0, __builtin_fmaf(m1.x, bflo(pv) - c0, c0)), r1 = __builtin_fmaf(m2.y, bfhi(nv) - c1, __builtin_fmaf(m1.y, bfhi(pv) - c1, c1));
    asm("" : "+v"(r0), "+v"(r1));
    return (f32x2){r0, r1};
}
__device__ __forceinline__ void mix8p(const u32x4 c, const u32x4 pv, const u32x4 nv, const LAS float* mp, const LAS float* mn, float* o) {
    const f32x4 a0 = *(const LAS f32x4*)mp, a1 = *(const LAS f32x4*)(mp + 4), b0 = *(const LAS f32x4*)mn, b1 = *(const LAS f32x4*)(mn + 4);
    const f32x2 r0 = mixp(c.x, pv.x, nv.x, (f32x2){a0.x, a0.y}, (f32x2){b0.x, b0.y}), r1 = mixp(c.y, pv.y, nv.y, (f32x2){a0.z, a0.w}, (f32x2){b0.z, b0.w});
    const f32x2 r2 = mixp(c.z, pv.z, nv.z, (f32x2){a1.x, a1.y}, (f32x2){b1.x, b1.y}), r3 = mixp(c.w, pv.w, nv.w, (f32x2){a1.z, a1.w}, (f32x2){b1.z, b1.w});
    o[0] = r0.x; o[1] = r0.y; o[2] = r1.x; o[3] = r1.y; o[4] = r2.x; o[5] = r2.y; o[6] = r3.x; o[7] = r3.y;
}
__device__ __forceinline__ void mix4p(const u32x2 c, const u32x2 pv, const u32x2 nv, const LAS float* mp, const LAS float* mn, float* o) {
    const f32x4 a0 = *(const LAS f32x4*)mp, b0 = *(const LAS f32x4*)mn;
    const f32x2 r0 = mixp(c.x, pv.x, nv.x, (f32x2){a0.x, a0.y}, (f32x2){b0.x, b0.y}), r1 = mixp(c.y, pv.y, nv.y, (f32x2){a0.z, a0.w}, (f32x2){b0.z, b0.w});
    o[0] = r0.x; o[1] = r0.y; o[2] = r1.x; o[3] = r1.y;
}
#define PREP_COMMON() \
    const CAS Params* p = KARG(); unsigned char* ws = p->ws; \
    asm volatile("" : "+v"(lane));     \
    const int fr = lane & 15, fq = lane >> 4; \
    const int s = fr, t = dir == 0 ? c * CHS + s : SEQ - 1 - c * CHS - s; \
    const size_t row = (size_t)b * SEQ + t; \
    const bf16* rawA = (const bf16*)(ws + OFF_RAWA) + row * LDA; \
    const int dp = t > 0 ? -LDA : 0, dn = t < SEQ - 1 ? LDA : 0;            \
    const bool pz = t > 0, nz = t < SEQ - 1; \
    LAS float* rs_ = rg + s * RSTEP;
#define ZERO_ENDS4(A) do { if (!pz) A[1] = (u32x4){0u, 0u, 0u, 0u}; if (!nz) A[2] = (u32x4){0u, 0u, 0u, 0u}; } while (0)
#define ZERO_ENDS2(A) do { if (!pz) A[1] = (u32x2){0u, 0u}; if (!nz) A[2] = (u32x2){0u, 0u}; } while (0)

__device__ __forceinline__ void prep_x(int l, int b, int h, int dir, int c, LAS float* rg, const LAS float* cst, int lane) {
    PREP_COMMON();
    const bf16* Wd = (const bf16*)(ws + OFF_WDEC) + (size_t)dir * DM * 64; const bf16* Wv = (const bf16*)(ws + OFF_WVR);
    bf16* vfirst = (bf16*)(ws + OFF_VFIRST) + row * DM; bf16* vfin = (bf16*)(ws + OFF_VFIN) + row * DM;
    u32x4 cdr[2][3];
#pragma unroll
    for (int ks = 0; ks < 2; ++ks) { const bf16* q = rawA + 3072 + 64 * dir + 32 * ks + 8 * fq; cdr[ks][0] = *(const u32x4*)q; cdr[ks][1] = *(const u32x4*)(q + dp); cdr[ks][2] = *(const u32x4*)(q + dn); }
    u32x4 bvr = {0u, 0u, 0u, 0u}; if (l > 0) bvr = *(const u32x4*)(rawA + 3328 + 8 * fq);
    u32x4 wdr[4][2], wvr[4]; u32x2 vr_[4][3], vfr[4];
#pragma unroll
    for (int nb = 0; nb < 4; ++nb) { const int chr = h * 64 + nb * 16 + fr;
#pragma unroll
        for (int ks = 0; ks < 2; ++ks) wdr[nb][ks] = *(const u32x4*)(Wd + (size_t)chr * 64 + 32 * ks + 8 * fq);
        wvr[nb] = (u32x4){0u, 0u, 0u, 0u}; if (l > 0) wvr[nb] = *(const u32x4*)(Wv + (size_t)chr * 32 + 8 * fq);
        const int ch = h * 64 + nb * 16 + 4 * fq; const bf16* q = rawA + 2048 + ch;
        vr_[nb][0] = *(const u32x2*)q; vr_[nb][1] = *(const u32x2*)(q + dp); vr_[nb][2] = *(const u32x2*)(q + dn);
        vfr[nb] = (u32x2){0u, 0u}; if (l > 0) vfr[nb] = *(const u32x2*)(vfirst + ch); }
    __builtin_amdgcn_sched_barrier(0);
    bf16x8 bd[2];
#pragma unroll
    for (int ks = 0; ks < 2; ++ks) {
        float o[8]; const int cc = 64 * dir + 32 * ks + 8 * fq;
        ZERO_ENDS4(cdr[ks]);
        mix8p(cdr[ks][0], cdr[ks][1], cdr[ks][2], cst + C_CMP + cc, cst + C_CMN + cc, o);
#pragma unroll
        for (int i = 0; i < 8; ++i) o[i] = 1.0f - 2.0f * __builtin_amdgcn_rcpf(1.0f + __expf(2.0f * o[i]));
        bd[ks] = pack8(o);
    }
    const bf16x8 bv = __builtin_bit_cast(bf16x8, bvr);
#pragma unroll
    for (int nb = 0; nb < 4; ++nb) {
        f32x4 aD = {0.f, 0.f, 0.f, 0.f}, aV = aD;
#pragma unroll
        for (int ks = 0; ks < 2; ++ks) aD = MFMA16(__builtin_bit_cast(bf16x8, wdr[nb][ks]), bd[ks], aD);
        if (l > 0) aV = MFMA16(__builtin_bit_cast(bf16x8, wvr[nb]), bv, aV);
        const int co = nb * 16 + 4 * fq, ch = h * 64 + co;
        float vv[4];
        ZERO_ENDS2(vr_[nb]);
        mix4p(vr_[nb][0], vr_[nb][1], vr_[nb][2], cst + C_RMP + 128 + co, cst + C_RMN + 128 + co, vv);
        const f32x4 dbias = *(const LAS f32x4*)(cst + C_DB + 64 * dir + co);
        if (l > 0) {
            float vf[4]; unpack4(vfr[nb], vf);
            const f32x4 vbias = *(const LAS f32x4*)(cst + C_VB + co);
#pragma unroll
            for (int i = 0; i < 4; ++i) { const float g = sigm(vbias[i] + aV[i]); vv[i] = vv[i] + (vf[i] - vv[i]) * g; }
        }
        if (dir == 0) { u32x2 o; o.x = pk2(vv[0], vv[1]); o.y = pk2(vv[2], vv[3]); *(u32x2*)((l == 0 ? vfirst : vfin) + ch) = o; }
        f32x4 vw, vvv;
#pragma unroll
        for (int i = 0; i < 4; ++i) { vw[i] = __expf(-0.60653066f * sigm(dbias[i] + aD[i])); vvv[i] = vv[i]; }
        *(LAS f32x4*)(rs_ + co) = vw; *(LAS f32x4*)(rs_ + 64 + co) = vvv;
    }
}
__device__ __forceinline__ void prep_y(int l, int b, int h, int dir, int c, LAS float* rg, const LAS float* cst, int lane) {
    PREP_COMMON();
    const bf16* Wi = (const bf16*)(ws + OFF_WIC) + (size_t)dir * DM * 64;
    u32x4 cir[2][3];
#pragma unroll
    for (int ks = 0; ks < 2; ++ks) { const bf16* q = rawA + 3200 + 64 * dir + 32 * ks + 8 * fq; cir[ks][0] = *(const u32x4*)q; cir[ks][1] = *(const u32x4*)(q + dp); cir[ks][2] = *(const u32x4*)(q + dn); }
    u32x4 wir[4][2]; u32x2 kr[4][3], rr_[4][3];
#pragma unroll
    for (int nb = 0; nb < 4; ++nb) { const int chr = h * 64 + nb * 16 + fr;
#pragma unroll
        for (int ks = 0; ks < 2; ++ks) wir[nb][ks] = *(const u32x4*)(Wi + (size_t)chr * 64 + 32 * ks + 8 * fq);
        const bf16* q = rawA + h * 64 + nb * 16 + 4 * fq;
        rr_[nb][0] = *(const u32x2*)q; rr_[nb][1] = *(const u32x2*)(q + dp); rr_[nb][2] = *(const u32x2*)(q + dn);
        kr[nb][0] = *(const u32x2*)(q + 1024); kr[nb][1] = *(const u32x2*)(q + 1024 + dp); kr[nb][2] = *(const u32x2*)(q + 1024 + dn); }
    __builtin_amdgcn_sched_barrier(0);
    bf16x8 bi[2];
#pragma unroll
    for (int ks = 0; ks < 2; ++ks) {
        float o[8]; const int cc = 128 + 64 * dir + 32 * ks + 8 * fq;
        ZERO_ENDS4(cir[ks]);
        mix8p(cir[ks][0], cir[ks][1], cir[ks][2], cst + C_CMP + cc, cst + C_CMN + cc, o);
        bi[ks] = pack8(o);
    }
    float kk[16]; float ss = 0.f;
#pragma unroll
    for (int nb = 0; nb < 4; ++nb) {
        const int co = nb * 16 + 4 * fq;
        ZERO_ENDS2(kr[nb]);
        mix4p(kr[nb][0], kr[nb][1], kr[nb][2], cst + C_RMP + 64 + co, cst + C_RMN + 64 + co, kk + 4 * nb);
        const f32x4 kkw = *(const LAS f32x4*)(cst + C_KK + co);
#pragma unroll
        for (int i = 0; i < 4; ++i) { const float kr_ = kk[4 * nb + i] * kkw[i]; ss += kr_ * kr_; }
    }
    ss += __shfl_xor(ss, 16); ss += __shfl_xor(ss, 32);
    const float nrm = rsqrtf(ss + 1e-12f);
    float cs = 0.f;
#pragma unroll
    for (int nb = 0; nb < 4; ++nb) {
        f32x4 aI = {0.f, 0.f, 0.f, 0.f};
#pragma unroll
        for (int ks = 0; ks < 2; ++ks) aI = MFMA16(__builtin_bit_cast(bf16x8, wir[nb][ks]), bi[ks], aI);
        const int co = nb * 16 + 4 * fq;
        float rr[4];
        ZERO_ENDS2(rr_[nb]);
        mix4p(rr_[nb][0], rr_[nb][1], rr_[nb][2], cst + C_RMP + co, cst + C_RMN + co, rr);
        const f32x4 ibias = *(const LAS f32x4*)(cst + C_IB + 64 * dir + co);
        const f32x4 kkw = *(const LAS f32x4*)(cst + C_KK + co), kaw = *(const LAS f32x4*)(cst + C_KA + co), rkw = *(const LAS f32x4*)(cst + C_RK + co);
        f32x4 va, vb, vkd, vr;
#pragma unroll
        for (int i = 0; i < 4; ++i) {
            const float al = sigm(ibias[i] + aI[i]);
            const float kraw = kk[4 * nb + i];
            const float kn = kraw * kkw[i] * nrm;
            const float kd = kraw * (1.0f + (al - 1.0f) * kaw[i]);
            va[i] = -kn; vb[i] = kn * al; vkd[i] = kd; vr[i] = rr[i];
            cs += rr[i] * kd * rkw[i];
        }
        *(LAS u32x4*)(rs_ + 128 + co) = (u32x4){cvtpk(0.25f * vb[0], 0.25f * vkd[0]), cvtpk(0.25f * vb[1], 0.25f * vkd[1]), cvtpk(0.25f * vb[2], 0.25f * vkd[2]), cvtpk(0.25f * vb[3], 0.25f * vkd[3])};
        *(LAS u32x2*)(rs_ + 192 + (co >> 1)) = (u32x2){cvtpk(va[0], va[1]), cvtpk(va[2], va[3])};
        *(LAS u32x2*)(rs_ + 224 + (co >> 1)) = (u32x2){cvtpk(vr[0], vr[1]), cvtpk(vr[2], vr[3])};
    }
    cs += __shfl_xor(cs, 16); cs += __shfl_xor(cs, 32);
    if (fq == 0) ((float*)(ws + OFF_COEF))[((size_t)dir * T + row) * 16 + h] = cs;
}
#define PREP_ROLE(jw, cc, slot) do { if (((jw) >> 1) == 0) prep_x(l, b, h, (jw) & 1, (cc), ring + (size_t)((slot) * 2 + ((jw) & 1)) * CHS * RSTEP, cst, lane); \
                                     else prep_y(l, b, h, (jw) & 1, (cc), ring + (size_t)((slot) * 2 + ((jw) & 1)) * CHS * RSTEP, cst, lane); } while (0)

#define SCHEDB() __builtin_amdgcn_sched_barrier(0)
__device__ __forceinline__ void swap16(float& a, float& b) { const auto r = __builtin_amdgcn_permlane16_swap(__builtin_bit_cast(unsigned, a), __builtin_bit_cast(unsigned, b), false, false); a = __builtin_bit_cast(float, (unsigned)r[0]); b = __builtin_bit_cast(float, (unsigned)r[1]); }
__device__ __forceinline__ void swap32(float& a, float& b) { const auto r = __builtin_amdgcn_permlane32_swap(__builtin_bit_cast(unsigned, a), __builtin_bit_cast(unsigned, b), false, false); a = __builtin_bit_cast(float, (unsigned)r[0]); b = __builtin_bit_cast(float, (unsigned)r[1]); }
__device__ __forceinline__ float scatter4(float p0, float p1) { swap16(p0, p1); float z = p0 + p1, z2 = z; swap32(z, z2); return z + z2; }
#define SCAN_DOTS(AH0, AH1, D0, D1) do { \
        const u32x4 b00 = {cvtpk(c[0][0].x, c[0][0].y), cvtpk(c[0][0].z, c[0][0].w), cvtpk(c[1][0].x, c[1][0].y), cvtpk(c[1][0].z, c[1][0].w)}; \
        const u32x4 b01 = {cvtpk(c[2][0].x, c[2][0].y), cvtpk(c[2][0].z, c[2][0].w), cvtpk(c[3][0].x, c[3][0].y), cvtpk(c[3][0].z, c[3][0].w)}; \
        const u32x4 b10 = {cvtpk(c[0][1].x, c[0][1].y), cvtpk(c[0][1].z, c[0][1].w), cvtpk(c[1][1].x, c[1][1].y), cvtpk(c[1][1].z, c[1][1].w)}; \
        const u32x4 b11 = {cvtpk(c[2][1].x, c[2][1].y), cvtpk(c[2][1].z, c[2][1].w), cvtpk(c[3][1].x, c[3][1].y), cvtpk(c[3][1].z, c[3][1].w)}; \
        D0 = MFMA16(__builtin_bit_cast(bf16x8, AH0), __builtin_bit_cast(bf16x8, b00), ((f32x4){0.f, 0.f, 0.f, 0.f})); D0 = MFMA16(__builtin_bit_cast(bf16x8, AH1), __builtin_bit_cast(bf16x8, b01), D0); \
        D1 = MFMA16(__builtin_bit_cast(bf16x8, AH0), __builtin_bit_cast(bf16x8, b10), ((f32x4){0.f, 0.f, 0.f, 0.f})); D1 = MFMA16(__builtin_bit_cast(bf16x8, AH1), __builtin_bit_cast(bf16x8, b11), D1); } while (0)
#define SCAN_LD_AV(AH0, AH1, P) do { const u32x2 q0 = *(const LAS u32x2*)((P) + 0), q1 = *(const LAS u32x2*)((P) + 8), q2 = *(const LAS u32x2*)((P) + 16), q3 = *(const LAS u32x2*)((P) + 24); \
        AH0 = (u32x4){q0.x, q0.y, q1.x, q1.y}; AH1 = (u32x4){q2.x, q2.y, q3.x, q3.y}; } while (0)
#define SCAN_STEP(S_, CW, CBK, NW, NBK) do { \
        const int sn = (S_) + 1 < CHS ? (S_) + 1 : (S_); const LAS float* nstep = sl + sn * RSTEP; \
        const LAS float* avp = (asel ? nstep + 192 : sl + (S_) * RSTEP + 224) + 2 * mg;        \
        u32x4 ah0, ah1; SCAN_LD_AV(ah0, ah1, avp); \
        _Pragma("unroll") for (int kt = 0; kt < 4; ++kt) { NW[kt] = *(const LAS f32x4*)(nstep + 16 * kt + 4 * mg); NBK[kt] = ((const LAS unsigned*)nstep)[128 + 16 * kt + v16]; } \
        const float vn0 = vb[sn * RSTEP], vn1 = vb[sn * RSTEP + 16]; \
        SCHEDB(); \
        { bx0.x = cvtpk(x0, v0); bx1.x = cvtpk(x1, v1);     \
        _Pragma("unroll") for (int kt = 0; kt < 4; ++kt) { \
            at.x = CBK[kt]; \
            const f32x4 i0 = MFMA16(__builtin_bit_cast(bf16x8, at), __builtin_bit_cast(bf16x8, bx0), ((f32x4){0.f, 0.f, 0.f, 0.f})); \
            const f32x4 i1 = MFMA16(__builtin_bit_cast(bf16x8, at), __builtin_bit_cast(bf16x8, bx1), ((f32x4){0.f, 0.f, 0.f, 0.f})); \
            _Pragma("unroll") for (int i = 0; i < 4; ++i) { float r0 = __builtin_fmaf(c[kt][0][i], CW[kt][i], i0[i]), r1 = __builtin_fmaf(c[kt][1][i], CW[kt][i], i1[i]); \
                asm("" : "+v"(r0), "+v"(r1));     \
                c[kt][0][i] = r0; c[kt][1][i] = r1; } } } \
        SCHEDB(); \
        { f32x4 d0, d1; SCAN_DOTS(ah0, ah1, d0, d1); \
        x0 = d0[1]; x1 = d1[1]; \
        if (lane < 32) ybuf[(S_) * 32 + lane] = mg == 0 ? d0[0] : d1[0];     } \
        v0 = vn0; v1 = vn1; \
        SCHEDB(); } while (0)
__device__ __forceinline__ void scan_chunk(f32x4 (&c)[4][2], const LAS float* sl  , int rh, LAS float* ybuf  , int lane) {
    const int mg = lane >> 4, v16 = lane & 15;
    const bool asel = (lane & 3) == 1;
    const LAS float* vb = sl + 64 + 32 * rh + v16;
    f32x4 wA[4], wB[4]; unsigned bkA[4], bkB[4];
    u32x4 at = {0u, 0u, 0u, 0u}, bx0 = {0u, 0u, 0u, 0u}, bx1 = {0u, 0u, 0u, 0u};
    float x0, x1;
    {
        u32x4 ah0, ah1; SCAN_LD_AV(ah0, ah1, sl + 192 + 2 * mg);
#pragma unroll
        for (int kt = 0; kt < 4; ++kt) { wA[kt] = *(const LAS f32x4*)(sl + 16 * kt + 4 * mg); bkA[kt] = ((const LAS unsigned*)sl)[128 + 16 * kt + v16]; }
        f32x4 d0, d1; SCAN_DOTS(ah0, ah1, d0, d1);
        x0 = asel ? d0[1] : d0[0]; x1 = asel ? d1[1] : d1[0];
    }
    float v0 = vb[0], v1 = vb[16];
#pragma unroll 1
    for (int s = 0; s < CHS; s += 2) {
        SCAN_STEP(s, wA, bkA, wB, bkB);
        SCAN_STEP(s + 1, wB, bkB, wA, bkA);
    }
}

#define Y_T(dir_, cc, s) ((dir_) == 0 ? (cc) * CHS + (s) : SEQ - 1 - (cc) * CHS - (s))
__device__ __forceinline__ void yflush_issue(unsigned (&yo)[4], const bf16* yb2  , int dir, int cc, int lane) {
    const int rg = lane >> 4;
    if (cc >= NCH / 2) {
#pragma unroll
        for (int i = 0; i < 4; ++i) yo[i] = *(const unsigned*)(yb2 + (size_t)Y_T(dir, cc, 4 * i + rg) * DM);
    } else {
#pragma unroll
        for (int i = 0; i < 4; ++i) yo[i] = 0u;
    }
}
__device__ __forceinline__ void yflush_finish(const unsigned (&yo)[4], bf16* yb2, const LAS float* ybuf  , int dir, int cc, int lane) {
    const int rg = lane >> 4, cp = lane & 15;
#pragma unroll
    for (int i = 0; i < 4; ++i) { const int s = 4 * i + rg; const f32x2 yv = *(const LAS f32x2*)(ybuf + s * 32 + 2 * cp);
        *(unsigned*)(yb2 + (size_t)Y_T(dir, cc, s) * DM) = pk2(yv.x + bflo(yo[i]), yv.y + bfhi(yo[i])); }
}

__device__ __forceinline__ void scan_phase(int l, LAS unsigned char* lds, int wave, int lane) {
    asm volatile("" : "+v"(lane));
    unsigned char* ws = KARG()->ws;
    LAS float* ring = (LAS float*)(lds + 32768);
    for (int bh = blockIdx.x; bh < BATCH * 16; bh += gridDim.x) {
        const int b = bh >> 4, h = bh & 15;
        LAS f32x4* sts = (LAS f32x4*)lds + (wave & 3) * 512 + lane;
        LAS float* cst = (LAS float*)(lds + CST_OFF);
        LAS float* ybw = (LAS float*)(lds + 133120) + (wave & 3) * 2 * CHS * 32;
        const int dirw = wave & 1, rhw = (wave >> 1) & 1;
        bf16* yb2 = (bf16*)(ws + OFF_YS) + (size_t)b * SEQ * DM + h * 64 + 32 * rhw + 2 * (lane & 15);
        prep_consts(l, h, cst);
        LDS_WAIT(); __syncthreads();
        f32x4 st[4][2];
#pragma unroll
        for (int k = 0; k < 8; ++k) st[k >> 1][k & 1] = (f32x4){0.f, 0.f, 0.f, 0.f};
        if (wave >= 4) PREP_ROLE(wave - 4, 0, 0);
        LDS_WAIT(); __syncthreads();
#pragma unroll 1
        for (int c = 0; c < NCH; ++c) {
            if (wave < 4) {
                scan_chunk(st, ring + (size_t)((c & 1) * 2 + dirw) * CHS * RSTEP, rhw, ybw + (c & 1) * CHS * 32, lane);
            } else {
                unsigned yo[4];
                if (c > 0) yflush_issue(yo, yb2, dirw, c - 1, lane);
                if (c + 1 < NCH) PREP_ROLE(wave - 4, c + 1, (c + 1) & 1);
                if (c > 0) yflush_finish(yo, yb2, ybw + ((c - 1) & 1) * CHS * 32, dirw, c - 1, lane);
            }
            if (c == NCH / 2) VM_WAIT(); else asm volatile("s_waitcnt vmcnt(4)" ::: "memory");
            LDS_WAIT(); __syncthreads();
        }
        if (wave >= 4) { unsigned yo[4]; yflush_issue(yo, yb2, dirw, NCH - 1, lane); yflush_finish(yo, yb2, ybw + ((NCH - 1) & 1) * CHS * 32, dirw, NCH - 1, lane); }
        VM_WAIT(); __syncthreads();
    }
}

__device__ __forceinline__ void postscan_phase(int l, int gw, int NGW, int lane) {
    asm volatile("" : "+s"(NGW), "+s"(gw));
    asm volatile("" : "+v"(lane));
    const CAS Params* p = KARG(); unsigned char* ws = p->ws;
    const bf16* vcur = (const bf16*)(ws + (l == 0 ? OFF_VFIRST : OFF_VFIN));
    const float* coef = (const float*)(ws + OFF_COEF);
    const int ch = 16 * lane, hd = lane >> 2;
    f32x4 g4[4], b4[4];
#pragma unroll
    for (int i = 0; i < 4; ++i) { g4[i] = *(const f32x4*)(p->in[I_LG] + (size_t)l * DM + ch + 4 * i); b4[i] = *(const f32x4*)(p->in[I_LB] + (size_t)l * DM + ch + 4 * i); }
    for (int m0 = gw; m0 < T; m0 += 2 * NGW) {
        u32x4 yr[2][2], vr[2][2]; float cf[2];
#pragma unroll
        for (int r = 0; r < 2; ++r) { const int m = m0 + r * NGW < T ? m0 + r * NGW : m0;
            const bf16* yp = (const bf16*)(ws + OFF_YS) + (size_t)m * DM + ch; const bf16* vp = vcur + (size_t)m * DM + ch;
            yr[r][0] = *(const u32x4*)yp; yr[r][1] = *(const u32x4*)(yp + 8); vr[r][0] = *(const u32x4*)vp; vr[r][1] = *(const u32x4*)(vp + 8);
            cf[r] = coef[(size_t)m * 16 + hd] + coef[((size_t)T + m) * 16 + hd]; }
#pragma unroll
        for (int r = 0; r < 2; ++r) { const int m = m0 + r * NGW; if (m < T) {
            float y[16], v[16];
            unpack8(yr[r][0], y); unpack8(yr[r][1], y + 8); unpack8(vr[r][0], v); unpack8(vr[r][1], v + 8);
            float sm = 0.f;
#pragma unroll
            for (int i = 0; i < 16; ++i) sm += y[i];
            sm += __shfl_xor(sm, 1); sm += __shfl_xor(sm, 2);
            const float mean = sm * (1.f / 64.f); float q = 0.f;
#pragma unroll
            for (int i = 0; i < 16; ++i) { y[i] -= mean; q += y[i] * y[i]; }
            q += __shfl_xor(q, 1); q += __shfl_xor(q, 2);
            const float rstd = rsqrtf(q * (1.f / 64.f) + 64e-5f);
            float o[16];
#pragma unroll
            for (int i = 0; i < 16; i += 4)
#pragma unroll
                for (int j = 0; j < 4; ++j) o[i + j] = y[i + j] * rstd * g4[i >> 2][j] + b4[i >> 2][j] + cf[r] * v[i + j];
            bf16* yp = (bf16*)(ws + OFF_YS) + (size_t)m * DM + ch;
            *(u32x4*)yp = pack8u(o); *(u32x4*)(yp + 8) = pack8u(o + 8); } }
    }
}

__device__ __forceinline__ float ret_log2g(int h) { const float e = exp2f(-5.0f - (float)h); return -1.4426950408889634f * (e + e * e * (0.5f + e * (0.33333333f + e * 0.25f))); }
constexpr int KP = 136;
constexpr int QP = 72;
__device__ __forceinline__ void stage_vt(const bf16* rawB, int b, int h, int j, LAS bf16* Vt, int tid) {
    const int m = tid >> 2, part = tid & 3;
    const bf16* src = rawB + ((size_t)b * SEQ + j * RC + m) * 2048 + 1024 + h * 128 + 32 * part;
#pragma unroll
    for (int q = 0; q < 4; ++q) { float f[8]; const u32x4 u = *(const u32x4*)(src + 8 * q);
        const unsigned w[4] = {u.x, u.y, u.z, u.w};
#pragma unroll
        for (int i = 0; i < 4; ++i) { Vt[(32 * part + 8 * q + 2 * i) * KP + m] = (bf16)(w[i] & 0xffffu); Vt[(32 * part + 8 * q + 2 * i + 1) * KP + m] = (bf16)(w[i] >> 16); }
        (void)f; }
}
__device__ __forceinline__ void rot8(const bf16* src, const float* rot, int pos, int part, float scale, float* o1, float* o2) {
    float x1[8], x2[8]; unpack8(*(const u32x4*)(src + 8 * part), x1); unpack8(*(const u32x4*)(src + 32 + 8 * part), x2);
    const float* cs = rot + (size_t)pos * 32 + 8 * part; const float* sn = rot + (size_t)2048 * 32 + (size_t)pos * 32 + 8 * part;
    const f32x4 c0 = *(const f32x4*)cs, c1 = *(const f32x4*)(cs + 4), s0 = *(const f32x4*)sn, s1 = *(const f32x4*)(sn + 4);
    const float cv[8] = {c0.x, c0.y, c0.z, c0.w, c1.x, c1.y, c1.z, c1.w}, sv[8] = {s0.x, s0.y, s0.z, s0.w, s1.x, s1.y, s1.z, s1.w};
#pragma unroll
    for (int i = 0; i < 8; ++i) { o1[i] = (x1[i] * cv[i] - x2[i] * sv[i]) * scale; o2[i] = (x1[i] * sv[i] + x2[i] * cv[i]) * scale; }
}
__device__ __forceinline__ void ret_states_phase(LAS unsigned char* lds, int wave, int lane_) {
    int tid = threadIdx.x; asm volatile("" : "+v"(tid)); const int lane = tid & 63;
    const CAS Params* p = KARG(); unsigned char* ws = p->ws; const int fr = lane & 15, fq = lane >> 4;
    const bf16* rawB = (const bf16*)(ws + OFF_RAWB); const float* rot = (const float*)(ws + OFF_ROT);
    LAS bf16* Kt = (LAS bf16*)lds; LAS bf16* Vt = (LAS bf16*)(lds + 64 * KP * 2);
    const int m = tid >> 2, part = tid & 3;
    for (int it = blockIdx.x; it < BATCH * 8 * 2; it += gridDim.x) {
        const int dir = it & 1, bh = it >> 1, b = bh >> 3, h = bh & 7;
        const float l2g = ret_log2g(h), dC = exp2f(l2g * (float)RC);
        const float z = exp2f(l2g * (float)(dir == 0 ? RC - 1 - m : m));
        f32x4 acc[4];
#pragma unroll
        for (int nb = 0; nb < 4; ++nb) acc[nb] = (f32x4){0.f, 0.f, 0.f, 0.f};
        u32x4 kx1, kx2, vraw[4]; f32x4 c0, c1, s0, s1;
#define R1_LOAD(J_) do { const int pos_ = (J_) * RC + m; const bf16* row_ = rawB + ((size_t)b * SEQ + pos_) * 2048; \
            kx1 = *(const u32x4*)(row_ + 512 + h * 64 + 8 * part); kx2 = *(const u32x4*)(row_ + 512 + h * 64 + 32 + 8 * part); \
            _Pragma("unroll") for (int q = 0; q < 4; ++q) vraw[q] = *(const u32x4*)(row_ + 1024 + h * 128 + 32 * part + 8 * q); \
            const float* cs_ = rot + (size_t)pos_ * 32 + 8 * part; const float* sn_ = cs_ + (size_t)2048 * 32; \
            c0 = *(const f32x4*)cs_; c1 = *(const f32x4*)(cs_ + 4); s0 = *(const f32x4*)sn_; s1 = *(const f32x4*)(sn_ + 4); } while (0)
        R1_LOAD(dir == 0 ? 0 : NRC - 1);
#pragma unroll 1
        for (int jj = 0; jj < NRC; ++jj) {
            const int j = dir == 0 ? jj : NRC - 1 - jj;
            bf16* so = (bf16*)(ws + OFF_ST) + ((size_t)(bh * NRC + j) * 2 + dir) * 8192;
#pragma unroll
            for (int nb = 0; nb < 4; ++nb)
#pragma unroll
                for (int i = 0; i < 4; ++i) { so[(16 * wave + 4 * fq + i) * 64 + nb * 16 + fr] = (bf16)f2bf(acc[nb][i]); acc[nb][i] *= dC; }
            {
                float x1[8], x2[8]; unpack8(kx1, x1); unpack8(kx2, x2);
                const float cv[8] = {c0.x, c0.y, c0.z, c0.w, c1.x, c1.y, c1.z, c1.w}, sv[8] = {s0.x, s0.y, s0.z, s0.w, s1.x, s1.y, s1.z, s1.w};
#pragma unroll
                for (int i = 0; i < 8; ++i) { Kt[(8 * part + i) * KP + m] = (bf16)f2bf((x1[i] * cv[i] - x2[i] * sv[i]) * z); Kt[(32 + 8 * part + i) * KP + m] = (bf16)f2bf((x1[i] * sv[i] + x2[i] * cv[i]) * z); }
#pragma unroll
                for (int q = 0; q < 4; ++q) { const unsigned w[4] = {vraw[q].x, vraw[q].y, vraw[q].z, vraw[q].w};
#pragma unroll
                    for (int i = 0; i < 4; ++i) { Vt[(32 * part + 8 * q + 2 * i) * KP + m] = (bf16)(w[i] & 0xffffu); Vt[(32 * part + 8 * q + 2 * i + 1) * KP + m] = (bf16)(w[i] >> 16); } }
            }
            LDS_WAIT(); __syncthreads();
            if (jj + 1 < NRC) R1_LOAD(dir == 0 ? jj + 1 : NRC - 2 - jj);
#pragma unroll
            for (int ks = 0; ks < 4; ++ks) {
                const bf16x8 av = *(const LAS bf16x8*)(Vt + (16 * wave + fr) * KP + 32 * ks + 8 * fq);
#pragma unroll
                for (int nb = 0; nb < 4; ++nb) { const bf16x8 bk = *(const LAS bf16x8*)(Kt + (nb * 16 + fr) * KP + 32 * ks + 8 * fq); acc[nb] = MFMA16(av, bk, acc[nb]); }
            }
            LDS_WAIT(); __syncthreads();
        }
#undef R1_LOAD
    }
}
__device__ __forceinline__ void ret_out_phase(int l, LAS unsigned char* lds, int wave, int lane_) {
    int tid = threadIdx.x; asm volatile("" : "+v"(tid)); const int lane = tid & 63;
    const CAS Params* p = KARG(); unsigned char* ws = p->ws; const int fr = lane & 15, fq = lane >> 4;
    const bf16* rawB = (const bf16*)(ws + OFF_RAWB); const float* rot = (const float*)(ws + OFF_ROT);
    LAS bf16* Qs = (LAS bf16*)lds; LAS bf16* Ks = (LAS bf16*)(lds + 128 * QP * 2); LAS bf16* Vt = (LAS bf16*)(lds + 2 * 128 * QP * 2); LAS bf16* Pw = (LAS bf16*)(lds + 2 * 128 * QP * 2 + 128 * KP * 2) + wave * 16 * KP;
    for (int it = blockIdx.x; it < BATCH * 8 * NRC; it += gridDim.x) {
        const int j = it % NRC, bh = it / NRC, b = bh >> 3, h = bh & 7;
        const float l2g = ret_log2g(h);
        const __amdgpu_buffer_rsrc_t strs = __builtin_amdgcn_make_buffer_rsrc((void*)(ws + OFF_ST), 0, 0x7fffffff, 0x00027000);
        const unsigned sfo = (unsigned)(((bh * NRC + j) * 2 + 0) * 8192 * 2);
        u32x4 sfv[4][2], sbv[4][2];
#define RET_LD_STATES(g) do { _Pragma("unroll") for (int o4 = 0; o4 < 4; ++o4) _Pragma("unroll") for (int ks = 0; ks < 2; ++ks) { \
            const unsigned eo = sfo + (unsigned)((((4 * (g) + o4) * 16 + fr) * 64 + 32 * ks + 8 * fq) * 2); \
            sfv[o4][ks] = __builtin_amdgcn_raw_buffer_load_b128(strs, eo, 0, 0x11); sbv[o4][ks] = __builtin_amdgcn_raw_buffer_load_b128(strs, eo + 16384u, 0, 0x11); } } while (0)
        RET_LD_STATES(0);
        {
            const int m = tid >> 2, part = tid & 3; const int pos = j * RC + m;
            const bf16* src = rawB + ((size_t)b * SEQ + pos) * 2048 + h * 64;
            float o1[8], o2[8];
            rot8(src, rot, pos, part, 0.125f, o1, o2);
            *(LAS u32x4*)(Qs + m * QP + 8 * part) = pack8u(o1); *(LAS u32x4*)(Qs + m * QP + 32 + 8 * part) = pack8u(o2);
            rot8(src + 512, rot, pos, part, 1.0f, o1, o2);
            *(LAS u32x4*)(Ks + m * QP + 8 * part) = pack8u(o1); *(LAS u32x4*)(Ks + m * QP + 32 + 8 * part) = pack8u(o2);
            stage_vt(rawB, b, h, j, Vt, tid);
        }
        LDS_WAIT(); __syncthreads();
        bf16x8 aq[2];
#pragma unroll
        for (int ks = 0; ks < 2; ++ks) aq[ks] = *(const LAS bf16x8*)(Qs + (16 * wave + fr) * QP + 32 * ks + 8 * fq);
#pragma unroll
        for (int nb = 0; nb < 8; ++nb) {
            f32x4 sc = {0.f, 0.f, 0.f, 0.f};
#pragma unroll
            for (int ks = 0; ks < 2; ++ks) { const bf16x8 bk = *(const LAS bf16x8*)(Ks + (nb * 16 + fr) * QP + 32 * ks + 8 * fq); sc = MFMA16(aq[ks], bk, sc); }
#pragma unroll
            for (int i = 0; i < 4; ++i) { const int n = 16 * wave + 4 * fq + i, mk = nb * 16 + fr; const int d = n > mk ? n - mk : mk - n;
                Pw[(4 * fq + i) * KP + mk] = (bf16)f2bf(sc[i] * __builtin_amdgcn_exp2f(l2g * (float)d)); }
        }
        LDS_WAIT(); asm volatile("" ::: "memory");
        f32x4 y1[8];
        f32x4 xfv, xbv;
#pragma unroll
        for (int i = 0; i < 4; ++i) { const int nl = 16 * wave + 4 * fq + i; xfv[i] = __builtin_amdgcn_exp2f(l2g * (float)(nl + 1)); xbv[i] = __builtin_amdgcn_exp2f(l2g * (float)(RC - nl)); }
        bf16x8 ap[4];
#pragma unroll
        for (int ks = 0; ks < 4; ++ks) ap[ks] = *(const LAS bf16x8*)(Pw + fr * KP + 32 * ks + 8 * fq);
#pragma unroll
        for (int g = 0; g < 2; ++g) {
            if (g == 1) { RET_LD_STATES(1); }
#pragma unroll
            for (int o4 = 0; o4 < 4; ++o4) {
                const int ob = 4 * g + o4;
                f32x4 y2 = {0.f, 0.f, 0.f, 0.f}, y3 = y2; y1[ob] = y2;
#pragma unroll
                for (int ks = 0; ks < 4; ++ks) { const bf16x8 bvv = *(const LAS bf16x8*)(Vt + (ob * 16 + fr) * KP + 32 * ks + 8 * fq); y1[ob] = MFMA16(ap[ks], bvv, y1[ob]); }
#pragma unroll
                for (int ks = 0; ks < 2; ++ks) { y2 = MFMA16(aq[ks], __builtin_bit_cast(bf16x8, sfv[o4][ks]), y2); y3 = MFMA16(aq[ks], __builtin_bit_cast(bf16x8, sbv[o4][ks]), y3); }
                y1[ob] = y1[ob] + xfv * y2 + xbv * y3;
            }
            asm volatile("" ::: "memory");
        }
#pragma unroll
        for (int i = 0; i < 4; ++i) {
            const int nl = 16 * wave + 4 * fq + i;
            float v[8]; float s = 0.f;
#pragma unroll
            for (int ob = 0; ob < 8; ++ob) { v[ob] = y1[ob][i]; s += v[ob]; }
            s += __shfl_xor(s, 1); s += __shfl_xor(s, 2); s += __shfl_xor(s, 4); s += __shfl_xor(s, 8);
            const float mean = s * (1.f / 128.f); float q = 0.f;
#pragma unroll
            for (int ob = 0; ob < 8; ++ob) { v[ob] -= mean; q += v[ob] * v[ob]; }
            q += __shfl_xor(q, 1); q += __shfl_xor(q, 2); q += __shfl_xor(q, 4); q += __shfl_xor(q, 8);
            const float rstd = rsqrtf(q * (1.f / 128.f) + 1e-6f);
            bf16* yo = (bf16*)(ws + OFF_YB) + ((size_t)b * SEQ + j * RC + nl) * DM + h * 128;
            const float* gn = p->in[I_RG] + (size_t)l * DM + h * 128;
#pragma unroll
            for (int ob = 0; ob < 8; ++ob) yo[ob * 16 + fr] = (bf16)f2bf(v[ob] * rstd * gn[ob * 16 + fr]);
        }
        __syncthreads();
    }
}

#define XB_TMO      128
#define XB_XCNT(j)  (256  + 64 * (j))
#define XB_XSUB(j)  (1280 + 64 * (j))
#define XB_XGEN(j)  (2304 + 64 * (j))
#define XB_TOP      3328
#define XB_TOPGEN   3392
#define XCD_BAR_WORDS 3456
#define XB_SPIN_CAP (1u << 18)

__device__ __forceinline__ unsigned xb_ld(unsigned* p)              { return __hip_atomic_load(p, __ATOMIC_RELAXED, __HIP_MEMORY_SCOPE_AGENT); }
__device__ __forceinline__ unsigned xb_add(unsigned* p, unsigned v) { return __hip_atomic_fetch_add(p, v, __ATOMIC_RELAXED, __HIP_MEMORY_SCOPE_AGENT); }
__device__ __forceinline__ unsigned xb_xcc_id() { return (unsigned)__builtin_amdgcn_s_getreg((3 << 11) | 20) & 0xFu; }
#define XB_SPIN(cond, bar) do { unsigned _sp = 0; while (cond) { __builtin_amdgcn_s_sleep(1); \
    if ((++_sp & 255u) == 0u) { if (xb_ld(&(bar)[XB_TMO])) break; if (_sp > XB_SPIN_CAP) { atomicAdd(&(bar)[XB_TMO], 1u); break; } } } } while (0)

struct XcdBarrier {
    unsigned* bar; unsigned x;
    volatile LAS unsigned* st;
};

__device__ __forceinline__ XcdBarrier xcd_barrier_post(unsigned* bar, volatile LAS unsigned* st) {
    XcdBarrier b; b.bar = bar; b.x = xb_xcc_id(); b.st = st;
    if (threadIdx.x == 0) (void)xb_add(&bar[XB_XCNT(b.x)], 1u);
    return b;
}
__device__ __forceinline__ void xcd_barrier_complete(unsigned* bar, unsigned x, unsigned& nloc, unsigned& nx) {
    const unsigned G = gridDim.x * gridDim.y * gridDim.z;
    unsigned sum, cnt, mine, sp = 0u;
    for (;;) {
        sum = 0u; cnt = 0u; mine = 0u;
#pragma unroll
        for (unsigned j = 0; j < 16; ++j) { const unsigned c = xb_ld(&bar[XB_XCNT(j)]); sum += c; cnt += (c > 0u) ? 1u : 0u; mine = (j == x) ? c : mine; }
        if (sum == G) break;
        __builtin_amdgcn_s_sleep(1);
        if ((++sp & 255u) == 0u) { if (xb_ld(&bar[XB_TMO])) break; if (sp > XB_SPIN_CAP) { atomicAdd(&bar[XB_TMO], 1u); break; } }
    }
    nloc = mine > 0u ? mine : 1u; nx = cnt > 0u ? cnt : 1u;
}

__device__ __forceinline__ void xcd_barrier(const XcdBarrier& b) {
    asm volatile("s_waitcnt vmcnt(0)" ::: "memory");
    __syncthreads();
    if (threadIdx.x == 0) {
        unsigned* bar = b.bar;
        __builtin_amdgcn_s_waitcnt(0);
        unsigned nloc = b.st[0], nx = b.st[1];
        if (nloc == 0u) { xcd_barrier_complete(bar, b.x, nloc, nx); b.st[0] = nloc; b.st[1] = nx; }
        const unsigned old = xb_add(&bar[XB_XSUB(b.x)], 1u);
        const unsigned gen = old / nloc;
        if (old + 1u == (gen + 1u) * nloc) {
            __builtin_amdgcn_fence(__ATOMIC_RELEASE, "agent");
            asm volatile("s_waitcnt vmcnt(0)" ::: "memory");
            const unsigned og = xb_add(&bar[XB_TOP], 1u);
            const unsigned tg = og / nx;
            if (og + 1u == (tg + 1u) * nx) xb_add(&bar[XB_TOPGEN], 1u);
            else XB_SPIN(xb_ld(&bar[XB_TOPGEN]) == tg, bar);
            __builtin_amdgcn_fence(__ATOMIC_ACQUIRE, "agent");
            xb_add(&bar[XB_XGEN(b.x)], 1u);
            asm volatile("s_waitcnt vmcnt(0)" ::: "memory");
        } else {
            XB_SPIN(xb_ld(&bar[XB_XGEN(b.x)]) == gen, bar);
            __builtin_amdgcn_fence(__ATOMIC_ACQUIRE, "agent");
            asm volatile("s_waitcnt vmcnt(0)" ::: "memory");
        }
    }
    __syncthreads();
}

#ifndef PHMASK
#define PHMASK 0xFFFF
#endif
#define PH(n) if constexpr ((PHMASK >> (n)) & 1)
#define GSYNC_CG() do { asm volatile("s_waitcnt vmcnt(0) lgkmcnt(0)" ::: "memory"); __syncthreads(); grid.sync(); __builtin_amdgcn_fence(__ATOMIC_ACQUIRE, "agent"); asm volatile("s_waitcnt vmcnt(0)" ::: "memory"); } while (0)
#define GSYNC() xcd_barrier(xbar)
__global__ void __launch_bounds__(512, 2) hybrid_fwd(Params p_unused) {
    extern __shared__ __attribute__((aligned(16))) unsigned char lds_raw[];
    LAS unsigned char* lds = (LAS unsigned char*)lds_raw;
    cg::grid_group grid = cg::this_grid();
    const int tid = threadIdx.x, lane = tid & 63, wave = __builtin_amdgcn_readfirstlane(tid >> 6);
    const int gw = blockIdx.x * 8 + wave, NGW = gridDim.x * 8;
    { volatile LAS unsigned* stw = (volatile LAS unsigned*)(lds + XB_LDS_OFF); if (threadIdx.x < 2) stw[threadIdx.x] = 0u; }
    __syncthreads();
    XcdBarrier xbar = xcd_barrier_post((unsigned*)KARG()->ws, (volatile LAS unsigned*)(lds + XB_LDS_OFF));
    GSYNC_CG();
    {
        float* rot = (float*)(KARG()->ws + OFF_ROT);
        for (int i = gw * 64 + lane; i < 2048 * 32; i += NGW * 64) { const int pos = i >> 5, jf = i & 31;
            const float fr_ = exp2f(-(float)jf * (13.287712379549449f / 32.0f)); float rev = (float)pos * fr_ * 0.15915494309189535f; rev -= rintf(rev);
            rot[i] = __builtin_amdgcn_cosf(rev); rot[2048 * 32 + i] = __builtin_amdgcn_sinf(rev); }
    }
#pragma unroll 1
    for (int l = 0; l < DEPTH; ++l) {
#define XIN (l == 0 ? KARG()->in[I_X] : (const float*)KARG()->out)
#define WSP(off) (KARG()->ws + (off))
        PH(0) convert_weights(l, lds, gw, NGW, wave, lane);
        PH(1) norm_phase(XIN, KARG()->in[I_NG] + (size_t)l * DM, (bf16*)WSP(OFF_XB), gw, NGW, lane);
        GSYNC();
        PH(2) run_gemm(lds, (const bf16*)WSP(OFF_XB), (const bf16*)WSP(OFF_WA), NA, FStoreA{(bf16*)WSP(OFF_RAWA)});
        GSYNC();
        PH(3) scan_phase(l, lds, wave, lane);
        GSYNC();
        PH(4) postscan_phase(l, gw, NGW, lane);
        PH(5) run_gemm(lds, (const bf16*)WSP(OFF_XB), (const bf16*)WSP(OFF_WB), 2048, FStoreB{(bf16*)WSP(OFF_RAWB)});
        GSYNC();
        PH(6) ret_states_phase(lds, wave, lane);
        GSYNC();
        PH(7) ret_out_phase(l, lds, wave, lane);
        GSYNC();
        PH(8) run_gemm(lds, (const bf16*)WSP(OFF_XB), (const bf16*)WSP(OFF_WG), 4096, FGates{(bf16*)WSP(OFF_YS), (bf16*)WSP(OFF_YB), (bf16*)WSP(OFF_SIGA), (bf16*)WSP(OFF_SIGB)});
        GSYNC();
        PH(9) run_gemm(lds, (const bf16*)WSP(OFF_YS), (const bf16*)WSP(OFF_Wa), DM, FGa{(const bf16*)WSP(OFF_SIGA), (bf16*)WSP(OFF_M1)});
        GSYNC();
        PH(10) run_gemm(lds, (const bf16*)WSP(OFF_YB), (const bf16*)WSP(OFF_Wb), DM, FGb{(const bf16*)WSP(OFF_SIGB), (const bf16*)WSP(OFF_M1), (bf16*)WSP(OFF_MG)});
        GSYNC();
        PH(11) run_gemm(lds, (const bf16*)WSP(OFF_MG), (const bf16*)WSP(OFF_Wo), DM, FGo{XIN, KARG()->out});
        GSYNC();
    }
    final_norm(KARG()->out, KARG()->in[I_FG], gw, NGW, lane);
}

extern "C" void kernel_launch(void* const* d_in, const int* in_sizes, int n_in, void* d_out, int out_size, void* d_ws, size_t ws_size, hipStream_t stream) {
    static int grid = 0;
    if (grid == 0) {
        if (n_in != 22 || ws_size < WS_END) { fprintf(stderr, "kernel_launch: unexpected n_in %d / ws_size %zu (need %zu)\n", n_in, ws_size, (size_t)WS_END); grid = -1; return; }
        int dev = 0, cus = 0, per_cu = 0;
        (void)hipGetDevice(&dev); (void)hipDeviceGetAttribute(&cus, hipDeviceAttributeMultiprocessorCount, dev);
        (void)hipFuncSetAttribute((const void*)hybrid_fwd, hipFuncAttributeMaxDynamicSharedMemorySize, LDS_BYTES);
        (void)hipOccupancyMaxActiveBlocksPerMultiprocessor(&per_cu, (const void*)hybrid_fwd, 512, LDS_BYTES);
        if (per_cu < 1) per_cu = 1;
        grid = cus * per_cu;
        (void)hipGetLastError();
    }
    if (grid < 0) return;
    Params p{};
    for (int i = 0; i < 22; ++i) p.in[i] = (const float*)d_in[i];
    p.out = (float*)d_out; p.ws = (unsigned char*)d_ws;
    if (hipMemsetAsync(d_ws, 0, 16384, stream) != hipSuccess) { fprintf(stderr, "kernel_launch: hipMemsetAsync of the barrier words failed\n"); return; }
    void* args[] = {&p};
    hipError_t e = hipLaunchCooperativeKernel((const void*)hybrid_fwd, dim3(grid), dim3(512), args, LDS_BYTES, stream);
    if (e != hipSuccess) fprintf(stderr, "cooperative launch failed: %s (grid %d)\n", hipGetErrorString(e), grid);
}
```

```cpp
#include <hip/hip_runtime.h>
#include <hip/hip_cooperative_groups.h>
#include <cstdio>
#include <cstdint>
namespace cg = cooperative_groups;
namespace pg8 {
#define PG8_LAS __attribute__((address_space(3)))
typedef unsigned short bf16_t;
typedef short bf16x8 __attribute__((ext_vector_type(8)));
typedef float f32x4 __attribute__((ext_vector_type(4)));
typedef unsigned u32x4 __attribute__((ext_vector_type(4)));
constexpr int BM = 256, BK = 64, HALF = 128, HTB = HALF * BK * 2  , STAGE_BYTES = 8 * HTB, NXCD = 8, WGM = 8;

__host__ __device__ __forceinline__ int lds_byte(int r, int c) { const int st = (r >> 4) * 2 + (c >> 5), rr = r & 15, cc = c & 31, ob = rr * 64 + cc * 2; return st * 1024 + (ob ^ (((ob >> 9) & 1) << 5)); }
__host__ __device__ __forceinline__ void stage_rc(int b, int& R, int& C) { const int st = b / 1024, sb = b % 1024, swz = sb ^ (((sb >> 9) & 1) << 5); R = (st >> 1) * 16 + swz / 64; C = (st & 1) * 32 + (swz % 64) / 2; }
__host__ __device__ __forceinline__ int perm32(int rho) { const int n = rho >> 4, i = rho & 15; return 8 * (i >> 2) + 4 * n + (i & 3); }

struct Unit { int pm, pn; };
struct Gemm { const bf16_t* A; const bf16_t* Bt; int M, N, K; };

struct StaticOrder {
    int nM, nN, nwg, G, c;
    __host__ __device__ void init(int M, int N, int G_, int c_) { nM = M / BM; nN = N / BM; nwg = nM * nN; G = G_; c = c_; }
    __host__ __device__ bool next(int i, Unit& u) const {
        const long L = (long)i * G + c; if (L >= nwg) return false;
        int wgid = (int)L; { const int q = nwg / NXCD, r = nwg % NXCD, xcd = wgid % NXCD, off = wgid / NXCD; wgid = (xcd < r ? xcd * (q + 1) : r * (q + 1) + (xcd - r) * q) + off; }
        const int nig = WGM * nN, gid = wgid / nig, fm = gid * WGM, gsz = (nM - fm) < WGM ? (nM - fm) : WGM;
        u.pm = fm + ((wgid % nig) % gsz); u.pn = (wgid % nig) / gsz; return true;
    }
    __device__ __forceinline__ void a_ready(const Unit&) const {}
    __device__ __forceinline__ void done(const Unit&) const {}
};
__device__ __forceinline__ unsigned cvt_pk_bf16(float lo, float hi) { unsigned r; asm volatile("v_cvt_pk_bf16_f32 %0, %1, %2" : "=v"(r) : "v"(lo), "v"(hi)); return r; }
typedef float f32x2 __attribute__((ext_vector_type(2)));
template <class Epi, class Sched, bool ALIGN_EPI = false, bool SP2 = false>
__device__ __forceinline__ void gemm_phase(PG8_LAS unsigned char* lds, const Gemm g, const Sched& S, const Epi& E) {
    int tid_ = threadIdx.x; asm volatile("" : "+v"(tid_));
    const int tid = tid_, wid = __builtin_amdgcn_readfirstlane(tid >> 6), lane = tid & 63, wr = wid >> 2, wc = wid & 3, fr = lane & 15, fq = lane >> 4;
    const int K = g.K, nt = K / BK;
    unsigned voffA[2], voffB[2];
#pragma unroll
    for (int i = 0; i < 2; ++i) { int R, C; stage_rc(tid * 16 + i * 8192, R, C); const int Rb = Epi::PERM ? ((R & ~31) + perm32(R & 31)) : R;
        voffA[i] = (unsigned)(R * K + C) * 2u; voffB[i] = (unsigned)(Rb * K + C) * 2u; }
    const size_t kstep = (size_t)(BK * 2);
    const size_t hstep = (size_t)HALF * K * 2;
    const size_t tstep = 2 * hstep;
    const unsigned ldsw = (unsigned)wid * 1024u;
    const int aoff = lds_byte(wr * 64 + fr, fq * 8), boff = lds_byte(wc * 32 + fr, fq * 8);
#define PG8_SA(b, h) (((b) * 2 + (h)) * HTB)
#define PG8_SB(b, h) ((4 + (b) * 2 + (h)) * HTB)
#define PG8_STAGE(bufoff, gbase, voff) do { _Pragma("unroll") for (int _i = 0; _i < 2; ++_i) \
        __builtin_amdgcn_global_load_lds((const unsigned*)((const char*)(gbase) + (voff)[_i]), (PG8_LAS unsigned*)(lds + (bufoff) + ldsw + _i * 8192), 16, 0, 0); } while (0)
#define PG8_LDA(dst, b, h) do { _Pragma("unroll") for (int m = 0; m < 4; ++m) _Pragma("unroll") for (int k = 0; k < 2; ++k) dst[m][k] = *(const PG8_LAS bf16x8*)(lds + PG8_SA(b, h) + aoff + m * 2048 + k * 1024); } while (0)
#define PG8_LDB(dst, b, h) do { _Pragma("unroll") for (int n = 0; n < 2; ++n) _Pragma("unroll") for (int k = 0; k < 2; ++k) dst[n][k] = *(const PG8_LAS bf16x8*)(lds + PG8_SB(b, h) + boff + n * 2048 + k * 1024); } while (0)
#define PG8_MMA(ai, bj, At, Bt) do { __builtin_amdgcn_s_setprio(1); _Pragma("unroll") for (int m = 0; m < 4; ++m) _Pragma("unroll") for (int n = 0; n < 2; ++n) _Pragma("unroll") for (int k = 0; k < 2; ++k) \
        acc[ai][bj][m][n] = __builtin_amdgcn_mfma_f32_16x16x32_bf16(Bt[n][k], At[m][k], acc[ai][bj][m][n], 0, 0, 0); __builtin_amdgcn_s_setprio(0); } while (0)
#define PG8_WAIT_V(n) asm volatile("s_waitcnt vmcnt(" #n ")" ::: "memory")
#define PG8_WAIT_L(n) asm volatile("s_waitcnt lgkmcnt(" #n ")" ::: "memory")
#define PG8_BAR __builtin_amdgcn_s_barrier()
#define PG8_SCHED __builtin_amdgcn_sched_barrier(0)
    Unit cur, nxt; int ui = 0;
    if (!S.next(0, cur)) return;
    f32x4 acc[2][2][4][2];
#pragma unroll
    for (int a = 0; a < 2; ++a)
#pragma unroll
        for (int b = 0; b < 2; ++b)
#pragma unroll
            for (int m = 0; m < 4; ++m)
#pragma unroll
                for (int n = 0; n < 2; ++n) acc[a][b][m][n] = (f32x4){0.f, 0.f, 0.f, 0.f};
    bf16x8 At[4][2], B0[2][2], B1[2][2];
    const char* cA = (const char*)g.A + (size_t)cur.pm * tstep; const char* cB = (const char*)g.Bt + (size_t)cur.pn * tstep;
    S.a_ready(cur);
    if constexpr (SP2) {
        PG8_STAGE(PG8_SB(0, 0), cB, voffB); PG8_STAGE(PG8_SB(0, 1), cB + hstep, voffB); PG8_STAGE(PG8_SA(0, 0), cA, voffA); PG8_STAGE(PG8_SA(0, 1), cA + hstep, voffA);
        if (wr == 1) PG8_BAR;
        PG8_WAIT_V(2); PG8_BAR;
        PG8_STAGE(PG8_SB(1, 0), cB + kstep, voffB); PG8_STAGE(PG8_SA(1, 0), cA + kstep, voffA); PG8_STAGE(PG8_SB(1, 1), cB + hstep + kstep, voffB);
        PG8_WAIT_V(6); PG8_BAR;
    } else {
        PG8_STAGE(PG8_SB(0, 0), cB, voffB); PG8_STAGE(PG8_SA(0, 0), cA, voffA); PG8_STAGE(PG8_SB(0, 1), cB + hstep, voffB); PG8_STAGE(PG8_SA(0, 1), cA + hstep, voffA);
        if (wr == 1) PG8_BAR;
        PG8_WAIT_V(4); PG8_BAR;
        PG8_STAGE(PG8_SB(1, 0), cB + kstep, voffB); PG8_STAGE(PG8_SA(1, 0), cA + kstep, voffA); PG8_STAGE(PG8_SB(1, 1), cB + hstep + kstep, voffB);
        PG8_WAIT_V(6); PG8_BAR;
    }
    for (;;) {
        const bool has_next = S.next(ui + 1, nxt);
        const char* nA = has_next ? (const char*)g.A + (size_t)nxt.pm * tstep : cA; const char* nB = has_next ? (const char*)g.Bt + (size_t)nxt.pn * tstep : cB;
        for (int t = 0; t < nt; t += 2) {
            const bool last = (t == nt - 2);
            const char* a1 = cA + (size_t)(t + 1) * kstep;
            const char* a2 = last ? nA : cA + (size_t)(t + 2) * kstep; const char* b2 = last ? nB : cB + (size_t)(t + 2) * kstep;
            const char* a3 = a2 + kstep; const char* b3 = b2 + kstep;
            if (last && has_next) S.a_ready(nxt);
            if constexpr (SP2) {
            PG8_LDB(B0, 0, 0); PG8_LDB(B1, 0, 1); PG8_SCHED; PG8_LDA(At, 0, 0); PG8_STAGE(PG8_SA(1, 1), a1 + hstep, voffA);
            PG8_WAIT_V(8); PG8_WAIT_L(0); PG8_BAR; PG8_MMA(0, 0, At, B0); PG8_MMA(0, 1, At, B1); PG8_BAR; PG8_SCHED;
            PG8_LDA(At, 0, 1); PG8_STAGE(PG8_SB(0, 0), b2, voffB); PG8_STAGE(PG8_SB(0, 1), b2 + hstep, voffB); PG8_STAGE(PG8_SA(0, 0), a2, voffA);
            PG8_WAIT_V(8); PG8_WAIT_L(0); PG8_BAR; PG8_MMA(1, 0, At, B0); PG8_MMA(1, 1, At, B1); PG8_BAR; PG8_SCHED;
            PG8_LDB(B0, 1, 0); PG8_LDB(B1, 1, 1); PG8_SCHED; PG8_LDA(At, 1, 0); PG8_STAGE(PG8_SA(0, 1), a2 + hstep, voffA);
            PG8_WAIT_V(8); PG8_WAIT_L(0); PG8_BAR; PG8_MMA(0, 0, At, B0); PG8_MMA(0, 1, At, B1); PG8_BAR; PG8_SCHED;
            PG8_LDA(At, 1, 1); PG8_STAGE(PG8_SB(1, 0), b3, voffB); PG8_STAGE(PG8_SB(1, 1), b3 + hstep, voffB); PG8_STAGE(PG8_SA(1, 0), a3, voffA);
            PG8_WAIT_V(8); PG8_WAIT_L(0); PG8_BAR; PG8_MMA(1, 0, At, B0); PG8_MMA(1, 1, At, B1); PG8_BAR; PG8_SCHED;
            } else {
            PG8_LDB(B0, 0, 0); PG8_SCHED; PG8_LDA(At, 0, 0); PG8_STAGE(PG8_SA(1, 1), a1 + hstep, voffA);
            PG8_WAIT_L(8); PG8_BAR; PG8_WAIT_L(0); PG8_MMA(0, 0, At, B0); PG8_BAR; PG8_SCHED;
            PG8_LDB(B1, 0, 1); PG8_STAGE(PG8_SB(0, 0), b2, voffB);
            PG8_BAR; PG8_WAIT_L(0); PG8_MMA(0, 1, At, B1); PG8_BAR;
            PG8_LDA(At, 0, 1); PG8_STAGE(PG8_SA(0, 0), a2, voffA);
            PG8_BAR; PG8_WAIT_L(0); PG8_MMA(1, 0, At, B0); PG8_BAR; PG8_SCHED;
            PG8_STAGE(PG8_SB(0, 1), b2 + hstep, voffB);
            PG8_WAIT_V(6); PG8_BAR; PG8_MMA(1, 1, At, B1); PG8_BAR;
            PG8_LDB(B0, 1, 0); PG8_SCHED; PG8_LDA(At, 1, 0); PG8_STAGE(PG8_SA(0, 1), a2 + hstep, voffA);
            PG8_WAIT_L(8); PG8_BAR; PG8_WAIT_L(0); PG8_MMA(0, 0, At, B0); PG8_BAR; PG8_SCHED;
            PG8_LDB(B1, 1, 1); PG8_STAGE(PG8_SB(1, 0), b3, voffB);
            PG8_BAR; PG8_WAIT_L(0); PG8_MMA(0, 1, At, B1); PG8_BAR;
            PG8_LDA(At, 1, 1); PG8_STAGE(PG8_SA(1, 0), a3, voffA);
            PG8_BAR; PG8_WAIT_L(0); PG8_MMA(1, 0, At, B0); PG8_BAR; PG8_SCHED;
            PG8_STAGE(PG8_SB(1, 1), b3 + hstep, voffB);
            PG8_WAIT_V(6); PG8_BAR; PG8_MMA(1, 1, At, B1); PG8_BAR;
            }
        }
        if constexpr (ALIGN_EPI) { if (wr == 0) PG8_BAR; }
        if constexpr (!Epi::AFTER_DRAIN) { E(acc, cur, wr, wc, fr, fq); S.done(cur); }
        if (!has_next) break;
#pragma unroll
        for (int a = 0; a < 2; ++a)
#pragma unroll
            for (int b = 0; b < 2; ++b)
#pragma unroll
                for (int m = 0; m < 4; ++m)
#pragma unroll
                    for (int n = 0; n < 2; ++n) acc[a][b][m][n] = (f32x4){0.f, 0.f, 0.f, 0.f};
        cur = nxt; cA = nA; cB = nB; ++ui;
        if constexpr (ALIGN_EPI) { if (wr == 1) PG8_BAR; }
    }
    PG8_WAIT_V(0);
    if constexpr (!ALIGN_EPI) { if (wr == 0) PG8_BAR; }
    PG8_BAR;
    if constexpr (Epi::AFTER_DRAIN) { E.fused(acc, cur, wr, wc, fr, fq, lds, wid, lane); S.done(cur); }
#undef PG8_SA
#undef PG8_SB
#undef PG8_STAGE
#undef PG8_LDA
#undef PG8_LDB
#undef PG8_MMA
#undef PG8_WAIT_V
#undef PG8_WAIT_L
#undef PG8_BAR
#undef PG8_SCHED
}
}
#define PG8_SP2 true
#define PG8_ALIGN true
#define GAS __attribute__((address_space(1)))
#define LAS __attribute__((address_space(3)))
#define CAS __attribute__((address_space(4)))
typedef unsigned short bf16;
typedef unsigned u32x4 __attribute__((ext_vector_type(4)));
typedef unsigned u32x2 __attribute__((ext_vector_type(2)));
typedef float f32x4 __attribute__((ext_vector_type(4)));
typedef float f32x2 __attribute__((ext_vector_type(2)));
typedef short bf16x8 __attribute__((ext_vector_type(8)));
#define LDS_WAIT() asm volatile("s_waitcnt lgkmcnt(0)" ::: "memory")
#define VM_WAIT() asm volatile("s_waitcnt vmcnt(0)" ::: "memory")

constexpr int BATCH = 16, SEQ = 2048, DM = 1024, DEPTH = 4, T = BATCH * SEQ;
constexpr int NIN = 9472;
constexpr int NA = 3584, LDA = 3360;
constexpr int CHS = 16, NCH = SEQ / CHS;
constexpr int RSTEP = 260;
constexpr int RC = 128, NRC = SEQ / RC;
constexpr size_t MiB = 1u << 20;
constexpr size_t OFF_WA = 2 * MiB, OFF_WB = 9 * MiB, OFF_WG = 13 * MiB, OFF_Wa = 21 * MiB, OFF_Wb = 23 * MiB, OFF_Wo = 25 * MiB;
constexpr size_t OFF_WDEC = 27 * MiB, OFF_WIC = OFF_WDEC + 256 * 1024, OFF_WVR = OFF_WIC + 256 * 1024, OFF_ROT = OFF_WVR + 64 * 1024;
constexpr size_t OFF_VFIRST = 29 * MiB, OFF_VFIN = 93 * MiB, OFF_YS = 157 * MiB, OFF_COEF = 221 * MiB, OFF_XB = 225 * MiB, OFF_RAWA = 289 * MiB;
constexpr size_t OFF_YB = OFF_VFIN;
constexpr size_t OFF_RAWB = OFF_RAWA, OFF_ST = OFF_RAWA + 128 * MiB;
constexpr size_t OFF_SIGA = OFF_RAWA, OFF_SIGB = OFF_RAWA + 64 * MiB, OFF_M1 = OFF_ST, OFF_MG = OFF_XB;
constexpr size_t OFF_COEF2 = 499 * MiB;
constexpr size_t WS_END = 503 * MiB;
static_assert(OFF_ROT + 2 * 2048 * 32 * 4 <= OFF_VFIRST, "small region");
static_assert(32768 + 2 * 2 * CHS * RSTEP * 4 <= 133120, "scan LDS map");
static_assert(OFF_RAWA + (size_t)T * LDA * 2 <= WS_END, "rawA");
constexpr int XB_LDS_OFF = 133120 + 16384 + 6144;
constexpr int LDS_BYTES = XB_LDS_OFF + 64;

enum { I_X = 0, I_NG, I_WIN, I_WVD, I_SP, I_SN, I_WDU, I_DB, I_WIU, I_IB, I_WVU, I_VB, I_KK, I_KA, I_RK, I_LG, I_LB, I_WBA, I_RG, I_WBB, I_WO, I_FG };
struct Params { const float* in[22]; float* out; unsigned char* ws; };
#define KARG() ({ const CAS Params* kp_ = (const CAS Params*)__builtin_amdgcn_kernarg_segment_ptr(); asm volatile("" : "+s"(kp_)); kp_; })

typedef __bf16 bf16x2_t __attribute__((ext_vector_type(2)));
__device__ __forceinline__ unsigned cvtpk(float lo, float hi) { const f32x2 v = {lo, hi}; const bf16x2_t b = __builtin_convertvector(v, bf16x2_t); return __builtin_bit_cast(unsigned, b); }
__device__ __forceinline__ unsigned pk2(float lo, float hi) { return cvtpk(lo, hi); }
__device__ __forceinline__ unsigned f2bf(float f) { return cvtpk(f, 0.f) & 0xffffu; }
__device__ __forceinline__ float bflo(unsigned u) { return __builtin_bit_cast(float, u << 16); }
__device__ __forceinline__ float bfhi(unsigned u) { return __builtin_bit_cast(float, u & 0xffff0000u); }
__device__ __forceinline__ float bf1(bf16 h) { return __builtin_bit_cast(float, (unsigned)h << 16); }
__device__ __forceinline__ void unpack8(u32x4 u, float* o) { o[0] = bflo(u.x); o[1] = bfhi(u.x); o[2] = bflo(u.y); o[3] = bfhi(u.y); o[4] = bflo(u.z); o[5] = bfhi(u.z); o[6] = bflo(u.w); o[7] = bfhi(u.w); }
__device__ __forceinline__ void unpack4(u32x2 u, float* o) { o[0] = bflo(u.x); o[1] = bfhi(u.x); o[2] = bflo(u.y); o[3] = bfhi(u.y); }
__device__ __forceinline__ u32x4 pack8u(const float* f) { u32x4 u; u.x = pk2(f[0], f[1]); u.y = pk2(f[2], f[3]); u.z = pk2(f[4], f[5]); u.w = pk2(f[6], f[7]); return u; }
__device__ __forceinline__ bf16x8 pack8(const float* f) { return __builtin_bit_cast(bf16x8, pack8u(f)); }
__device__ __forceinline__ float sigm(float x) { return __builtin_amdgcn_rcpf(1.0f + __expf(-x)); }
__device__ __forceinline__ float wave_sum(float v) {
#pragma unroll
    for (int o = 1; o < 64; o <<= 1) v += __shfl_xor(v, o);
    return v;
}
#define MFMA16(a, b, c) __builtin_amdgcn_mfma_f32_16x16x32_bf16((a), (b), (c), 0, 0, 0)

__device__ __forceinline__ void tr_item(const float* W, int ldw, int K, bf16* WT, int item, int nblk, LAS float* scr, int lane) {
    const int kb = item / nblk, nb = item % nblk, k0 = 64 * kb, n0 = 32 * nb;
    float wv[32];
#pragma unroll
    for (int i = 0; i < 32; ++i) wv[i] = W[(size_t)(k0 + 2 * i + (lane >> 5)) * ldw + n0 + (lane & 31)];
#pragma unroll
    for (int i = 0; i < 32; ++i) scr[(2 * i + (lane >> 5)) * 33 + (lane & 31)] = wv[i];
    LDS_WAIT(); asm volatile("" ::: "memory");
    const int c = lane & 7;
#pragma unroll
    for (int j = 0; j < 4; ++j) { const int n = (lane >> 3) + 8 * j; const LAS float* s = scr + (8 * c) * 33 + n;
        u32x4 o; o.x = pk2(s[0 * 33], s[1 * 33]); o.y = pk2(s[2 * 33], s[3 * 33]); o.z = pk2(s[4 * 33], s[5 * 33]); o.w = pk2(s[6 * 33], s[7 * 33]);
        *(u32x4*)(WT + (size_t)(n0 + n) * K + k0 + 8 * c) = o; }
    LDS_WAIT(); asm volatile("" ::: "memory");
}

__device__ __forceinline__ void convert_weights(int l, LAS unsigned char* lds, int gw, int NGW, int wave, int lane) {
    asm volatile("" : "+s"(NGW), "+s"(gw));
    asm volatile("" : "+v"(lane));
    const CAS Params* p = KARG(); unsigned char* ws = p->ws;
    LAS float* scr = (LAS float*)(lds + wave * 16384);
    const float* win = p->in[I_WIN] + (size_t)l * DM * NIN;
    bf16* WA = (bf16*)(ws + OFF_WA); bf16* WB = (bf16*)(ws + OFF_WB); bf16* WG = (bf16*)(ws + OFF_WG);
    constexpr int S1 = 16 * 104, S2 = 16 * 64, S3 = 16 * 32, S4 = 16 * 96, S5 = 512, S8 = 16, S10 = 32;
    constexpr int NIT = S1 + S2 + S3 + S4 + 3 * S5 + S8 + 4 * S10;
    for (int it = gw; it < NIT; it += NGW) {
        int r = it;
        if (r < S1) { tr_item(win, NIN, DM, WA, r, 104, scr, lane); continue; } r -= S1;
        if (r < S2) { tr_item(win + 4352, NIN, DM, WB, r, 64, scr, lane); continue; } r -= S2;
        if (r < S3) { tr_item(win + 3328, NIN, DM, WG, r, 32, scr, lane); continue; } r -= S3;
        if (r < S4) { tr_item(win + 6400, NIN, DM, WG + (size_t)1024 * DM, r, 96, scr, lane); continue; } r -= S4;
        if (r < S5) { tr_item(p->in[I_WBA] + (size_t)l * DM * DM, DM, DM, (bf16*)(ws + OFF_Wa), r, 32, scr, lane); continue; } r -= S5;
        if (r < S5) { tr_item(p->in[I_WBB] + (size_t)l * DM * DM, DM, DM, (bf16*)(ws + OFF_Wb), r, 32, scr, lane); continue; } r -= S5;
        if (r < S5) { tr_item(p->in[I_WO] + (size_t)l * DM * DM, DM, DM, (bf16*)(ws + OFF_Wo), r, 32, scr, lane); continue; } r -= S5;
        if (r < S8) { if (l > 0) tr_item(p->in[I_WVD] + (size_t)(l - 1) * DM * 32, 32, DM, WA + (size_t)3328 * DM, r, 1, scr, lane); continue; } r -= S8;
        { const int which = r / S10, rr = r % S10;
          const float* src = (which < 2 ? p->in[I_WDU] : p->in[I_WIU]) + ((size_t)l * 2 + (which & 1)) * 64 * DM;
          bf16* dst = (bf16*)(ws + (which < 2 ? OFF_WDEC : OFF_WIC)) + (size_t)(which & 1) * DM * 64;
          tr_item(src, DM, 64, dst, rr, 32, scr, lane); }
    }
    const int gt = gw * 64 + lane, NGT = NGW * 64;
    if (l == 0) {
        u32x4* z = (u32x4*)(WA + (size_t)3328 * DM); const u32x4 zero = {0u, 0u, 0u, 0u};
        for (int i = gt; i < 256 * DM * 2 / 16; i += NGT) z[i] = zero;
    } else {
        const float* src = p->in[I_WVU] + (size_t)(l - 1) * 32 * DM; bf16* dst = (bf16*)(ws + OFF_WVR);
        for (int i = gt; i < 32 * DM; i += NGT) { const int n = i >> 5, k = i & 31; dst[i] = (bf16)f2bf(src[(size_t)k * DM + n]); }
    }
}

__device__ __forceinline__ void norm_phase(const float* x, const float* gain, bf16* xb, int gw, int NGW, int lane) {
    asm volatile("" : "+s"(NGW), "+s"(gw));
    asm volatile("" : "+v"(lane));
    for (int m0 = gw; m0 < T; m0 += 4 * NGW) {
        f32x4 v[4][4]; float ss[4];
#pragma unroll
        for (int r = 0; r < 4; ++r) { const int m = m0 + r * NGW < T ? m0 + r * NGW : m0; const f32x4* xr = (const f32x4*)(x + (size_t)m * DM) + lane;
#pragma unroll
            for (int j = 0; j < 4; ++j) v[r][j] = xr[64 * j]; }
#pragma unroll
        for (int r = 0; r < 4; ++r) { float q = 0.f;
#pragma unroll
            for (int j = 0; j < 4; ++j) q += (v[r][j].x * v[r][j].x + v[r][j].y * v[r][j].y) + (v[r][j].z * v[r][j].z + v[r][j].w * v[r][j].w);
            ss[r] = q; }
#pragma unroll
        for (int o = 1; o < 64; o <<= 1) {
#pragma unroll
            for (int r = 0; r < 4; ++r) ss[r] += __shfl_xor(ss[r], o); }
#pragma unroll
        for (int r = 0; r < 4; ++r) { const int m = m0 + r * NGW; if (m < T) {
            const float rs = rsqrtf(ss[r] * (1.f / DM) + 1e-6f);
            u32x2* o8 = (u32x2*)(xb + (size_t)m * DM) + lane;
#pragma unroll
            for (int j = 0; j < 4; ++j) { const f32x4 g = ((const f32x4*)gain)[lane + 64 * j]; u32x2 o; o.x = pk2(v[r][j].x * rs * g.x, v[r][j].y * rs * g.y); o.y = pk2(v[r][j].z * rs * g.z, v[r][j].w * rs * g.w); o8[64 * j] = o; } } }
    }
}
__device__ __forceinline__ void final_norm(float* x, const float* gain, int gw, int NGW, int lane) {
    asm volatile("" : "+s"(NGW), "+s"(gw));
    asm volatile("" : "+v"(lane));
    for (int m0 = gw; m0 < T; m0 += 4 * NGW) {
        f32x4 v[4][4]; float ss[4];
#pragma unroll
        for (int r = 0; r < 4; ++r) { const int m = m0 + r * NGW < T ? m0 + r * NGW : m0; const f32x4* xr = (const f32x4*)(x + (size_t)m * DM) + lane;
#pragma unroll
            for (int j = 0; j < 4; ++j) v[r][j] = xr[64 * j]; }
#pragma unroll
        for (int r = 0; r < 4; ++r) { float q = 0.f;
#pragma unroll
            for (int j = 0; j < 4; ++j) q += (v[r][j].x * v[r][j].x + v[r][j].y * v[r][j].y) + (v[r][j].z * v[r][j].z + v[r][j].w * v[r][j].w);
            ss[r] = q; }
#pragma unroll
        for (int o = 1; o < 64; o <<= 1) {
#pragma unroll
            for (int r = 0; r < 4; ++r) ss[r] += __shfl_xor(ss[r], o); }
#pragma unroll
        for (int r = 0; r < 4; ++r) { const int m = m0 + r * NGW; if (m < T) {
            const float rs = rsqrtf(ss[r] * (1.f / DM) + 1e-6f);
            f32x4* xr = (f32x4*)(x + (size_t)m * DM) + lane;
#pragma unroll
            for (int j = 0; j < 4; ++j) { const f32x4 g = ((const f32x4*)gain)[lane + 64 * j]; xr[64 * j] = v[r][j] * rs * g; } } }
    }
}

template <class F> struct EpiGen {
    static constexpr bool PERM = true, AFTER_DRAIN = false;
    F f;
    __device__ __forceinline__ void operator()(const pg8::f32x4 (&acc)[2][2][4][2], const pg8::Unit& u, int wr, int wc, int fr, int fq) const {
        const int row0 = u.pm * 256 + wr * 64 + fr, col0 = u.pn * 256 + wc * 32 + 8 * fq;
#pragma unroll
        for (int ai = 0; ai < 2; ++ai)
#pragma unroll
            for (int m = 0; m < 4; ++m)
#pragma unroll
                for (int bj = 0; bj < 2; ++bj) {
                    float v[8];
#pragma unroll
                    for (int i = 0; i < 4; ++i) { v[i] = acc[ai][bj][m][0][i]; v[4 + i] = acc[ai][bj][m][1][i]; }
                    f(row0 + ai * 128 + m * 16, col0 + bj * 128, v);
                }
    }
};
struct FStoreA { bf16* O; __device__ __forceinline__ void operator()(int row, int col, const float* v) const { if (col < LDA) *(u32x4*)(O + (size_t)row * LDA + col) = pack8u(v); } };
struct FStoreB { bf16* O; __device__ __forceinline__ void operator()(int row, int col, const float* v) const { *(u32x4*)(O + (size_t)row * 2048 + col) = pack8u(v); } };
struct FGates { bf16 *ya, *yb, *sa, *sb;
    __device__ __forceinline__ void operator()(int row, int col, const float* v) const {
        const int reg = col >> 10, c = col & 1023; const size_t off = (size_t)row * DM + c; float o[8];
        if (reg < 2) { bf16* y = reg == 0 ? ya : yb; float yv[8]; unpack8(*(const u32x4*)(y + off), yv);
#pragma unroll
            for (int i = 0; i < 8; ++i) o[i] = yv[i] * v[i] * sigm(v[i]);
            *(u32x4*)(y + off) = pack8u(o);
        } else { bf16* s = reg == 2 ? sa : sb;
#pragma unroll
            for (int i = 0; i < 8; ++i) o[i] = sigm(v[i]);
            *(u32x4*)(s + off) = pack8u(o); }
    } };
struct FGa { const bf16* sg; bf16* m1; __device__ __forceinline__ void operator()(int row, int col, const float* v) const {
        const size_t off = (size_t)row * DM + col; float g[8], o[8]; unpack8(*(const u32x4*)(sg + off), g);
#pragma unroll
        for (int i = 0; i < 8; ++i) o[i] = g[i] * v[i];
        *(u32x4*)(m1 + off) = pack8u(o); } };
struct FGb { const bf16* sg; const bf16* m1; bf16* mg; __device__ __forceinline__ void operator()(int row, int col, const float* v) const {
        const size_t off = (size_t)row * DM + col; float g[8], a[8], o[8]; unpack8(*(const u32x4*)(sg + off), g); unpack8(*(const u32x4*)(m1 + off), a);
#pragma unroll
        for (int i = 0; i < 8; ++i) o[i] = a[i] + g[i] * v[i];
        *(u32x4*)(mg + off) = pack8u(o); } };
struct FGo { const float* xo; float* xn; __device__ __forceinline__ void operator()(int row, int col, const float* v) const {
        const size_t off = (size_t)row * DM + col; const f32x4 a = *(const f32x4*)(xo + off), b = *(const f32x4*)(xo + off + 4);
        f32x4 o0 = {a.x + v[0], a.y + v[1], a.z + v[2], a.w + v[3]}, o1 = {b.x + v[4], b.y + v[5], b.z + v[6], b.w + v[7]};
        *(f32x4*)(xn + off) = o0; *(f32x4*)(xn + off + 4) = o1; } };

template <class F> __device__ __forceinline__ void run_gemm(LAS unsigned char* lds, const bf16* A, const bf16* Bt, int N, const F& f) {
    pg8::Gemm g{A, Bt, T, N, DM}; pg8::StaticOrder S; S.init(T, N, (int)gridDim.x, (int)blockIdx.x);
    EpiGen<F> E{f};
    pg8::gemm_phase<EpiGen<F>, pg8::StaticOrder, PG8_ALIGN, PG8_SP2>(lds, g, S, E);
}
constexpr int CST_OFF = 133120 + 16384;
constexpr int C_CMP = 0, C_CMN = 256;
constexpr int C_RMP = 512, C_RMN = 704;
constexpr int C_DB = 896, C_IB = 1024;
constexpr int C_KK = 1152, C_KA = 1216, C_RK = 1280, C_VB = 1344, C_END = 1408;
__device__ __forceinline__ void prep_consts(int l, int h, LAS float* cst) {
    const CAS Params* p = KARG();
    for (int i = threadIdx.x; i < C_END; i += 512) {
        float v;
        if (i < 512) { const int r = i & 255, type = r >> 7, dir = (r >> 6) & 1, col = r & 63; const int gc = (type ? 3200 : 3072) + 64 * dir + col; v = (i < 256 ? p->in[I_SP] : p->in[I_SN])[(size_t)l * 3328 + gc]; }
        else if (i < 896) { const int r = (i - 512) % 192, which = r >> 6, col = r & 63; v = (i < 704 ? p->in[I_SP] : p->in[I_SN])[(size_t)l * 3328 + which * 1024 + h * 64 + col]; }
        else if (i < 1152) { const int r = (i - 896) & 127, dir = r >> 6, col = r & 63; v = (i < 1024 ? p->in[I_DB] : p->in[I_IB])[((size_t)l * 2 + dir) * DM + h * 64 + col]; }
        else { const int which = (i - 1152) >> 6, col = i & 63; const float* src = which == 0 ? p->in[I_KK] : which == 1 ? p->in[I_KA] : which == 2 ? p->in[I_RK] : p->in[I_VB];
               v = (which == 3 && l == 0) ? 0.f : src[(size_t)(which == 3 ? l - 1 : l) * DM + h * 64 + col]; }
        cst[i] = v;
    }
}
__device__ __forceinline__ f32x2 mixp(unsigned c, unsigned pv, unsigned nv, f32x2 m1, f32x2 m2) {
    const float c0 = bflo(c), c1 = bfhi(c);
    float r0 = __builtin_fmaf(m2.x, bflo(nv) - c0, __builtin_fmaf(m1.x, bflo(pv) - c0, c0)), r1 = __builtin_fmaf(m2.y, bfhi(nv) - c1, __builtin_fmaf(m1.y, bfhi(pv) - c1, c1));
    asm("" : "+v"(r0), "+v"(r1));
    return (f32x2){r0, r1};
}
__device__ __forceinline__ void mix8p(const u32x4 c, const u32x4 pv, const u32x4 nv, const LAS float* mp, const LAS float* mn, float* o) {
    const f32x4 a0 = *(const LAS f32x4*)mp, a1 = *(const LAS f32x4*)(mp + 4), b0 = *(const LAS f32x4*)mn, b1 = *(const LAS f32x4*)(mn + 4);
    const f32x2 r0 = mixp(c.x, pv.x, nv.x, (f32x2){a0.x, a0.y}, (f32x2){b0.x, b0.y}), r1 = mixp(c.y, pv.y, nv.y, (f32x2){a0.z, a0.w}, (f32x2){b0.z, b0.w});
    const f32x2 r2 = mixp(c.z, pv.z, nv.z, (f32x2){a1.x, a1.y}, (f32x2){b1.x, b1.y}), r3 = mixp(c.w, pv.w, nv.w, (f32x2){a1.z, a1.w}, (f32x2){b1.z, b1.w});
    o[0] = r0.x; o[1] = r0.y; o[2] = r1.x; o[3] = r1.y; o[4] = r2.x; o[5] = r2.y; o[6] = r3.x; o[7] = r3.y;
}
__device__ __forceinline__ void mix4p(const u32x2 c, const u32x2 pv, const u32x2 nv, const LAS float* mp, const LAS float* mn, float* o) {
    const f32x4 a0 = *(const LAS f32x4*)mp, b0 = *(const LAS f32x4*)mn;
    const f32x2 r0 = mixp(c.x, pv.x, nv.x, (f32x2){a0.x, a0.y}, (f32x2){b0.x, b0.y}), r1 = mixp(c.y, pv.y, nv.y, (f32x2){a0.z, a0.w}, (f32x2){b0.z, b0.w});
    o[0] = r0.x; o[1] = r0.y; o[2] = r1.x; o[3] = r1.y;
}
#define PREP_COMMON() \
    const CAS Params* p = KARG(); unsigned char* ws = p->ws; \
    asm volatile("" : "+v"(lane));     \
    const int fr = lane & 15, fq = lane >> 4; \
    const int s = fr, t = dir == 0 ? c * CHS + s : SEQ - 1 - c * CHS - s; \
    const size_t row = (size_t)b * SEQ + t; \
    const bf16* rawA = (const bf16*)(ws + OFF_RAWA) + row * LDA; \
    const int dp = t > 0 ? -LDA : 0, dn = t < SEQ - 1 ? LDA : 0;            \
    const bool pz = t > 0, nz = t < SEQ - 1; \
    LAS float* rs_ = rg + s * RSTEP;
#define ZERO_ENDS4(A) do { if (!pz) A[1] = (u32x4){0u, 0u, 0u, 0u}; if (!nz) A[2] = (u32x4){0u, 0u, 0u, 0u}; } while (0)
#define ZERO_ENDS2(A) do { if (!pz) A[1] = (u32x2){0u, 0u}; if (!nz) A[2] = (u32x2){0u, 0u}; } while (0)

__device__ __forceinline__ void prep_x(int l, int b, int h, int dir, int c, LAS float* rg, const LAS float* cst, int lane) {
    PREP_COMMON();
    const bf16* Wd = (const bf16*)(ws + OFF_WDEC) + (size_t)dir * DM * 64; const bf16* Wv = (const bf16*)(ws + OFF_WVR);
    bf16* vfirst = (bf16*)(ws + OFF_VFIRST) + row * DM; bf16* vfin = (bf16*)(ws + OFF_VFIN) + row * DM;
    u32x4 cdr[2][3];
#pragma unroll
    for (int ks = 0; ks < 2; ++ks) { const bf16* q = rawA + 3072 + 64 * dir + 32 * ks + 8 * fq; cdr[ks][0] = *(const u32x4*)q; cdr[ks][1] = *(const u32x4*)(q + dp); cdr[ks][2] = *(const u32x4*)(q + dn); }
    u32x4 bvr = {0u, 0u, 0u, 0u}; if (l > 0) bvr = *(const u32x4*)(rawA + 3328 + 8 * fq);
    u32x4 wdr[4][2], wvr[4]; u32x2 vr_[4][3], vfr[4];
#pragma unroll
    for (int nb = 0; nb < 4; ++nb) { const int chr = h * 64 + nb * 16 + fr;
#pragma unroll
        for (int ks = 0; ks < 2; ++ks) wdr[nb][ks] = *(const u32x4*)(Wd + (size_t)chr * 64 + 32 * ks + 8 * fq);
        wvr[nb] = (u32x4){0u, 0u, 0u, 0u}; if (l > 0) wvr[nb] = *(const u32x4*)(Wv + (size_t)chr * 32 + 8 * fq);
        const int ch = h * 64 + nb * 16 + 4 * fq; const bf16* q = rawA + 2048 + ch;
        vr_[nb][0] = *(const u32x2*)q; vr_[nb][1] = *(const u32x2*)(q + dp); vr_[nb][2] = *(const u32x2*)(q + dn);
        vfr[nb] = (u32x2){0u, 0u}; if (l > 0) vfr[nb] = *(const u32x2*)(vfirst + ch); }
    __builtin_amdgcn_sched_barrier(0);
    bf16x8 bd[2];
#pragma unroll
    for (int ks = 0; ks < 2; ++ks) {
        float o[8]; const int cc = 64 * dir + 32 * ks + 8 * fq;
        ZERO_ENDS4(cdr[ks]);
        mix8p(cdr[ks][0], cdr[ks][1], cdr[ks][2], cst + C_CMP + cc, cst + C_CMN + cc, o);
#pragma unroll
        for (int i = 0; i < 8; ++i) o[i] = 1.0f - 2.0f * __builtin_amdgcn_rcpf(1.0f + __expf(2.0f * o[i]));
        bd[ks] = pack8(o);
    }
    const bf16x8 bv = __builtin_bit_cast(bf16x8, bvr);
#pragma unroll
    for (int nb = 0; nb < 4; ++nb) {
        f32x4 aD = {0.f, 0.f, 0.f, 0.f}, aV = aD;
#pragma unroll
        for (int ks = 0; ks < 2; ++ks) aD = MFMA16(__builtin_bit_cast(bf16x8, wdr[nb][ks]), bd[ks], aD);
        if (l > 0) aV = MFMA16(__builtin_bit_cast(bf16x8, wvr[nb]), bv, aV);
        const int co = nb * 16 + 4 * fq, ch = h * 64 + co;
        float vv[4];
        ZERO_ENDS2(vr_[nb]);
        mix4p(vr_[nb][0], vr_[nb][1], vr_[nb][2], cst + C_RMP + 128 + co, cst + C_RMN + 128 + co, vv);
        const f32x4 dbias = *(const LAS f32x4*)(cst + C_DB + 64 * dir + co);
        if (l > 0) {
            float vf[4]; unpack4(vfr[nb], vf);
            const f32x4 vbias = *(const LAS f32x4*)(cst + C_VB + co);
#pragma unroll
            for (int i = 0; i < 4; ++i) { const float g = sigm(vbias[i] + aV[i]); vv[i] = vv[i] + (vf[i] - vv[i]) * g; }
        }
        if (dir == 0) { u32x2 o; o.x = pk2(vv[0], vv[1]); o.y = pk2(vv[2], vv[3]); *(u32x2*)((l == 0 ? vfirst : vfin) + ch) = o; }
        f32x4 vw, vvv;
#pragma unroll
        for (int i = 0; i < 4; ++i) { vw[i] = __expf(-0.60653066f * sigm(dbias[i] + aD[i])); vvv[i] = vv[i]; }
        *(LAS f32x4*)(rs_ + co) = vw; *(LAS f32x4*)(rs_ + 64 + co) = vvv;
    }
}
__device__ __forceinline__ void prep_y(int l, int b, int h, int dir, int c, LAS float* rg, const LAS float* cst, int lane) {
    PREP_COMMON();
    const bf16* Wi = (const bf16*)(ws + OFF_WIC) + (size_t)dir * DM * 64;
    u32x4 cir[2][3];
#pragma unroll
    for (int ks = 0; ks < 2; ++ks) { const bf16* q = rawA + 3200 + 64 * dir + 32 * ks + 8 * fq; cir[ks][0] = *(const u32x4*)q; cir[ks][1] = *(const u32x4*)(q + dp); cir[ks][2] = *(const u32x4*)(q + dn); }
    u32x4 wir[4][2]; u32x2 kr[4][3], rr_[4][3];
#pragma unroll
    for (int nb = 0; nb < 4; ++nb) { const int chr = h * 64 + nb * 16 + fr;
#pragma unroll
        for (int ks = 0; ks < 2; ++ks) wir[nb][ks] = *(const u32x4*)(Wi + (size_t)chr * 64 + 32 * ks + 8 * fq);
        const bf16* q = rawA + h * 64 + nb * 16 + 4 * fq;
        rr_[nb][0] = *(const u32x2*)q; rr_[nb][1] = *(const u32x2*)(q + dp); rr_[nb][2] = *(const u32x2*)(q + dn);
        kr[nb][0] = *(const u32x2*)(q + 1024); kr[nb][1] = *(const u32x2*)(q + 1024 + dp); kr[nb][2] = *(const u32x2*)(q + 1024 + dn); }
    __builtin_amdgcn_sched_barrier(0);
    bf16x8 bi[2];
#pragma unroll
    for (int ks = 0; ks < 2; ++ks) {
        float o[8]; const int cc = 128 + 64 * dir + 32 * ks + 8 * fq;
        ZERO_ENDS4(cir[ks]);
        mix8p(cir[ks][0], cir[ks][1], cir[ks][2], cst + C_CMP + cc, cst + C_CMN + cc, o);
        bi[ks] = pack8(o);
    }
    float kk[16]; float ss = 0.f;
#pragma unroll
    for (int nb = 0; nb < 4; ++nb) {
        const int co = nb * 16 + 4 * fq;
        ZERO_ENDS2(kr[nb]);
        mix4p(kr[nb][0], kr[nb][1], kr[nb][2], cst + C_RMP + 64 + co, cst + C_RMN + 64 + co, kk + 4 * nb);
        const f32x4 kkw = *(const LAS f32x4*)(cst + C_KK + co);
#pragma unroll
        for (int i = 0; i < 4; ++i) { const float kr_ = kk[4 * nb + i] * kkw[i]; ss += kr_ * kr_; }
    }
    ss += __shfl_xor(ss, 16); ss += __shfl_xor(ss, 32);
    const float nrm = rsqrtf(ss + 1e-12f);
    float cs = 0.f;
#pragma unroll
    for (int nb = 0; nb < 4; ++nb) {
        f32x4 aI = {0.f, 0.f, 0.f, 0.f};
#pragma unroll
        for (int ks = 0; ks < 2; ++ks) aI = MFMA16(__builtin_bit_cast(bf16x8, wir[nb][ks]), bi[ks], aI);
        const int co = nb * 16 + 4 * fq;
        float rr[4];
        ZERO_ENDS2(rr_[nb]);
        mix4p(rr_[nb][0], rr_[nb][1], rr_[nb][2], cst + C_RMP + co, cst + C_RMN + co, rr);
        const f32x4 ibias = *(const LAS f32x4*)(cst + C_IB + 64 * dir + co);
        const f32x4 kkw = *(const LAS f32x4*)(cst + C_KK + co), kaw = *(const LAS f32x4*)(cst + C_KA + co), rkw = *(const LAS f32x4*)(cst + C_RK + co);
        f32x4 va, vb, vkd, vr;
#pragma unroll
        for (int i = 0; i < 4; ++i) {
            const float al = sigm(ibias[i] + aI[i]);
            const float kraw = kk[4 * nb + i];
            const float kn = kraw * kkw[i] * nrm;
            const float kd = kraw * (1.0f + (al - 1.0f) * kaw[i]);
            va[i] = -kn; vb[i] = kn * al; vkd[i] = kd; vr[i] = rr[i];
            cs += rr[i] * kd * rkw[i];
        }
        *(LAS u32x4*)(rs_ + 128 + co) = (u32x4){cvtpk(0.25f * vb[0], 0.25f * vkd[0]), cvtpk(0.25f * vb[1], 0.25f * vkd[1]), cvtpk(0.25f * vb[2], 0.25f * vkd[2]), cvtpk(0.25f * vb[3], 0.25f * vkd[3])};
        *(LAS u32x2*)(rs_ + 192 + (co >> 1)) = (u32x2){cvtpk(va[0], va[1]), cvtpk(va[2], va[3])};
        *(LAS u32x2*)(rs_ + 224 + (co >> 1)) = (u32x2){cvtpk(vr[0], vr[1]), cvtpk(vr[2], vr[3])};
    }
    cs += __shfl_xor(cs, 16); cs += __shfl_xor(cs, 32);
    if (fq == 0) ((float*)(ws + OFF_COEF))[((size_t)dir * T + row) * 16 + h] = cs;
}
#define PREP_ROLE(jw, cc, slot) do { if (((jw) >> 1) == 0) prep_x(l, b, h, (jw) & 1, (cc), ring + (size_t)((slot) * 2 + ((jw) & 1)) * CHS * RSTEP, cst, lane); \
                                     else prep_y(l, b, h, (jw) & 1, (cc), ring + (size_t)((slot) * 2 + ((jw) & 1)) * CHS * RSTEP, cst, lane); } while (0)

#define SCHEDB() __builtin_amdgcn_sched_barrier(0)
__device__ __forceinline__ void swap16(float& a, float& b) { const auto r = __builtin_amdgcn_permlane16_swap(__builtin_bit_cast(unsigned, a), __builtin_bit_cast(unsigned, b), false, false); a = __builtin_bit_cast(float, (unsigned)r[0]); b = __builtin_bit_cast(float, (unsigned)r[1]); }
__device__ __forceinline__ void swap32(float& a, float& b) { const auto r = __builtin_amdgcn_permlane32_swap(__builtin_bit_cast(unsigned, a), __builtin_bit_cast(unsigned, b), false, false); a = __builtin_bit_cast(float, (unsigned)r[0]); b = __builtin_bit_cast(float, (unsigned)r[1]); }
__device__ __forceinline__ float scatter4(float p0, float p1) { swap16(p0, p1); float z = p0 + p1, z2 = z; swap32(z, z2); return z + z2; }
#define SCAN_DOTS(AH0, AH1, D0, D1) do { \
        const u32x4 b00 = {cvtpk(c[0][0].x, c[0][0].y), cvtpk(c[0][0].z, c[0][0].w), cvtpk(c[1][0].x, c[1][0].y), cvtpk(c[1][0].z, c[1][0].w)}; \
        const u32x4 b01 = {cvtpk(c[2][0].x, c[2][0].y), cvtpk(c[2][0].z, c[2][0].w), cvtpk(c[3][0].x, c[3][0].y), cvtpk(c[3][0].z, c[3][0].w)}; \
        const u32x4 b10 = {cvtpk(c[0][1].x, c[0][1].y), cvtpk(c[0][1].z, c[0][1].w), cvtpk(c[1][1].x, c[1][1].y), cvtpk(c[1][1].z, c[1][1].w)}; \
        const u32x4 b11 = {cvtpk(c[2][1].x, c[2][1].y), cvtpk(c[2][1].z, c[2][1].w), cvtpk(c[3][1].x, c[3][1].y), cvtpk(c[3][1].z, c[3][1].w)}; \
        D0 = MFMA16(__builtin_bit_cast(bf16x8, AH0), __builtin_bit_cast(bf16x8, b00), ((f32x4){0.f, 0.f, 0.f, 0.f})); D0 = MFMA16(__builtin_bit_cast(bf16x8, AH1), __builtin_bit_cast(bf16x8, b01), D0); \
        D1 = MFMA16(__builtin_bit_cast(bf16x8, AH0), __builtin_bit_cast(bf16x8, b10), ((f32x4){0.f, 0.f, 0.f, 0.f})); D1 = MFMA16(__builtin_bit_cast(bf16x8, AH1), __builtin_bit_cast(bf16x8, b11), D1); } while (0)
#define SCAN_LD_AV(AH0, AH1, P) do { const u32x2 q0 = *(const LAS u32x2*)((P) + 0), q1 = *(const LAS u32x2*)((P) + 8), q2 = *(const LAS u32x2*)((P) + 16), q3 = *(const LAS u32x2*)((P) + 24); \
        AH0 = (u32x4){q0.x, q0.y, q1.x, q1.y}; AH1 = (u32x4){q2.x, q2.y, q3.x, q3.y}; } while (0)
#define SCAN_STEP(S_, CW, CBK, NW, NBK) do { \
        const int sn = (S_) + 1 < CHS ? (S_) + 1 : (S_); const LAS float* nstep = sl + sn * RSTEP; \
        const LAS float* avp = (asel ? nstep + 192 : sl + (S_) * RSTEP + 224) + 2 * mg;        \
        u32x4 ah0, ah1; SCAN_LD_AV(ah0, ah1, avp); \
        _Pragma("unroll") for (int kt = 0; kt < 4; ++kt) { NW[kt] = *(const LAS f32x4*)(nstep + 16 * kt + 4 * mg); NBK[kt] = ((const LAS unsigned*)nstep)[128 + 16 * kt + v16]; } \
        const float vn0 = vb[sn * RSTEP], vn1 = vb[sn * RSTEP + 16]; \
        SCHEDB(); \
        { bx0.x = cvtpk(x0, v0); bx1.x = cvtpk(x1, v1);     \
        _Pragma("unroll") for (int kt = 0; kt < 4; ++kt) { \
            at.x = CBK[kt]; \
            const f32x4 i0 = MFMA16(__builtin_bit_cast(bf16x8, at), __builtin_bit_cast(bf16x8, bx0), ((f32x4){0.f, 0.f, 0.f, 0.f})); \
            const f32x4 i1 = MFMA16(__builtin_bit_cast(bf16x8, at), __builtin_bit_cast(bf16x8, bx1), ((f32x4){0.f, 0.f, 0.f, 0.f})); \
            _Pragma("unroll") for (int i = 0; i < 4; ++i) { float r0 = __builtin_fmaf(c[kt][0][i], CW[kt][i], i0[i]), r1 = __builtin_fmaf(c[kt][1][i], CW[kt][i], i1[i]); \
                asm("" : "+v"(r0), "+v"(r1));     \
                c[kt][0][i] = r0; c[kt][1][i] = r1; } } } \
        SCHEDB(); \
        { f32x4 d0, d1; SCAN_DOTS(ah0, ah1, d0, d1); \
        x0 = d0[1]; x1 = d1[1]; \
        if (lane < 32) ybuf[(S_) * 32 + lane] = mg == 0 ? d0[0] : d1[0];     } \
        v0 = vn0; v1 = vn1; \
        SCHEDB(); } while (0)
__device__ __forceinline__ void scan_chunk(f32x4 (&c)[4][2], const LAS float* sl  , int rh, LAS float* ybuf  , int lane) {
    const int mg = lane >> 4, v16 = lane & 15;
    const bool asel = (lane & 3) == 1;
    const LAS float* vb = sl + 64 + 32 * rh + v16;
    f32x4 wA[4], wB[4]; unsigned bkA[4], bkB[4];
    u32x4 at = {0u, 0u, 0u, 0u}, bx0 = {0u, 0u, 0u, 0u}, bx1 = {0u, 0u, 0u, 0u};
    float x0, x1;
    {
        u32x4 ah0, ah1; SCAN_LD_AV(ah0, ah1, sl + 192 + 2 * mg);
#pragma unroll
        for (int kt = 0; kt < 4; ++kt) { wA[kt] = *(const LAS f32x4*)(sl + 16 * kt + 4 * mg); bkA[kt] = ((const LAS unsigned*)sl)[128 + 16 * kt + v16]; }
        f32x4 d0, d1; SCAN_DOTS(ah0, ah1, d0, d1);
        x0 = asel ? d0[1] : d0[0]; x1 = asel ? d1[1] : d1[0];
    }
    float v0 = vb[0], v1 = vb[16];
#pragma unroll 1
    for (int s = 0; s < CHS; s += 2) {
        SCAN_STEP(s, wA, bkA, wB, bkB);
        SCAN_STEP(s + 1, wB, bkB, wA, bkA);
    }
}

#define Y_T(dir_, cc, s) ((dir_) == 0 ? (cc) * CHS + (s) : SEQ - 1 - (cc) * CHS - (s))
__device__ __forceinline__ void yflush_issue(unsigned (&yo)[4], const bf16* yb2  , int dir, int cc, int lane) {
    const int rg = lane >> 4;
    if (cc >= NCH / 2) {
#pragma unroll
        for (int i = 0; i < 4; ++i) yo[i] = *(const unsigned*)(yb2 + (size_t)Y_T(dir, cc, 4 * i + rg) * DM);
    } else {
#pragma unroll
        for (int i = 0; i < 4; ++i) yo[i] = 0u;
    }
}
__device__ __forceinline__ void yflush_finish(const unsigned (&yo)[4], bf16* yb2, const LAS float* ybuf  , int dir, int cc, int lane) {
    const int rg = lane >> 4, cp = lane & 15;
#pragma unroll
    for (int i = 0; i < 4; ++i) { const int s = 4 * i + rg; const f32x2 yv = *(const LAS f32x2*)(ybuf + s * 32 + 2 * cp);
        *(unsigned*)(yb2 + (size_t)Y_T(dir, cc, s) * DM) = pk2(yv.x + bflo(yo[i]), yv.y + bfhi(yo[i])); }
}

__device__ __forceinline__ void scan_phase(int l, LAS unsigned char* lds, int wave, int lane) {
    asm volatile("" : "+v"(lane));
    unsigned char* ws = KARG()->ws;
    LAS float* ring = (LAS float*)(lds + 32768);
    for (int bh = blockIdx.x; bh < BATCH * 16; bh += gridDim.x) {
        const int b = bh >> 4, h = bh & 15;
        LAS f32x4* sts = (LAS f32x4*)lds + (wave & 3) * 512 + lane;
        LAS float* cst = (LAS float*)(lds + CST_OFF);
        LAS float* ybw = (LAS float*)(lds + 133120) + (wave & 3) * 2 * CHS * 32;
        const int dirw = wave & 1, rhw = (wave >> 1) & 1;
        bf16* yb2 = (bf16*)(ws + OFF_YS) + (size_t)b * SEQ * DM + h * 64 + 32 * rhw + 2 * (lane & 15);
        prep_consts(l, h, cst);
        LDS_WAIT(); __syncthreads();
        f32x4 st[4][2];
#pragma unroll
        for (int k = 0; k < 8; ++k) st[k >> 1][k & 1] = (f32x4){0.f, 0.f, 0.f, 0.f};
        if (wave >= 4) PREP_ROLE(wave - 4, 0, 0);
        LDS_WAIT(); __syncthreads();
#pragma unroll 1
        for (int c = 0; c < NCH; ++c) {
            if (wave < 4) {
                scan_chunk(st, ring + (size_t)((c & 1) * 2 + dirw) * CHS * RSTEP, rhw, ybw + (c & 1) * CHS * 32, lane);
            } else {
                unsigned yo[4];
                if (c > 0) yflush_issue(yo, yb2, dirw, c - 1, lane);
                if (c + 1 < NCH) PREP_ROLE(wave - 4, c + 1, (c + 1) & 1);
                if (c > 0) yflush_finish(yo, yb2, ybw + ((c - 1) & 1) * CHS * 32, dirw, c - 1, lane);
            }
            if (c == NCH / 2) VM_WAIT(); else asm volatile("s_waitcnt vmcnt(4)" ::: "memory");
            LDS_WAIT(); __syncthreads();
        }
        if (wave >= 4) { unsigned yo[4]; yflush_issue(yo, yb2, dirw, NCH - 1, lane); yflush_finish(yo, yb2, ybw + ((NCH - 1) & 1) * CHS * 32, dirw, NCH - 1, lane); }
        VM_WAIT(); __syncthreads();
    }
}

__device__ __forceinline__ void postscan_phase(int l, int gw, int NGW, int lane) {
    asm volatile("" : "+s"(NGW), "+s"(gw));
    asm volatile("" : "+v"(lane));
    const CAS Params* p = KARG(); unsigned char* ws = p->ws;
    const bf16* vcur = (const bf16*)(ws + (l == 0 ? OFF_VFIRST : OFF_VFIN));
    const float* coef = (const float*)(ws + OFF_COEF);
    const int ch = 16 * lane, hd = lane >> 2;
    f32x4 g4[4], b4[4];
#pragma unroll
    for (int i = 0; i < 4; ++i) { g4[i] = *(const f32x4*)(p->in[I_LG] + (size_t)l * DM + ch + 4 * i); b4[i] = *(const f32x4*)(p->in[I_LB] + (size_t)l * DM + ch + 4 * i); }
    for (int m0 = gw; m0 < T; m0 += 2 * NGW) {
        u32x4 yr[2][2], vr[2][2]; float cf[2];
#pragma unroll
        for (int r = 0; r < 2; ++r) { const int m = m0 + r * NGW < T ? m0 + r * NGW : m0;
            const bf16* yp = (const bf16*)(ws + OFF_YS) + (size_t)m * DM + ch; const bf16* vp = vcur + (size_t)m * DM + ch;
            yr[r][0] = *(const u32x4*)yp; yr[r][1] = *(const u32x4*)(yp + 8); vr[r][0] = *(const u32x4*)vp; vr[r][1] = *(const u32x4*)(vp + 8);
            cf[r] = coef[(size_t)m * 16 + hd] + coef[((size_t)T + m) * 16 + hd]; }
#pragma unroll
        for (int r = 0; r < 2; ++r) { const int m = m0 + r * NGW; if (m < T) {
            float y[16], v[16];
            unpack8(yr[r][0], y); unpack8(yr[r][1], y + 8); unpack8(vr[r][0], v); unpack8(vr[r][1], v + 8);
            float sm = 0.f;
#pragma unroll
            for (int i = 0; i < 16; ++i) sm += y[i];
            sm += __shfl_xor(sm, 1); sm += __shfl_xor(sm, 2);
            const float mean = sm * (1.f / 64.f); float q = 0.f;
#pragma unroll
            for (int i = 0; i < 16; ++i) { y[i] -= mean; q += y[i] * y[i]; }
            q += __shfl_xor(q, 1); q += __shfl_xor(q, 2);
            const float rstd = rsqrtf(q * (1.f / 64.f) + 64e-5f);
            float o[16];
#pragma unroll
            for (int i = 0; i < 16; i += 4)
#pragma unroll
                for (int j = 0; j < 4; ++j) o[i + j] = y[i + j] * rstd * g4[i >> 2][j] + b4[i >> 2][j] + cf[r] * v[i + j];
            bf16* yp = (bf16*)(ws + OFF_YS) + (size_t)m * DM + ch;
            *(u32x4*)yp = pack8u(o); *(u32x4*)(yp + 8) = pack8u(o + 8); } }
    }
}

__device__ __forceinline__ float ret_log2g(int h) { const float e = exp2f(-5.0f - (float)h); return -1.4426950408889634f * (e + e * e * (0.5f + e * (0.33333333f + e * 0.25f))); }
constexpr int KP = 136;
constexpr int QP = 72;
__device__ __forceinline__ void stage_vt(const bf16* rawB, int b, int h, int j, LAS bf16* Vt, int tid) {
    const int m = tid >> 2, part = tid & 3;
    const bf16* src = rawB + ((size_t)b * SEQ + j * RC + m) * 2048 + 1024 + h * 128 + 32 * part;
#pragma unroll
    for (int q = 0; q < 4; ++q) { float f[8]; const u32x4 u = *(const u32x4*)(src + 8 * q);
        const unsigned w[4] = {u.x, u.y, u.z, u.w};
#pragma unroll
        for (int i = 0; i < 4; ++i) { Vt[(32 * part + 8 * q + 2 * i) * KP + m] = (bf16)(w[i] & 0xffffu); Vt[(32 * part + 8 * q + 2 * i + 1) * KP + m] = (bf16)(w[i] >> 16); }
        (void)f; }
}
__device__ __forceinline__ void rot8(const bf16* src, const float* rot, int pos, int part, float scale, float* o1, float* o2) {
    float x1[8], x2[8]; unpack8(*(const u32x4*)(src + 8 * part), x1); unpack8(*(const u32x4*)(src + 32 + 8 * part), x2);
    const float* cs = rot + (size_t)pos * 32 + 8 * part; const float* sn = rot + (size_t)2048 * 32 + (size_t)pos * 32 + 8 * part;
    const f32x4 c0 = *(const f32x4*)cs, c1 = *(const f32x4*)(cs + 4), s0 = *(const f32x4*)sn, s1 = *(const f32x4*)(sn + 4);
    const float cv[8] = {c0.x, c0.y, c0.z, c0.w, c1.x, c1.y, c1.z, c1.w}, sv[8] = {s0.x, s0.y, s0.z, s0.w, s1.x, s1.y, s1.z, s1.w};
#pragma unroll
    for (int i = 0; i < 8; ++i) { o1[i] = (x1[i] * cv[i] - x2[i] * sv[i]) * scale; o2[i] = (x1[i] * sv[i] + x2[i] * cv[i]) * scale; }
}
__device__ __forceinline__ void ret_states_phase(LAS unsigned char* lds, int wave, int lane_) {
    int tid = threadIdx.x; asm volatile("" : "+v"(tid)); const int lane = tid & 63;
    const CAS Params* p = KARG(); unsigned char* ws = p->ws; const int fr = lane & 15, fq = lane >> 4;
    const bf16* rawB = (const bf16*)(ws + OFF_RAWB); const float* rot = (const float*)(ws + OFF_ROT);
    LAS bf16* Kt = (LAS bf16*)lds; LAS bf16* Vt = (LAS bf16*)(lds + 64 * KP * 2);
    const int m = tid >> 2, part = tid & 3;
    for (int it = blockIdx.x; it < BATCH * 8 * 2; it += gridDim.x) {
        const int dir = it & 1, bh = it >> 1, b = bh >> 3, h = bh & 7;
        const float l2g = ret_log2g(h), dC = exp2f(l2g * (float)RC);
        const float z = exp2f(l2g * (float)(dir == 0 ? RC - 1 - m : m));
        f32x4 acc[4];
#pragma unroll
        for (int nb = 0; nb < 4; ++nb) acc[nb] = (f32x4){0.f, 0.f, 0.f, 0.f};
        u32x4 kx1, kx2, vraw[4]; f32x4 c0, c1, s0, s1;
#define R1_LOAD(J_) do { const int pos_ = (J_) * RC + m; const bf16* row_ = rawB + ((size_t)b * SEQ + pos_) * 2048; \
            kx1 = *(const u32x4*)(row_ + 512 + h * 64 + 8 * part); kx2 = *(const u32x4*)(row_ + 512 + h * 64 + 32 + 8 * part); \
            _Pragma("unroll") for (int q = 0; q < 4; ++q) vraw[q] = *(const u32x4*)(row_ + 1024 + h * 128 + 32 * part + 8 * q); \
            const float* cs_ = rot + (size_t)pos_ * 32 + 8 * part; const float* sn_ = cs_ + (size_t)2048 * 32; \
            c0 = *(const f32x4*)cs_; c1 = *(const f32x4*)(cs_ + 4); s0 = *(const f32x4*)sn_; s1 = *(const f32x4*)(sn_ + 4); } while (0)
        R1_LOAD(dir == 0 ? 0 : NRC - 1);
#pragma unroll 1
        for (int jj = 0; jj < NRC; ++jj) {
            const int j = dir == 0 ? jj : NRC - 1 - jj;
            bf16* so = (bf16*)(ws + OFF_ST) + ((size_t)(bh * NRC + j) * 2 + dir) * 8192;
#pragma unroll
            for (int nb = 0; nb < 4; ++nb)
#pragma unroll
                for (int i = 0; i < 4; ++i) { so[(16 * wave + 4 * fq + i) * 64 + nb * 16 + fr] = (bf16)f2bf(acc[nb][i]); acc[nb][i] *= dC; }
            {
                float x1[8], x2[8]; unpack8(kx1, x1); unpack8(kx2, x2);
                const float cv[8] = {c0.x, c0.y, c0.z, c0.w, c1.x, c1.y, c1.z, c1.w}, sv[8] = {s0.x, s0.y, s0.z, s0.w, s1.x, s1.y, s1.z, s1.w};
#pragma unroll
                for (int i = 0; i < 8; ++i) { Kt[(8 * part + i) * KP + m] = (bf16)f2bf((x1[i] * cv[i] - x2[i] * sv[i]) * z); Kt[(32 + 8 * part + i) * KP + m] = (bf16)f2bf((x1[i] * sv[i] + x2[i] * cv[i]) * z); }
#pragma unroll
                for (int q = 0; q < 4; ++q) { const unsigned w[4] = {vraw[q].x, vraw[q].y, vraw[q].z, vraw[q].w};
#pragma unroll
                    for (int i = 0; i < 4; ++i) { Vt[(32 * part + 8 * q + 2 * i) * KP + m] = (bf16)(w[i] & 0xffffu); Vt[(32 * part + 8 * q + 2 * i + 1) * KP + m] = (bf16)(w[i] >> 16); } }
            }
            LDS_WAIT(); __syncthreads();
            if (jj + 1 < NRC) R1_LOAD(dir == 0 ? jj + 1 : NRC - 2 - jj);
#pragma unroll
            for (int ks = 0; ks < 4; ++ks) {
                const bf16x8 av = *(const LAS bf16x8*)(Vt + (16 * wave + fr) * KP + 32 * ks + 8 * fq);
#pragma unroll
                for (int nb = 0; nb < 4; ++nb) { const bf16x8 bk = *(const LAS bf16x8*)(Kt + (nb * 16 + fr) * KP + 32 * ks + 8 * fq); acc[nb] = MFMA16(av, bk, acc[nb]); }
            }
            LDS_WAIT(); __syncthreads();
        }
#undef R1_LOAD
    }
}
__device__ __forceinline__ void ret_out_phase(int l, LAS unsigned char* lds, int wave, int lane_) {
    int tid = threadIdx.x; asm volatile("" : "+v"(tid)); const int lane = tid & 63;
    const CAS Params* p = KARG(); unsigned char* ws = p->ws; const int fr = lane & 15, fq = lane >> 4;
    const bf16* rawB = (const bf16*)(ws + OFF_RAWB); const float* rot = (const float*)(ws + OFF_ROT);
    LAS bf16* Qs = (LAS bf16*)lds; LAS bf16* Ks = (LAS bf16*)(lds + 128 * QP * 2); LAS bf16* Vt = (LAS bf16*)(lds + 2 * 128 * QP * 2); LAS bf16* Pw = (LAS bf16*)(lds + 2 * 128 * QP * 2 + 128 * KP * 2) + wave * 16 * KP;
    for (int it = blockIdx.x; it < BATCH * 8 * NRC; it += gridDim.x) {
        const int j = it % NRC, bh = it / NRC, b = bh >> 3, h = bh & 7;
        const float l2g = ret_log2g(h);
        const __amdgpu_buffer_rsrc_t strs = __builtin_amdgcn_make_buffer_rsrc((void*)(ws + OFF_ST), 0, 0x7fffffff, 0x00027000);
        const unsigned sfo = (unsigned)(((bh * NRC + j) * 2 + 0) * 8192 * 2);
        u32x4 sfv[4][2], sbv[4][2];
#define RET_LD_STATES(g) do { _Pragma("unroll") for (int o4 = 0; o4 < 4; ++o4) _Pragma("unroll") for (int ks = 0; ks < 2; ++ks) { \
            const unsigned eo = sfo + (unsigned)((((4 * (g) + o4) * 16 + fr) * 64 + 32 * ks + 8 * fq) * 2); \
            sfv[o4][ks] = __builtin_amdgcn_raw_buffer_load_b128(strs, eo, 0, 0x11); sbv[o4][ks] = __builtin_amdgcn_raw_buffer_load_b128(strs, eo + 16384u, 0, 0x11); } } while (0)
        RET_LD_STATES(0);
        {
            const int m = tid >> 2, part = tid & 3; const int pos = j * RC + m;
            const bf16* src = rawB + ((size_t)b * SEQ + pos) * 2048 + h * 64;
            float o1[8], o2[8];
            rot8(src, rot, pos, part, 0.125f, o1, o2);
            *(LAS u32x4*)(Qs + m * QP + 8 * part) = pack8u(o1); *(LAS u32x4*)(Qs + m * QP + 32 + 8 * part) = pack8u(o2);
            rot8(src + 512, rot, pos, part, 1.0f, o1, o2);
            *(LAS u32x4*)(Ks + m * QP + 8 * part) = pack8u(o1); *(LAS u32x4*)(Ks + m * QP + 32 + 8 * part) = pack8u(o2);
            stage_vt(rawB, b, h, j, Vt, tid);
        }
        LDS_WAIT(); __syncthreads();
        bf16x8 aq[2];
#pragma unroll
        for (int ks = 0; ks < 2; ++ks) aq[ks] = *(const LAS bf16x8*)(Qs + (16 * wave + fr) * QP + 32 * ks + 8 * fq);
#pragma unroll
        for (int nb = 0; nb < 8; ++nb) {
            f32x4 sc = {0.f, 0.f, 0.f, 0.f};
#pragma unroll
            for (int ks = 0; ks < 2; ++ks) { const bf16x8 bk = *(const LAS bf16x8*)(Ks + (nb * 16 + fr) * QP + 32 * ks + 8 * fq); sc = MFMA16(aq[ks], bk, sc); }
#pragma unroll
            for (int i = 0; i < 4; ++i) { const int n = 16 * wave + 4 * fq + i, mk = nb * 16 + fr; const int d = n > mk ? n - mk : mk - n;
                Pw[(4 * fq + i) * KP + mk] = (bf16)f2bf(sc[i] * __builtin_amdgcn_exp2f(l2g * (float)d)); }
        }
        LDS_WAIT(); asm volatile("" ::: "memory");
        f32x4 y1[8];
        f32x4 xfv, xbv;
#pragma unroll
        for (int i = 0; i < 4; ++i) { const int nl = 16 * wave + 4 * fq + i; xfv[i] = __builtin_amdgcn_exp2f(l2g * (float)(nl + 1)); xbv[i] = __builtin_amdgcn_exp2f(l2g * (float)(RC - nl)); }
        bf16x8 ap[4];
#pragma unroll
        for (int ks = 0; ks < 4; ++ks) ap[ks] = *(const LAS bf16x8*)(Pw + fr * KP + 32 * ks + 8 * fq);
#pragma unroll
        for (int g = 0; g < 2; ++g) {
            if (g == 1) { RET_LD_STATES(1); }
#pragma unroll
            for (int o4 = 0; o4 < 4; ++o4) {
                const int ob = 4 * g + o4;
                f32x4 y2 = {0.f, 0.f, 0.f, 0.f}, y3 = y2; y1[ob] = y2;
#pragma unroll
                for (int ks = 0; ks < 4; ++ks) { const bf16x8 bvv = *(const LAS bf16x8*)(Vt + (ob * 16 + fr) * KP + 32 * ks + 8 * fq); y1[ob] = MFMA16(ap[ks], bvv, y1[ob]); }
#pragma unroll
                for (int ks = 0; ks < 2; ++ks) { y2 = MFMA16(aq[ks], __builtin_bit_cast(bf16x8, sfv[o4][ks]), y2); y3 = MFMA16(aq[ks], __builtin_bit_cast(bf16x8, sbv[o4][ks]), y3); }
                y1[ob] = y1[ob] + xfv * y2 + xbv * y3;
            }
            asm volatile("" ::: "memory");
        }
#pragma unroll
        for (int i = 0; i < 4; ++i) {
            const int nl = 16 * wave + 4 * fq + i;
            float v[8]; float s = 0.f;
#pragma unroll
            for (int ob = 0; ob < 8; ++ob) { v[ob] = y1[ob][i]; s += v[ob]; }
            s += __shfl_xor(s, 1); s += __shfl_xor(s, 2); s += __shfl_xor(s, 4); s += __shfl_xor(s, 8);
            const float mean = s * (1.f / 128.f); float q = 0.f;
#pragma unroll
            for (int ob = 0; ob < 8; ++ob) { v[ob] -= mean; q += v[ob] * v[ob]; }
            q += __shfl_xor(q, 1); q += __shfl_xor(q, 2); q += __shfl_xor(q, 4); q += __shfl_xor(q, 8);
            const float rstd = rsqrtf(q * (1.f / 128.f) + 1e-6f);
            bf16* yo = (bf16*)(ws + OFF_YB) + ((size_t)b * SEQ + j * RC + nl) * DM + h * 128;
            const float* gn = p->in[I_RG] + (size_t)l * DM + h * 128;
#pragma unroll
            for (int ob = 0; ob < 8; ++ob) yo[ob * 16 + fr] = (bf16)f2bf(v[ob] * rstd * gn[ob * 16 + fr]);
        }
        __syncthreads();
    }
}

#define XB_TMO      128
#define XB_XCNT(j)  (256  + 64 * (j))
#define XB_XSUB(j)  (1280 + 64 * (j))
#define XB_XGEN(j)  (2304 + 64 * (j))
#define XB_TOP      3328
#define XB_TOPGEN   3392
#define XCD_BAR_WORDS 3456
#define XB_SPIN_CAP (1u << 18)

__device__ __forceinline__ unsigned xb_ld(unsigned* p)              { return __hip_atomic_load(p, __ATOMIC_RELAXED, __HIP_MEMORY_SCOPE_AGENT); }
__device__ __forceinline__ unsigned xb_add(unsigned* p, unsigned v) { return __hip_atomic_fetch_add(p, v, __ATOMIC_RELAXED, __HIP_MEMORY_SCOPE_AGENT); }
__device__ __forceinline__ unsigned xb_xcc_id() { return (unsigned)__builtin_amdgcn_s_getreg((3 << 11) | 20) & 0xFu; }
#define XB_SPIN(cond, bar) do { unsigned _sp = 0; while (cond) { __builtin_amdgcn_s_sleep(1); \
    if ((++_sp & 255u) == 0u) { if (xb_ld(&(bar)[XB_TMO])) break; if (_sp > XB_SPIN_CAP) { atomicAdd(&(bar)[XB_TMO], 1u); break; } } } } while (0)

struct XcdBarrier {
    unsigned* bar; unsigned x;
    volatile LAS unsigned* st;
};

__device__ __forceinline__ XcdBarrier xcd_barrier_post(unsigned* bar, volatile LAS unsigned* st) {
    XcdBarrier b; b.bar = bar; b.x = xb_xcc_id(); b.st = st;
    if (threadIdx.x == 0) (void)xb_add(&bar[XB_XCNT(b.x)], 1u);
    return b;
}
__device__ __forceinline__ void xcd_barrier_complete(unsigned* bar, unsigned x, unsigned& nloc, unsigned& nx) {
    const unsigned G = gridDim.x * gridDim.y * gridDim.z;
    unsigned sum, cnt, mine, sp = 0u;
    for (;;) {
        sum = 0u; cnt = 0u; mine = 0u;
#pragma unroll
        for (unsigned j = 0; j < 16; ++j) { const unsigned c = xb_ld(&bar[XB_XCNT(j)]); sum += c; cnt += (c > 0u) ? 1u : 0u; mine = (j == x) ? c : mine; }
        if (sum == G) break;
        __builtin_amdgcn_s_sleep(1);
        if ((++sp & 255u) == 0u) { if (xb_ld(&bar[XB_TMO])) break; if (sp > XB_SPIN_CAP) { atomicAdd(&bar[XB_TMO], 1u); break; } }
    }
    nloc = mine > 0u ? mine : 1u; nx = cnt > 0u ? cnt : 1u;
}

__device__ __forceinline__ void xcd_barrier(const XcdBarrier& b) {
    asm volatile("s_waitcnt vmcnt(0)" ::: "memory");
    __syncthreads();
    if (threadIdx.x == 0) {
        unsigned* bar = b.bar;
        __builtin_amdgcn_s_waitcnt(0);
        unsigned nloc = b.st[0], nx = b.st[1];
        if (nloc == 0u) { xcd_barrier_complete(bar, b.x, nloc, nx); b.st[0] = nloc; b.st[1] = nx; }
        const unsigned old = xb_add(&bar[XB_XSUB(b.x)], 1u);
        const unsigned gen = old / nloc;
        if (old + 1u == (gen + 1u) * nloc) {
            __builtin_amdgcn_fence(__ATOMIC_RELEASE, "agent");
            asm volatile("s_waitcnt vmcnt(0)" ::: "memory");
            const unsigned og = xb_add(&bar[XB_TOP], 1u);
            const unsigned tg = og / nx;
            if (og + 1u == (tg + 1u) * nx) xb_add(&bar[XB_TOPGEN], 1u);
            else XB_SPIN(xb_ld(&bar[XB_TOPGEN]) == tg, bar);
            __builtin_amdgcn_fence(__ATOMIC_ACQUIRE, "agent");
            xb_add(&bar[XB_XGEN(b.x)], 1u);
            asm volatile("s_waitcnt vmcnt(0)" ::: "memory");
        } else {
            XB_SPIN(xb_ld(&bar[XB_XGEN(b.x)]) == gen, bar);
            __builtin_amdgcn_fence(__ATOMIC_ACQUIRE, "agent");
            asm volatile("s_waitcnt vmcnt(0)" ::: "memory");
        }
    }
    __syncthreads();
}

#ifndef PHMASK
#define PHMASK 0xFFFF
#endif
#define PH(n) if constexpr ((PHMASK >> (n)) & 1)
#define GSYNC_CG() do { asm volatile("s_waitcnt vmcnt(0) lgkmcnt(0)" ::: "memory"); __syncthreads(); grid.sync(); __builtin_amdgcn_fence(__ATOMIC_ACQUIRE, "agent"); asm volatile("s_waitcnt vmcnt(0)" ::: "memory"); } while (0)
#define GSYNC() xcd_barrier(xbar)
__global__ void __launch_bounds__(512, 2) hybrid_fwd(Params p_unused) {
    extern __shared__ __attribute__((aligned(16))) unsigned char lds_raw[];
    LAS unsigned char* lds = (LAS unsigned char*)lds_raw;
    cg::grid_group grid = cg::this_grid();
    const int tid = threadIdx.x, lane = tid & 63, wave = __builtin_amdgcn_readfirstlane(tid >> 6);
    const int gw = blockIdx.x * 8 + wave, NGW = gridDim.x * 8;
    { volatile LAS unsigned* stw = (volatile LAS unsigned*)(lds + XB_LDS_OFF); if (threadIdx.x < 2) stw[threadIdx.x] = 0u; }
    __syncthreads();
    XcdBarrier xbar = xcd_barrier_post((unsigned*)KARG()->ws, (volatile LAS unsigned*)(lds + XB_LDS_OFF));
    GSYNC_CG();
    {
        float* rot = (float*)(KARG()->ws + OFF_ROT);
        for (int i = gw * 64 + lane; i < 2048 * 32; i += NGW * 64) { const int pos = i >> 5, jf = i & 31;
            const float fr_ = exp2f(-(float)jf * (13.287712379549449f / 32.0f)); float rev = (float)pos * fr_ * 0.15915494309189535f; rev -= rintf(rev);
            rot[i] = __builtin_amdgcn_cosf(rev); rot[2048 * 32 + i] = __builtin_amdgcn_sinf(rev); }
    }
#pragma unroll 1
    for (int l = 0; l < DEPTH; ++l) {
#define XIN (l == 0 ? KARG()->in[I_X] : (const float*)KARG()->out)
#define WSP(off) (KARG()->ws + (off))
        PH(0) convert_weights(l, lds, gw, NGW, wave, lane);
        PH(1) norm_phase(XIN, KARG()->in[I_NG] + (size_t)l * DM, (bf16*)WSP(OFF_XB), gw, NGW, lane);
        GSYNC();
        PH(2) run_gemm(lds, (const bf16*)WSP(OFF_XB), (const bf16*)WSP(OFF_WA), NA, FStoreA{(bf16*)WSP(OFF_RAWA)});
        GSYNC();
        PH(3) scan_phase(l, lds, wave, lane);
        GSYNC();
        PH(4) postscan_phase(l, gw, NGW, lane);
        PH(5) run_gemm(lds, (const bf16*)WSP(OFF_XB), (const bf16*)WSP(OFF_WB), 2048, FStoreB{(bf16*)WSP(OFF_RAWB)});
        GSYNC();
        PH(6) ret_states_phase(lds, wave, lane);
        GSYNC();
        PH(7) ret_out_phase(l, lds, wave, lane);
        GSYNC();
        PH(8) run_gemm(lds, (const bf16*)WSP(OFF_XB), (const bf16*)WSP(OFF_WG), 4096, FGates{(bf16*)WSP(OFF_YS), (bf16*)WSP(OFF_YB), (bf16*)WSP(OFF_SIGA), (bf16*)WSP(OFF_SIGB)});
        GSYNC();
        PH(9) run_gemm(lds, (const bf16*)WSP(OFF_YS), (const bf16*)WSP(OFF_Wa), DM, FGa{(const bf16*)WSP(OFF_SIGA), (bf16*)WSP(OFF_M1)});
        PH(10) run_gemm(lds, (const bf16*)WSP(OFF_YB), (const bf16*)WSP(OFF_Wb), DM, FGb{(const bf16*)WSP(OFF_SIGB), (const bf16*)WSP(OFF_M1), (bf16*)WSP(OFF_MG)});
        GSYNC();
        PH(11) run_gemm(lds, (const bf16*)WSP(OFF_MG), (const bf16*)WSP(OFF_Wo), DM, FGo{XIN, KARG()->out});
        GSYNC();
    }
    final_norm(KARG()->out, KARG()->in[I_FG], gw, NGW, lane);
}

extern "C" void kernel_launch(void* const* d_in, const int* in_sizes, int n_in, void* d_out, int out_size, void* d_ws, size_t ws_size, hipStream_t stream) {
    static int grid = 0;
    if (grid == 0) {
        if (n_in != 22 || ws_size < WS_END) { fprintf(stderr, "kernel_launch: unexpected n_in %d / ws_size %zu (need %zu)\n", n_in, ws_size, (size_t)WS_END); grid = -1; return; }
        int dev = 0, cus = 0, per_cu = 0;
        (void)hipGetDevice(&dev); (void)hipDeviceGetAttribute(&cus, hipDeviceAttributeMultiprocessorCount, dev);
        (void)hipFuncSetAttribute((const void*)hybrid_fwd, hipFuncAttributeMaxDynamicSharedMemorySize, LDS_BYTES);
        (void)hipOccupancyMaxActiveBlocksPerMultiprocessor(&per_cu, (const void*)hybrid_fwd, 512, LDS_BYTES);
        if (per_cu < 1) per_cu = 1;
        grid = cus * per_cu;
        (void)hipGetLastError();
    }
    if (grid < 0) return;
    Params p{};
    for (int i = 0; i < 22; ++i) p.in[i] = (const float*)d_in[i];
    p.out = (float*)d_out; p.ws = (unsigned char*)d_ws;
    if (hipMemsetAsync(d_ws, 0, 16384, stream) != hipSuccess) { fprintf(stderr, "kernel_launch: hipMemsetAsync of the barrier words failed\n"); return; }
    void* args[] = {&p};
    hipError_t e = hipLaunchCooperativeKernel((const void*)hybrid_fwd, dim3(grid), dim3(512), args, LDS_BYTES, stream);
    if (e != hipSuccess) fprintf(stderr, "cooperative launch failed: %s (grid %d)\n", hipGetErrorString(e), grid);
}
```

```cpp
#include <hip/hip_runtime.h>
#include <hip/hip_cooperative_groups.h>
#include <cstdio>
#include <cstdint>
namespace cg = cooperative_groups;
namespace pg8 {
#define PG8_LAS __attribute__((address_space(3)))
typedef unsigned short bf16_t;
typedef short bf16x8 __attribute__((ext_vector_type(8)));
typedef float f32x4 __attribute__((ext_vector_type(4)));
typedef unsigned u32x4 __attribute__((ext_vector_type(4)));
constexpr int BM = 256, BK = 64, HALF = 128, HTB = HALF * BK * 2  , STAGE_BYTES = 8 * HTB, NXCD = 8, WGM = 8;

__host__ __device__ __forceinline__ int lds_byte(int r, int c) { const int st = (r >> 4) * 2 + (c >> 5), rr = r & 15, cc = c & 31, ob = rr * 64 + cc * 2; return st * 1024 + (ob ^ (((ob >> 9) & 1) << 5)); }
__host__ __device__ __forceinline__ void stage_rc(int b, int& R, int& C) { const int st = b / 1024, sb = b % 1024, swz = sb ^ (((sb >> 9) & 1) << 5); R = (st >> 1) * 16 + swz / 64; C = (st & 1) * 32 + (swz % 64) / 2; }
__host__ __device__ __forceinline__ int perm32(int rho) { const int n = rho >> 4, i = rho & 15; return 8 * (i >> 2) + 4 * n + (i & 3); }

struct Unit { int pm, pn; };
struct Gemm { const bf16_t* A; const bf16_t* Bt; int M, N, K; };

struct StaticOrder {
    int nM, nN, nwg, G, c;
    __host__ __device__ void init(int M, int N, int G_, int c_) { nM = M / BM; nN = N / BM; nwg = nM * nN; G = G_; c = c_; }
    __host__ __device__ bool next(int i, Unit& u) const {
        const long L = (long)i * G + c; if (L >= nwg) return false;
        int wgid = (int)L; { const int q = nwg / NXCD, r = nwg % NXCD, xcd = wgid % NXCD, off = wgid / NXCD; wgid = (xcd < r ? xcd * (q + 1) : r * (q + 1) + (xcd - r) * q) + off; }
        const int nig = WGM * nN, gid = wgid / nig, fm = gid * WGM, gsz = (nM - fm) < WGM ? (nM - fm) : WGM;
        u.pm = fm + ((wgid % nig) % gsz); u.pn = (wgid % nig) / gsz; return true;
    }
    __device__ __forceinline__ void a_ready(const Unit&) const {}
    __device__ __forceinline__ void done(const Unit&) const {}
};
__device__ __forceinline__ unsigned cvt_pk_bf16(float lo, float hi) { unsigned r; asm volatile("v_cvt_pk_bf16_f32 %0, %1, %2" : "=v"(r) : "v"(lo), "v"(hi)); return r; }
typedef float f32x2 __attribute__((ext_vector_type(2)));
template <class Epi, class Sched, bool ALIGN_EPI = false, bool SP2 = false>
__device__ __forceinline__ void gemm_phase(PG8_LAS unsigned char* lds, const Gemm g, const Sched& S, const Epi& E) {
    int tid_ = threadIdx.x; asm volatile("" : "+v"(tid_));
    const int tid = tid_, wid = __builtin_amdgcn_readfirstlane(tid >> 6), lane = tid & 63, wr = wid >> 2, wc = wid & 3, fr = lane & 15, fq = lane >> 4;
    const int K = g.K, nt = K / BK;
    unsigned voffA[2], voffB[2];
#pragma unroll
    for (int i = 0; i < 2; ++i) { int R, C; stage_rc(tid * 16 + i * 8192, R, C); const int Rb = Epi::PERM ? ((R & ~31) + perm32(R & 31)) : R;
        voffA[i] = (unsigned)(R * K + C) * 2u; voffB[i] = (unsigned)(Rb * K + C) * 2u; }
    const size_t kstep = (size_t)(BK * 2);
    const size_t hstep = (size_t)HALF * K * 2;
    const size_t tstep = 2 * hstep;
    const unsigned ldsw = (unsigned)wid * 1024u;
    const int aoff = lds_byte(wr * 64 + fr, fq * 8), boff = lds_byte(wc * 32 + fr, fq * 8);
#define PG8_SA(b, h) (((b) * 2 + (h)) * HTB)
#define PG8_SB(b, h) ((4 + (b) * 2 + (h)) * HTB)
#define PG8_STAGE(bufoff, gbase, voff) do { _Pragma("unroll") for (int _i = 0; _i < 2; ++_i) \
        __builtin_amdgcn_global_load_lds((const unsigned*)((const char*)(gbase) + (voff)[_i]), (PG8_LAS unsigned*)(lds + (bufoff) + ldsw + _i * 8192), 16, 0, 0); } while (0)
#define PG8_LDA(dst, b, h) do { _Pragma("unroll") for (int m = 0; m < 4; ++m) _Pragma("unroll") for (int k = 0; k < 2; ++k) dst[m][k] = *(const PG8_LAS bf16x8*)(lds + PG8_SA(b, h) + aoff + m * 2048 + k * 1024); } while (0)
#define PG8_LDB(dst, b, h) do { _Pragma("unroll") for (int n = 0; n < 2; ++n) _Pragma("unroll") for (int k = 0; k < 2; ++k) dst[n][k] = *(const PG8_LAS bf16x8*)(lds + PG8_SB(b, h) + boff + n * 2048 + k * 1024); } while (0)
#define PG8_MMA(ai, bj, At, Bt) do { __builtin_amdgcn_s_setprio(1); _Pragma("unroll") for (int m = 0; m < 4; ++m) _Pragma("unroll") for (int n = 0; n < 2; ++n) _Pragma("unroll") for (int k = 0; k < 2; ++k) \
        acc[ai][bj][m][n] = __builtin_amdgcn_mfma_f32_16x16x32_bf16(Bt[n][k], At[m][k], acc[ai][bj][m][n], 0, 0, 0); __builtin_amdgcn_s_setprio(0); } while (0)
#define PG8_WAIT_V(n) asm volatile("s_waitcnt vmcnt(" #n ")" ::: "memory")
#define PG8_WAIT_L(n) asm volatile("s_waitcnt lgkmcnt(" #n ")" ::: "memory")
#define PG8_BAR __builtin_amdgcn_s_barrier()
#define PG8_SCHED __builtin_amdgcn_sched_barrier(0)
    Unit cur, nxt; int ui = 0;
    if (!S.next(0, cur)) return;
    f32x4 acc[2][2][4][2];
#pragma unroll
    for (int a = 0; a < 2; ++a)
#pragma unroll
        for (int b = 0; b < 2; ++b)
#pragma unroll
            for (int m = 0; m < 4; ++m)
#pragma unroll
                for (int n = 0; n < 2; ++n) acc[a][b][m][n] = (f32x4){0.f, 0.f, 0.f, 0.f};
    bf16x8 At[4][2], B0[2][2], B1[2][2];
    const char* cA = (const char*)g.A + (size_t)cur.pm * tstep; const char* cB = (const char*)g.Bt + (size_t)cur.pn * tstep;
    S.a_ready(cur);
    if constexpr (SP2) {
        PG8_STAGE(PG8_SB(0, 0), cB, voffB); PG8_STAGE(PG8_SB(0, 1), cB + hstep, voffB); PG8_STAGE(PG8_SA(0, 0), cA, voffA); PG8_STAGE(PG8_SA(0, 1), cA + hstep, voffA);
        if (wr == 1) PG8_BAR;
        PG8_WAIT_V(2); PG8_BAR;
        PG8_STAGE(PG8_SB(1, 0), cB + kstep, voffB); PG8_STAGE(PG8_SA(1, 0), cA + kstep, voffA); PG8_STAGE(PG8_SB(1, 1), cB + hstep + kstep, voffB);
        PG8_WAIT_V(6); PG8_BAR;
    } else {
        PG8_STAGE(PG8_SB(0, 0), cB, voffB); PG8_STAGE(PG8_SA(0, 0), cA, voffA); PG8_STAGE(PG8_SB(0, 1), cB + hstep, voffB); PG8_STAGE(PG8_SA(0, 1), cA + hstep, voffA);
        if (wr == 1) PG8_BAR;
        PG8_WAIT_V(4); PG8_BAR;
        PG8_STAGE(PG8_SB(1, 0), cB + kstep, voffB); PG8_STAGE(PG8_SA(1, 0), cA + kstep, voffA); PG8_STAGE(PG8_SB(1, 1), cB + hstep + kstep, voffB);
        PG8_WAIT_V(6); PG8_BAR;
    }
    for (;;) {
        const bool has_next = S.next(ui + 1, nxt);
        const char* nA = has_next ? (const char*)g.A + (size_t)nxt.pm * tstep : cA; const char* nB = has_next ? (const char*)g.Bt + (size_t)nxt.pn * tstep : cB;
        for (int t = 0; t < nt; t += 2) {
            const bool last = (t == nt - 2);
            const char* a1 = cA + (size_t)(t + 1) * kstep;
            const char* a2 = last ? nA : cA + (size_t)(t + 2) * kstep; const char* b2 = last ? nB : cB + (size_t)(t + 2) * kstep;
            const char* a3 = a2 + kstep; const char* b3 = b2 + kstep;
            if (last && has_next) S.a_ready(nxt);
            if constexpr (SP2) {
            PG8_LDB(B0, 0, 0); PG8_LDB(B1, 0, 1); PG8_SCHED; PG8_LDA(At, 0, 0); PG8_STAGE(PG8_SA(1, 1), a1 + hstep, voffA);
            PG8_WAIT_V(8); PG8_WAIT_L(0); PG8_BAR; PG8_MMA(0, 0, At, B0); PG8_MMA(0, 1, At, B1); PG8_BAR; PG8_SCHED;
            PG8_LDA(At, 0, 1); PG8_STAGE(PG8_SB(0, 0), b2, voffB); PG8_STAGE(PG8_SB(0, 1), b2 + hstep, voffB); PG8_STAGE(PG8_SA(0, 0), a2, voffA);
            PG8_WAIT_V(8); PG8_WAIT_L(0); PG8_BAR; PG8_MMA(1, 0, At, B0); PG8_MMA(1, 1, At, B1); PG8_BAR; PG8_SCHED;
            PG8_LDB(B0, 1, 0); PG8_LDB(B1, 1, 1); PG8_SCHED; PG8_LDA(At, 1, 0); PG8_STAGE(PG8_SA(0, 1), a2 + hstep, voffA);
            PG8_WAIT_V(8); PG8_WAIT_L(0); PG8_BAR; PG8_MMA(0, 0, At, B0); PG8_MMA(0, 1, At, B1); PG8_BAR; PG8_SCHED;
            PG8_LDA(At, 1, 1); PG8_STAGE(PG8_SB(1, 0), b3, voffB); PG8_STAGE(PG8_SB(1, 1), b3 + hstep, voffB); PG8_STAGE(PG8_SA(1, 0), a3, voffA);
            PG8_WAIT_V(8); PG8_WAIT_L(0); PG8_BAR; PG8_MMA(1, 0, At, B0); PG8_MMA(1, 1, At, B1); PG8_BAR; PG8_SCHED;
            } else {
            PG8_LDB(B0, 0, 0); PG8_SCHED; PG8_LDA(At, 0, 0); PG8_STAGE(PG8_SA(1, 1), a1 + hstep, voffA);
            PG8_WAIT_L(8); PG8_BAR; PG8_WAIT_L(0); PG8_MMA(0, 0, At, B0); PG8_BAR; PG8_SCHED;
            PG8_LDB(B1, 0, 1); PG8_STAGE(PG8_SB(0, 0), b2, voffB);
            PG8_BAR; PG8_WAIT_L(0); PG8_MMA(0, 1, At, B1); PG8_BAR;
            PG8_LDA(At, 0, 1); PG8_STAGE(PG8_SA(0, 0), a2, voffA);
            PG8_BAR; PG8_WAIT_L(0); PG8_MMA(1, 0, At, B0); PG8_BAR; PG8_SCHED;
            PG8_STAGE(PG8_SB(0, 1), b2 + hstep, voffB);
            PG8_WAIT_V(6); PG8_BAR; PG8_MMA(1, 1, At, B1); PG8_BAR;
            PG8_LDB(B0, 1, 0); PG8_SCHED; PG8_LDA(At, 1, 0); PG8_STAGE(PG8_SA(0, 1), a2 + hstep, voffA);
            PG8_WAIT_L(8); PG8_BAR; PG8_WAIT_L(0); PG8_MMA(0, 0, At, B0); PG8_BAR; PG8_SCHED;
            PG8_LDB(B1, 1, 1); PG8_STAGE(PG8_SB(1, 0), b3, voffB);
            PG8_BAR; PG8_WAIT_L(0); PG8_MMA(0, 1, At, B1); PG8_BAR;
            PG8_LDA(At, 1, 1); PG8_STAGE(PG8_SA(1, 0), a3, voffA);
            PG8_BAR; PG8_WAIT_L(0); PG8_MMA(1, 0, At, B0); PG8_BAR; PG8_SCHED;
            PG8_STAGE(PG8_SB(1, 1), b3 + hstep, voffB);
            PG8_WAIT_V(6); PG8_BAR; PG8_MMA(1, 1, At, B1); PG8_BAR;
            }
        }
        if constexpr (ALIGN_EPI) { if (wr == 0) PG8_BAR; }
        if constexpr (!Epi::AFTER_DRAIN) { E(acc, cur, wr, wc, fr, fq); S.done(cur); }
        if (!has_next) break;
#pragma unroll
        for (int a = 0; a < 2; ++a)
#pragma unroll
            for (int b = 0; b < 2; ++b)
#pragma unroll
                for (int m = 0; m < 4; ++m)
#pragma unroll
                    for (int n = 0; n < 2; ++n) acc[a][b][m][n] = (f32x4){0.f, 0.f, 0.f, 0.f};
        cur = nxt; cA = nA; cB = nB; ++ui;
        if constexpr (ALIGN_EPI) { if (wr == 1) PG8_BAR; }
    }
    PG8_WAIT_V(0);
    if constexpr (!ALIGN_EPI) { if (wr == 0) PG8_BAR; }
    PG8_BAR;
    if constexpr (Epi::AFTER_DRAIN) { E.fused(acc, cur, wr, wc, fr, fq, lds, wid, lane); S.done(cur); }
#undef PG8_SA
#undef PG8_SB
#undef PG8_STAGE
#undef PG8_LDA
#undef PG8_LDB
#undef PG8_MMA
#undef PG8_WAIT_V
#undef PG8_WAIT_L
#undef PG8_BAR
#undef PG8_SCHED
}
}
#define PG8_SP2 true
#define PG8_ALIGN true
#define GAS __attribute__((address_space(1)))
#define LAS __attribute__((address_space(3)))
#define CAS __attribute__((address_space(4)))
typedef unsigned short bf16;
typedef unsigned u32x4 __attribute__((ext_vector_type(4)));
typedef unsigned u32x2 __attribute__((ext_vector_type(2)));
typedef float f32x4 __attribute__((ext_vector_type(4)));
typedef float f32x2 __attribute__((ext_vector_type(2)));
typedef short bf16x8 __attribute__((ext_vector_type(8)));
#define LDS_WAIT() asm volatile("s_waitcnt lgkmcnt(0)" ::: "memory")
#define VM_WAIT() asm volatile("s_waitcnt vmcnt(0)" ::: "memory")

constexpr int BATCH = 16, SEQ = 2048, DM = 1024, DEPTH = 4, T = BATCH * SEQ;
constexpr int NIN = 9472;
constexpr int NA = 3584, LDA = 3360;
constexpr int CHS = 16, NCH = SEQ / CHS;
constexpr int RSTEP = 260;
constexpr int RC = 128, NRC = SEQ / RC;
constexpr size_t MiB = 1u << 20;
constexpr size_t OFF_WA = 2 * MiB, OFF_WB = 9 * MiB, OFF_WG = 13 * MiB, OFF_Wa = 21 * MiB, OFF_Wb = 23 * MiB, OFF_Wo = 25 * MiB;
constexpr size_t OFF_WDEC = 27 * MiB, OFF_WIC = OFF_WDEC + 256 * 1024, OFF_WVR = OFF_WIC + 256 * 1024, OFF_ROT = OFF_WVR + 64 * 1024;
constexpr size_t OFF_VFIRST = 29 * MiB, OFF_VFIN = 93 * MiB, OFF_YS = 157 * MiB, OFF_COEF = 221 * MiB, OFF_XB = 225 * MiB, OFF_RAWA = 289 * MiB;
constexpr size_t OFF_YB = OFF_VFIN;
constexpr size_t OFF_RAWB = OFF_RAWA, OFF_ST = OFF_RAWA + 128 * MiB;
constexpr size_t OFF_SIGA = OFF_RAWA, OFF_SIGB = OFF_RAWA + 64 * MiB, OFF_M1 = OFF_ST, OFF_MG = OFF_XB;
constexpr size_t OFF_COEF2 = 499 * MiB;
constexpr size_t WS_END = 503 * MiB;
static_assert(OFF_ROT + 2 * 2048 * 32 * 4 <= OFF_VFIRST, "small region");
static_assert(32768 + 2 * 2 * CHS * RSTEP * 4 <= 133120, "scan LDS map");
static_assert(OFF_RAWA + (size_t)T * LDA * 2 <= WS_END, "rawA");
constexpr int XB_LDS_OFF = 133120 + 16384 + 6144;
constexpr int LDS_BYTES = XB_LDS_OFF + 64;

enum { I_X = 0, I_NG, I_WIN, I_WVD, I_SP, I_SN, I_WDU, I_DB, I_WIU, I_IB, I_WVU, I_VB, I_KK, I_KA, I_RK, I_LG, I_LB, I_WBA, I_RG, I_WBB, I_WO, I_FG };
struct Params { const float* in[22]; float* out; unsigned char* ws; };
#define KARG() ({ const CAS Params* kp_ = (const CAS Params*)__builtin_amdgcn_kernarg_segment_ptr(); asm volatile("" : "+s"(kp_)); kp_; })

typedef __bf16 bf16x2_t __attribute__((ext_vector_type(2)));
__device__ __forceinline__ unsigned cvtpk(float lo, float hi) { const f32x2 v = {lo, hi}; const bf16x2_t b = __builtin_convertvector(v, bf16x2_t); return __builtin_bit_cast(unsigned, b); }
__device__ __forceinline__ unsigned pk2(float lo, float hi) { return cvtpk(lo, hi); }
__device__ __forceinline__ unsigned f2bf(float f) { return cvtpk(f, 0.f) & 0xffffu; }
__device__ __forceinline__ float bflo(unsigned u) { return __builtin_bit_cast(float, u << 16); }
__device__ __forceinline__ float bfhi(unsigned u) { return __builtin_bit_cast(float, u & 0xffff0000u); }
__device__ __forceinline__ float bf1(bf16 h) { return __builtin_bit_cast(float, (unsigned)h << 16); }
__device__ __forceinline__ void unpack8(u32x4 u, float* o) { o[0] = bflo(u.x); o[1] = bfhi(u.x); o[2] = bflo(u.y); o[3] = bfhi(u.y); o[4] = bflo(u.z); o[5] = bfhi(u.z); o[6] = bflo(u.w); o[7] = bfhi(u.w); }
__device__ __forceinline__ void unpack4(u32x2 u, float* o) { o[0] = bflo(u.x); o[1] = bfhi(u.x); o[2] = bflo(u.y); o[3] = bfhi(u.y); }
__device__ __forceinline__ u32x4 pack8u(const float* f) { u32x4 u; u.x = pk2(f[0], f[1]); u.y = pk2(f[2], f[3]); u.z = pk2(f[4], f[5]); u.w = pk2(f[6], f[7]); return u; }
__device__ __forceinline__ bf16x8 pack8(const float* f) { return __builtin_bit_cast(bf16x8, pack8u(f)); }
__device__ __forceinline__ float sigm(float x) { return __builtin_amdgcn_rcpf(1.0f + __expf(-x)); }
__device__ __forceinline__ float wave_sum(float v) {
#pragma unroll
    for (int o = 1; o < 64; o <<= 1) v += __shfl_xor(v, o);
    return v;
}
#define MFMA16(a, b, c) __builtin_amdgcn_mfma_f32_16x16x32_bf16((a), (b), (c), 0, 0, 0)

__device__ __forceinline__ void tr_item(const float* W, int ldw, int K, bf16* WT, int item, int nblk, LAS float* scr, int lane) {
    const int kb = item / nblk, nb = item % nblk, k0 = 64 * kb, n0 = 32 * nb;
    float wv[32];
#pragma unroll
    for (int i = 0; i < 32; ++i) wv[i] = W[(size_t)(k0 + 2 * i + (lane >> 5)) * ldw + n0 + (lane & 31)];
#pragma unroll
    for (int i = 0; i < 32; ++i) scr[(2 * i + (lane >> 5)) * 33 + (lane & 31)] = wv[i];
    LDS_WAIT(); asm volatile("" ::: "memory");
    const int c = lane & 7;
#pragma unroll
    for (int j = 0; j < 4; ++j) { const int n = (lane >> 3) + 8 * j; const LAS float* s = scr + (8 * c) * 33 + n;
        u32x4 o; o.x = pk2(s[0 * 33], s[1 * 33]); o.y = pk2(s[2 * 33], s[3 * 33]); o.z = pk2(s[4 * 33], s[5 * 33]); o.w = pk2(s[6 * 33], s[7 * 33]);
        *(u32x4*)(WT + (size_t)(n0 + n) * K + k0 + 8 * c) = o; }
    LDS_WAIT(); asm volatile("" ::: "memory");
}

__device__ __forceinline__ void convert_weights(int l, LAS unsigned char* lds, int gw, int NGW, int wave, int lane) {
    asm volatile("" : "+s"(NGW), "+s"(gw));
    asm volatile("" : "+v"(lane));
    const CAS Params* p = KARG(); unsigned char* ws = p->ws;
    LAS float* scr = (LAS float*)(lds + wave * 16384);
    const float* win = p->in[I_WIN] + (size_t)l * DM * NIN;
    bf16* WA = (bf16*)(ws + OFF_WA); bf16* WB = (bf16*)(ws + OFF_WB); bf16* WG = (bf16*)(ws + OFF_WG);
    constexpr int S1 = 16 * 104, S2 = 16 * 64, S3 = 16 * 32, S4 = 16 * 96, S5 = 512, S8 = 16, S10 = 32;
    constexpr int NIT = S1 + S2 + S3 + S4 + 3 * S5 + S8 + 4 * S10;
    for (int it = gw; it < NIT; it += NGW) {
        int r = it;
        if (r < S1) { tr_item(win, NIN, DM, WA, r, 104, scr, lane); continue; } r -= S1;
        if (r < S2) { tr_item(win + 4352, NIN, DM, WB, r, 64, scr, lane); continue; } r -= S2;
        if (r < S3) { tr_item(win + 3328, NIN, DM, WG, r, 32, scr, lane); continue; } r -= S3;
        if (r < S4) { tr_item(win + 6400, NIN, DM, WG + (size_t)1024 * DM, r, 96, scr, lane); continue; } r -= S4;
        if (r < S5) { tr_item(p->in[I_WBA] + (size_t)l * DM * DM, DM, DM, (bf16*)(ws + OFF_Wa), r, 32, scr, lane); continue; } r -= S5;
        if (r < S5) { tr_item(p->in[I_WBB] + (size_t)l * DM * DM, DM, DM, (bf16*)(ws + OFF_Wb), r, 32, scr, lane); continue; } r -= S5;
        if (r < S5) { tr_item(p->in[I_WO] + (size_t)l * DM * DM, DM, DM, (bf16*)(ws + OFF_Wo), r, 32, scr, lane); continue; } r -= S5;
        if (r < S8) { if (l > 0) tr_item(p->in[I_WVD] + (size_t)(l - 1) * DM * 32, 32, DM, WA + (size_t)3328 * DM, r, 1, scr, lane); continue; } r -= S8;
        { const int which = r / S10, rr = r % S10;
          const float* src = (which < 2 ? p->in[I_WDU] : p->in[I_WIU]) + ((size_t)l * 2 + (which & 1)) * 64 * DM;
          bf16* dst = (bf16*)(ws + (which < 2 ? OFF_WDEC : OFF_WIC)) + (size_t)(which & 1) * DM * 64;
          tr_item(src, DM, 64, dst, rr, 32, scr, lane); }
    }
    const int gt = gw * 64 + lane, NGT = NGW * 64;
    if (l == 0) {
        u32x4* z = (u32x4*)(WA + (size_t)3328 * DM); const u32x4 zero = {0u, 0u, 0u, 0u};
        for (int i = gt; i < 256 * DM * 2 / 16; i += NGT) z[i] = zero;
    } else {
        const float* src = p->in[I_WVU] + (size_t)(l - 1) * 32 * DM; bf16* dst = (bf16*)(ws + OFF_WVR);
        for (int i = gt; i < 32 * DM; i += NGT) { const int n = i >> 5, k = i & 31; dst[i] = (bf16)f2bf(src[(size_t)k * DM + n]); }
    }
}

__device__ __forceinline__ void norm_phase(const float* x, const float* gain, bf16* xb, int gw, int NGW, int lane) {
    asm volatile("" : "+s"(NGW), "+s"(gw));
    asm volatile("" : "+v"(lane));
    for (int m0 = gw; m0 < T; m0 += 4 * NGW) {
        f32x4 v[4][4]; float ss[4];
#pragma unroll
        for (int r = 0; r < 4; ++r) { const int m = m0 + r * NGW < T ? m0 + r * NGW : m0; const f32x4* xr = (const f32x4*)(x + (size_t)m * DM) + lane;
#pragma unroll
            for (int j = 0; j < 4; ++j) v[r][j] = xr[64 * j]; }
#pragma unroll
        for (int r = 0; r < 4; ++r) { float q = 0.f;
#pragma unroll
            for (int j = 0; j < 4; ++j) q += (v[r][j].x * v[r][j].x + v[r][j].y * v[r][j].y) + (v[r][j].z * v[r][j].z + v[r][j].w * v[r][j].w);
            ss[r] = q; }
#pragma unroll
        for (int o = 1; o < 64; o <<= 1) {
#pragma unroll
            for (int r = 0; r < 4; ++r) ss[r] += __shfl_xor(ss[r], o); }
#pragma unroll
        for (int r = 0; r < 4; ++r) { const int m = m0 + r * NGW; if (m < T) {
            const float rs = rsqrtf(ss[r] * (1.f / DM) + 1e-6f);
            u32x2* o8 = (u32x2*)(xb + (size_t)m * DM) + lane;
#pragma unroll
            for (int j = 0; j < 4; ++j) { const f32x4 g = ((const f32x4*)gain)[lane + 64 * j]; u32x2 o; o.x = pk2(v[r][j].x * rs * g.x, v[r][j].y * rs * g.y); o.y = pk2(v[r][j].z * rs * g.z, v[r][j].w * rs * g.w); o8[64 * j] = o; } } }
    }
}
__device__ __forceinline__ void final_norm(float* x, const float* gain, int gw, int NGW, int lane) {
    asm volatile("" : "+s"(NGW), "+s"(gw));
    asm volatile("" : "+v"(lane));
    for (int m0 = gw; m0 < T; m0 += 4 * NGW) {
        f32x4 v[4][4]; float ss[4];
#pragma unroll
        for (int r = 0; r < 4; ++r) { const int m = m0 + r * NGW < T ? m0 + r * NGW : m0; const f32x4* xr = (const f32x4*)(x + (size_t)m * DM) + lane;
#pragma unroll
            for (int j = 0; j < 4; ++j) v[r][j] = xr[64 * j]; }
#pragma unroll
        for (int r = 0; r < 4; ++r) { float q = 0.f;
#pragma unroll
            for (int j = 0; j < 4; ++j) q += (v[r][j].x * v[r][j].x + v[r][j].y * v[r][j].y) + (v[r][j].z * v[r][j].z + v[r][j].w * v[r][j].w);
            ss[r] = q; }
#pragma unroll
        for (int o = 1; o < 64; o <<= 1) {
#pragma unroll
            for (int r = 0; r < 4; ++r) ss[r] += __shfl_xor(ss[r], o); }
#pragma unroll
        for (int r = 0; r < 4; ++r) { const int m = m0 + r * NGW; if (m < T) {
            const float rs = rsqrtf(ss[r] * (1.f / DM) + 1e-6f);
            f32x4* xr = (f32x4*)(x + (size_t)m * DM) + lane;
#pragma unroll
            for (int j = 0; j < 4; ++j) { const f32x4 g = ((const f32x4*)gain)[lane + 64 * j]; xr[64 * j] = v[r][j] * rs * g; } } }
    }
}

template <class F> struct EpiGen {
    static constexpr bool PERM = true, AFTER_DRAIN = false;
    F f;
    __device__ __forceinline__ void operator()(const pg8::f32x4 (&acc)[2][2][4][2], const pg8::Unit& u, int wr, int wc, int fr, int fq) const {
        const int row0 = u.pm * 256 + wr * 64 + fr, col0 = u.pn * 256 + wc * 32 + 8 * fq;
#pragma unroll
        for (int ai = 0; ai < 2; ++ai) {
            u32x4 ld[4][2][2];
#pragma unroll
            for (int m = 0; m < 4; ++m)
#pragma unroll
                for (int bj = 0; bj < 2; ++bj) { ld[m][bj][0] = (u32x4){0u, 0u, 0u, 0u}; ld[m][bj][1] = (u32x4){0u, 0u, 0u, 0u}; }
#pragma unroll
            for (int m = 0; m < 4; ++m)
#pragma unroll
                for (int bj = 0; bj < 2; ++bj) f.pre(row0 + ai * 128 + m * 16, col0 + bj * 128, ld[m][bj]);
            __builtin_amdgcn_sched_barrier(0);
#pragma unroll
            for (int m = 0; m < 4; ++m)
#pragma unroll
                for (int bj = 0; bj < 2; ++bj) {
                    float v[8];
#pragma unroll
                    for (int i = 0; i < 4; ++i) { v[i] = acc[ai][bj][m][0][i]; v[4 + i] = acc[ai][bj][m][1][i]; }
                    f.fin(row0 + ai * 128 + m * 16, col0 + bj * 128, v, ld[m][bj]);
                }
            __builtin_amdgcn_sched_barrier(0);
        }
    }
};
struct FStoreA { bf16* O;
    __device__ __forceinline__ void pre(int, int, u32x4 (&)[2]) const {}
    __device__ __forceinline__ void fin(int row, int col, const float* v, const u32x4 (&)[2]) const { if (col < LDA) *(u32x4*)(O + (size_t)row * LDA + col) = pack8u(v); } };
struct FStoreB { bf16* O;
    __device__ __forceinline__ void pre(int, int, u32x4 (&)[2]) const {}
    __device__ __forceinline__ void fin(int row, int col, const float* v, const u32x4 (&)[2]) const { *(u32x4*)(O + (size_t)row * 2048 + col) = pack8u(v); } };
struct FGates { unsigned char* ws;
    __device__ __forceinline__ bf16* buf(int reg) const {
        const size_t o = (reg == 0 ? OFF_YS : (size_t)0) + (reg == 1 ? OFF_YB : (size_t)0) + (reg == 2 ? OFF_SIGA : (size_t)0) + (reg == 3 ? OFF_SIGB : (size_t)0);
        return (bf16*)(ws + o); }
    __device__ __forceinline__ void pre(int row, int col, u32x4 (&ld)[2]) const {
        const int reg = col >> 10, c = col & 1023;
        ld[0] = *(const u32x4*)(buf(reg) + (size_t)row * DM + c); }
    __device__ __forceinline__ void fin(int row, int col, const float* v, const u32x4 (&ld)[2]) const {
        const int reg = col >> 10, c = col & 1023; bf16* dst = buf(reg) + (size_t)row * DM + c; float o[8], yv[8]; unpack8(ld[0], yv);
#pragma unroll
        for (int i = 0; i < 8; ++i) { const float sg = sigm(v[i]); o[i] = reg < 2 ? yv[i] * v[i] * sg : sg; }
        *(u32x4*)dst = pack8u(o);
    } };
struct FGa { const bf16* sg; bf16* m1;
    __device__ __forceinline__ void pre(int row, int col, u32x4 (&ld)[2]) const { ld[0] = *(const u32x4*)(sg + (size_t)row * DM + col); }
    __device__ __forceinline__ void fin(int row, int col, const float* v, const u32x4 (&ld)[2]) const {
        const size_t off = (size_t)row * DM + col; float g[8], o[8]; unpack8(ld[0], g);
#pragma unroll
        for (int i = 0; i < 8; ++i) o[i] = g[i] * v[i];
        *(u32x4*)(m1 + off) = pack8u(o); } };
struct FGb { const bf16* sg; const bf16* m1; bf16* mg;
    __device__ __forceinline__ void pre(int row, int col, u32x4 (&ld)[2]) const { const size_t off = (size_t)row * DM + col; ld[0] = *(const u32x4*)(sg + off); ld[1] = *(const u32x4*)(m1 + off); }
    __device__ __forceinline__ void fin(int row, int col, const float* v, const u32x4 (&ld)[2]) const {
        const size_t off = (size_t)row * DM + col; float g[8], a[8], o[8]; unpack8(ld[0], g); unpack8(ld[1], a);
#pragma unroll
        for (int i = 0; i < 8; ++i) o[i] = a[i] + g[i] * v[i];
        *(u32x4*)(mg + off) = pack8u(o); } };
struct FGo { const float* xo; float* xn;
    __device__ __forceinline__ void pre(int row, int col, u32x4 (&ld)[2]) const { const size_t off = (size_t)row * DM + col; ld[0] = *(const u32x4*)(xo + off); ld[1] = *(const u32x4*)(xo + off + 4); }
    __device__ __forceinline__ void fin(int row, int col, const float* v, const u32x4 (&ld)[2]) const {
        const size_t off = (size_t)row * DM + col; const f32x4 a = __builtin_bit_cast(f32x4, ld[0]), b = __builtin_bit_cast(f32x4, ld[1]);
        f32x4 o0 = {a.x + v[0], a.y + v[1], a.z + v[2], a.w + v[3]}, o1 = {b.x + v[4], b.y + v[5], b.z + v[6], b.w + v[7]};
        *(f32x4*)(xn + off) = o0; *(f32x4*)(xn + off + 4) = o1; } };

template <class F> __device__ __forceinline__ void run_gemm(LAS unsigned char* lds, const bf16* A, const bf16* Bt, int N, const F& f) {
    pg8::Gemm g{A, Bt, T, N, DM}; pg8::StaticOrder S; S.init(T, N, (int)gridDim.x, (int)blockIdx.x);
    EpiGen<F> E{f};
    pg8::gemm_phase<EpiGen<F>, pg8::StaticOrder, PG8_ALIGN, PG8_SP2>(lds, g, S, E);
}
constexpr int CST_OFF = 133120 + 16384;
constexpr int C_CMP = 0, C_CMN = 256;
constexpr int C_RMP = 512, C_RMN = 704;
constexpr int C_DB = 896, C_IB = 1024;
constexpr int C_KK = 1152, C_KA = 1216, C_RK = 1280, C_VB = 1344, C_END = 1408;
__device__ __forceinline__ void prep_consts(int l, int h, LAS float* cst) {
    const CAS Params* p = KARG();
    for (int i = threadIdx.x; i < C_END; i += 512) {
        float v;
        if (i < 512) { const int r = i & 255, type = r >> 7, dir = (r >> 6) & 1, col = r & 63; const int gc = (type ? 3200 : 3072) + 64 * dir + col; v = (i < 256 ? p->in[I_SP] : p->in[I_SN])[(size_t)l * 3328 + gc]; }
        else if (i < 896) { const int r = (i - 512) % 192, which = r >> 6, col = r & 63; v = (i < 704 ? p->in[I_SP] : p->in[I_SN])[(size_t)l * 3328 + which * 1024 + h * 64 + col]; }
        else if (i < 1152) { const int r = (i - 896) & 127, dir = r >> 6, col = r & 63; v = (i < 1024 ? p->in[I_DB] : p->in[I_IB])[((size_t)l * 2 + dir) * DM + h * 64 + col]; }
        else { const int which = (i - 1152) >> 6, col = i & 63; const float* src = which == 0 ? p->in[I_KK] : which == 1 ? p->in[I_KA] : which == 2 ? p->in[I_RK] : p->in[I_VB];
               v = (which == 3 && l == 0) ? 0.f : src[(size_t)(which == 3 ? l - 1 : l) * DM + h * 64 + col]; }
        cst[i] = v;
    }
}
__device__ __forceinline__ f32x2 mixp(unsigned c, unsigned pv, unsigned nv, f32x2 m1, f32x2 m2) {
    const float c0 = bflo(c), c1 = bfhi(c);
    float r0 = __builtin_fmaf(m2.x, bflo(nv) - c0, __builtin_fmaf(m1.x, bflo(pv) - c0, c0)), r1 = __builtin_fmaf(m2.y, bfhi(nv) - c1, __builtin_fmaf(m1.y, bfhi(pv) - c1, c1));
    asm("" : "+v"(r0), "+v"(r1));
    return (f32x2){r0, r1};
}
__device__ __forceinline__ void mix8p(const u32x4 c, const u32x4 pv, const u32x4 nv, const LAS float* mp, const LAS float* mn, float* o) {
    const f32x4 a0 = *(const LAS f32x4*)mp, a1 = *(const LAS f32x4*)(mp + 4), b0 = *(const LAS f32x4*)mn, b1 = *(const LAS f32x4*)(mn + 4);
    const f32x2 r0 = mixp(c.x, pv.x, nv.x, (f32x2){a0.x, a0.y}, (f32x2){b0.x, b0.y}), r1 = mixp(c.y, pv.y, nv.y, (f32x2){a0.z, a0.w}, (f32x2){b0.z, b0.w});
    const f32x2 r2 = mixp(c.z, pv.z, nv.z, (f32x2){a1.x, a1.y}, (f32x2){b1.x, b1.y}), r3 = mixp(c.w, pv.w, nv.w, (f32x2){a1.z, a1.w}, (f32x2){b1.z, b1.w});
    o[0] = r0.x; o[1] = r0.y; o[2] = r1.x; o[3] = r1.y; o[4] = r2.x; o[5] = r2.y; o[6] = r3.x; o[7] = r3.y;
}
__device__ __forceinline__ void mix4p(const u32x2 c, const u32x2 pv, const u32x2 nv, const LAS float* mp, const LAS float* mn, float* o) {
    const f32x4 a0 = *(const LAS f32x4*)mp, b0 = *(const LAS f32x4*)mn;
    const f32x2 r0 = mixp(c.x, pv.x, nv.x, (f32x2){a0.x, a0.y}, (f32x2){b0.x, b0.y}), r1 = mixp(c.y, pv.y, nv.y, (f32x2){a0.z, a0.w}, (f32x2){b0.z, b0.w});
    o[0] = r0.x; o[1] = r0.y; o[2] = r1.x; o[3] = r1.y;
}
#define PREP_COMMON() \
    const CAS Params* p = KARG(); unsigned char* ws = p->ws; \
    asm volatile("" : "+v"(lane));     \
    const int fr = lane & 15, fq = lane >> 4; \
    const int s = fr, t = dir == 0 ? c * CHS + s : SEQ - 1 - c * CHS - s; \
    const size_t row = (size_t)b * SEQ + t; \
    const bf16* rawA = (const bf16*)(ws + OFF_RAWA) + row * LDA; \
    const int dp = t > 0 ? -LDA : 0, dn = t < SEQ - 1 ? LDA : 0;            \
    const bool pz = t > 0, nz = t < SEQ - 1; \
    LAS float* rs_ = rg + s * RSTEP;
#define ZERO_ENDS4(A) do { if (!pz) A[1] = (u32x4){0u, 0u, 0u, 0u}; if (!nz) A[2] = (u32x4){0u, 0u, 0u, 0u}; } while (0)
#define ZERO_ENDS2(A) do { if (!pz) A[1] = (u32x2){0u, 0u}; if (!nz) A[2] = (u32x2){0u, 0u}; } while (0)

__device__ __forceinline__ void prep_x(int l, int b, int h, int dir, int c, LAS float* rg, const LAS float* cst, int lane) {
    PREP_COMMON();
    const bf16* Wd = (const bf16*)(ws + OFF_WDEC) + (size_t)dir * DM * 64; const bf16* Wv = (const bf16*)(ws + OFF_WVR);
    bf16* vfirst = (bf16*)(ws + OFF_VFIRST) + row * DM; bf16* vfin = (bf16*)(ws + OFF_VFIN) + row * DM;
    u32x4 cdr[2][3];
#pragma unroll
    for (int ks = 0; ks < 2; ++ks) { const bf16* q = rawA + 3072 + 64 * dir + 32 * ks + 8 * fq; cdr[ks][0] = *(const u32x4*)q; cdr[ks][1] = *(const u32x4*)(q + dp); cdr[ks][2] = *(const u32x4*)(q + dn); }
    u32x4 bvr = {0u, 0u, 0u, 0u}; if (l > 0) bvr = *(const u32x4*)(rawA + 3328 + 8 * fq);
    u32x4 wdr[4][2], wvr[4]; u32x2 vr_[4][3], vfr[4];
#pragma unroll
    for (int nb = 0; nb < 4; ++nb) { const int chr = h * 64 + nb * 16 + fr;
#pragma unroll
        for (int ks = 0; ks < 2; ++ks) wdr[nb][ks] = *(const u32x4*)(Wd + (size_t)chr * 64 + 32 * ks + 8 * fq);
        wvr[nb] = (u32x4){0u, 0u, 0u, 0u}; if (l > 0) wvr[nb] = *(const u32x4*)(Wv + (size_t)chr * 32 + 8 * fq);
        const int ch = h * 64 + nb * 16 + 4 * fq; const bf16* q = rawA + 2048 + ch;
        vr_[nb][0] = *(const u32x2*)q; vr_[nb][1] = *(const u32x2*)(q + dp); vr_[nb][2] = *(const u32x2*)(q + dn);
        vfr[nb] = (u32x2){0u, 0u}; if (l > 0) vfr[nb] = *(const u32x2*)(vfirst + ch); }
    __builtin_amdgcn_sched_barrier(0);
    bf16x8 bd[2];
#pragma unroll
    for (int ks = 0; ks < 2; ++ks) {
        float o[8]; const int cc = 64 * dir + 32 * ks + 8 * fq;
        ZERO_ENDS4(cdr[ks]);
        mix8p(cdr[ks][0], cdr[ks][1], cdr[ks][2], cst + C_CMP + cc, cst + C_CMN + cc, o);
#pragma unroll
        for (int i = 0; i < 8; ++i) o[i] = 1.0f - 2.0f * __builtin_amdgcn_rcpf(1.0f + __expf(2.0f * o[i]));
        bd[ks] = pack8(o);
    }
    const bf16x8 bv = __builtin_bit_cast(bf16x8, bvr);
#pragma unroll
    for (int nb = 0; nb < 4; ++nb) {
        f32x4 aD = {0.f, 0.f, 0.f, 0.f}, aV = aD;
#pragma unroll
        for (int ks = 0; ks < 2; ++ks) aD = MFMA16(__builtin_bit_cast(bf16x8, wdr[nb][ks]), bd[ks], aD);
        if (l > 0) aV = MFMA16(__builtin_bit_cast(bf16x8, wvr[nb]), bv, aV);
        const int co = nb * 16 + 4 * fq, ch = h * 64 + co;
        float vv[4];
        ZERO_ENDS2(vr_[nb]);
        mix4p(vr_[nb][0], vr_[nb][1], vr_[nb][2], cst + C_RMP + 128 + co, cst + C_RMN + 128 + co, vv);
        const f32x4 dbias = *(const LAS f32x4*)(cst + C_DB + 64 * dir + co);
        if (l > 0) {
            float vf[4]; unpack4(vfr[nb], vf);
            const f32x4 vbias = *(const LAS f32x4*)(cst + C_VB + co);
#pragma unroll
            for (int i = 0; i < 4; ++i) { const float g = sigm(vbias[i] + aV[i]); vv[i] = vv[i] + (vf[i] - vv[i]) * g; }
        }
        if (dir == 0) { u32x2 o; o.x = pk2(vv[0], vv[1]); o.y = pk2(vv[2], vv[3]); *(u32x2*)((l == 0 ? vfirst : vfin) + ch) = o; }
        f32x4 vw, vvv;
#pragma unroll
        for (int i = 0; i < 4; ++i) { vw[i] = __expf(-0.60653066f * sigm(dbias[i] + aD[i])); vvv[i] = vv[i]; }
        *(LAS f32x4*)(rs_ + co) = vw; *(LAS f32x4*)(rs_ + 64 + co) = vvv;
    }
}
__device__ __forceinline__ void prep_y(int l, int b, int h, int dir, int c, LAS float* rg, const LAS float* cst, int lane) {
    PREP_COMMON();
    const bf16* Wi = (const bf16*)(ws + OFF_WIC) + (size_t)dir * DM * 64;
    u32x4 cir[2][3];
#pragma unroll
    for (int ks = 0; ks < 2; ++ks) { const bf16* q = rawA + 3200 + 64 * dir + 32 * ks + 8 * fq; cir[ks][0] = *(const u32x4*)q; cir[ks][1] = *(const u32x4*)(q + dp); cir[ks][2] = *(const u32x4*)(q + dn); }
    u32x4 wir[4][2]; u32x2 kr[4][3], rr_[4][3];
#pragma unroll
    for (int nb = 0; nb < 4; ++nb) { const int chr = h * 64 + nb * 16 + fr;
#pragma unroll
        for (int ks = 0; ks < 2; ++ks) wir[nb][ks] = *(const u32x4*)(Wi + (size_t)chr * 64 + 32 * ks + 8 * fq);
        const bf16* q = rawA + h * 64 + nb * 16 + 4 * fq;
        rr_[nb][0] = *(const u32x2*)q; rr_[nb][1] = *(const u32x2*)(q + dp); rr_[nb][2] = *(const u32x2*)(q + dn);
        kr[nb][0] = *(const u32x2*)(q + 1024); kr[nb][1] = *(const u32x2*)(q + 1024 + dp); kr[nb][2] = *(const u32x2*)(q + 1024 + dn); }
    __builtin_amdgcn_sched_barrier(0);
    bf16x8 bi[2];
#pragma unroll
    for (int ks = 0; ks < 2; ++ks) {
        float o[8]; const int cc = 128 + 64 * dir + 32 * ks + 8 * fq;
        ZERO_ENDS4(cir[ks]);
        mix8p(cir[ks][0], cir[ks][1], cir[ks][2], cst + C_CMP + cc, cst + C_CMN + cc, o);
        bi[ks] = pack8(o);
    }
    float kk[16]; float ss = 0.f;
#pragma unroll
    for (int nb = 0; nb < 4; ++nb) {
        const int co = nb * 16 + 4 * fq;
        ZERO_ENDS2(kr[nb]);
        mix4p(kr[nb][0], kr[nb][1], kr[nb][2], cst + C_RMP + 64 + co, cst + C_RMN + 64 + co, kk + 4 * nb);
        const f32x4 kkw = *(const LAS f32x4*)(cst + C_KK + co);
#pragma unroll
        for (int i = 0; i < 4; ++i) { const float kr_ = kk[4 * nb + i] * kkw[i]; ss += kr_ * kr_; }
    }
    ss += __shfl_xor(ss, 16); ss += __shfl_xor(ss, 32);
    const float nrm = rsqrtf(ss + 1e-12f);
    float cs = 0.f;
#pragma unroll
    for (int nb = 0; nb < 4; ++nb) {
        f32x4 aI = {0.f, 0.f, 0.f, 0.f};
#pragma unroll
        for (int ks = 0; ks < 2; ++ks) aI = MFMA16(__builtin_bit_cast(bf16x8, wir[nb][ks]), bi[ks], aI);
        const int co = nb * 16 + 4 * fq;
        float rr[4];
        ZERO_ENDS2(rr_[nb]);
        mix4p(rr_[nb][0], rr_[nb][1], rr_[nb][2], cst + C_RMP + co, cst + C_RMN + co, rr);
        const f32x4 ibias = *(const LAS f32x4*)(cst + C_IB + 64 * dir + co);
        const f32x4 kkw = *(const LAS f32x4*)(cst + C_KK + co), kaw = *(const LAS f32x4*)(cst + C_KA + co), rkw = *(const LAS f32x4*)(cst + C_RK + co);
        f32x4 va, vb, vkd, vr;
#pragma unroll
        for (int i = 0; i < 4; ++i) {
            const float al = sigm(ibias[i] + aI[i]);
            const float kraw = kk[4 * nb + i];
            const float kn = kraw * kkw[i] * nrm;
            const float kd = kraw * (1.0f + (al - 1.0f) * kaw[i]);
            va[i] = -kn; vb[i] = kn * al; vkd[i] = kd; vr[i] = rr[i];
            cs += rr[i] * kd * rkw[i];
        }
        *(LAS u32x4*)(rs_ + 128 + co) = (u32x4){cvtpk(0.25f * vb[0], 0.25f * vkd[0]), cvtpk(0.25f * vb[1], 0.25f * vkd[1]), cvtpk(0.25f * vb[2], 0.25f * vkd[2]), cvtpk(0.25f * vb[3], 0.25f * vkd[3])};
        *(LAS u32x2*)(rs_ + 192 + (co >> 1)) = (u32x2){cvtpk(va[0], va[1]), cvtpk(va[2], va[3])};
        *(LAS u32x2*)(rs_ + 224 + (co >> 1)) = (u32x2){cvtpk(vr[0], vr[1]), cvtpk(vr[2], vr[3])};
    }
    cs += __shfl_xor(cs, 16); cs += __shfl_xor(cs, 32);
    if (fq == 0) ((float*)(ws + OFF_COEF))[((size_t)dir * T + row) * 16 + h] = cs;
}
#define PREP_ROLE(jw, cc, slot) do { if (((jw) >> 1) == 0) prep_x(l, b, h, (jw) & 1, (cc), ring + (size_t)((slot) * 2 + ((jw) & 1)) * CHS * RSTEP, cst, lane); \
                                     else prep_y(l, b, h, (jw) & 1, (cc), ring + (size_t)((slot) * 2 + ((jw) & 1)) * CHS * RSTEP, cst, lane); } while (0)

#define SCHEDB() __builtin_amdgcn_sched_barrier(0)
__device__ __forceinline__ void swap16(float& a, float& b) { const auto r = __builtin_amdgcn_permlane16_swap(__builtin_bit_cast(unsigned, a), __builtin_bit_cast(unsigned, b), false, false); a = __builtin_bit_cast(float, (unsigned)r[0]); b = __builtin_bit_cast(float, (unsigned)r[1]); }
__device__ __forceinline__ void swap32(float& a, float& b) { const auto r = __builtin_amdgcn_permlane32_swap(__builtin_bit_cast(unsigned, a), __builtin_bit_cast(unsigned, b), false, false); a = __builtin_bit_cast(float, (unsigned)r[0]); b = __builtin_bit_cast(float, (unsigned)r[1]); }
__device__ __forceinline__ float scatter4(float p0, float p1) { swap16(p0, p1); float z = p0 + p1, z2 = z; swap32(z, z2); return z + z2; }
#define SCAN_DOTS(AH0, AH1, D0, D1) do { \
        const u32x4 b00 = {cvtpk(c[0][0].x, c[0][0].y), cvtpk(c[0][0].z, c[0][0].w), cvtpk(c[1][0].x, c[1][0].y), cvtpk(c[1][0].z, c[1][0].w)}; \
        const u32x4 b01 = {cvtpk(c[2][0].x, c[2][0].y), cvtpk(c[2][0].z, c[2][0].w), cvtpk(c[3][0].x, c[3][0].y), cvtpk(c[3][0].z, c[3][0].w)}; \
        const u32x4 b10 = {cvtpk(c[0][1].x, c[0][1].y), cvtpk(c[0][1].z, c[0][1].w), cvtpk(c[1][1].x, c[1][1].y), cvtpk(c[1][1].z, c[1][1].w)}; \
        const u32x4 b11 = {cvtpk(c[2][1].x, c[2][1].y), cvtpk(c[2][1].z, c[2][1].w), cvtpk(c[3][1].x, c[3][1].y), cvtpk(c[3][1].z, c[3][1].w)}; \
        D0 = MFMA16(__builtin_bit_cast(bf16x8, AH0), __builtin_bit_cast(bf16x8, b00), ((f32x4){0.f, 0.f, 0.f, 0.f})); D0 = MFMA16(__builtin_bit_cast(bf16x8, AH1), __builtin_bit_cast(bf16x8, b01), D0); \
        D1 = MFMA16(__builtin_bit_cast(bf16x8, AH0), __builtin_bit_cast(bf16x8, b10), ((f32x4){0.f, 0.f, 0.f, 0.f})); D1 = MFMA16(__builtin_bit_cast(bf16x8, AH1), __builtin_bit_cast(bf16x8, b11), D1); } while (0)
#define SCAN_LD_AV(AH0, AH1, P) do { const u32x2 q0 = *(const LAS u32x2*)((P) + 0), q1 = *(const LAS u32x2*)((P) + 8), q2 = *(const LAS u32x2*)((P) + 16), q3 = *(const LAS u32x2*)((P) + 24); \
        AH0 = (u32x4){q0.x, q0.y, q1.x, q1.y}; AH1 = (u32x4){q2.x, q2.y, q3.x, q3.y}; } while (0)
#define SCAN_STEP(S_, CW, CBK, NW, NBK) do { \
        const int sn = (S_) + 1 < CHS ? (S_) + 1 : (S_); const LAS float* nstep = sl + sn * RSTEP; \
        const LAS float* avp = (asel ? nstep + 192 : sl + (S_) * RSTEP + 224) + 2 * mg;        \
        u32x4 ah0, ah1; SCAN_LD_AV(ah0, ah1, avp); \
        _Pragma("unroll") for (int kt = 0; kt < 4; ++kt) { NW[kt] = *(const LAS f32x4*)(nstep + 16 * kt + 4 * mg); NBK[kt] = ((const LAS unsigned*)nstep)[128 + 16 * kt + v16]; } \
        const float vn0 = vb[sn * RSTEP], vn1 = vb[sn * RSTEP + 16]; \
        SCHEDB(); \
        { bx0.x = cvtpk(x0, v0); bx1.x = cvtpk(x1, v1);     \
        _Pragma("unroll") for (int kt = 0; kt < 4; ++kt) { \
            at.x = CBK[kt]; \
            const f32x4 i0 = MFMA16(__builtin_bit_cast(bf16x8, at), __builtin_bit_cast(bf16x8, bx0), ((f32x4){0.f, 0.f, 0.f, 0.f})); \
            const f32x4 i1 = MFMA16(__builtin_bit_cast(bf16x8, at), __builtin_bit_cast(bf16x8, bx1), ((f32x4){0.f, 0.f, 0.f, 0.f})); \
            _Pragma("unroll") for (int i = 0; i < 4; ++i) { float r0 = __builtin_fmaf(c[kt][0][i], CW[kt][i], i0[i]), r1 = __builtin_fmaf(c[kt][1][i], CW[kt][i], i1[i]); \
                asm("" : "+v"(r0), "+v"(r1));     \
                c[kt][0][i] = r0; c[kt][1][i] = r1; } } } \
        SCHEDB(); \
        { f32x4 d0, d1; SCAN_DOTS(ah0, ah1, d0, d1); \
        x0 = d0[1]; x1 = d1[1]; \
        if (lane < 32) ybuf[(S_) * 32 + lane] = mg == 0 ? d0[0] : d1[0];     } \
        v0 = vn0; v1 = vn1; \
        SCHEDB(); } while (0)
__device__ __forceinline__ void scan_chunk(f32x4 (&c)[4][2], const LAS float* sl  , int rh, LAS float* ybuf  , int lane) {
    const int mg = lane >> 4, v16 = lane & 15;
    const bool asel = (lane & 3) == 1;
    const LAS float* vb = sl + 64 + 32 * rh + v16;
    f32x4 wA[4], wB[4]; unsigned bkA[4], bkB[4];
    u32x4 at = {0u, 0u, 0u, 0u}, bx0 = {0u, 0u, 0u, 0u}, bx1 = {0u, 0u, 0u, 0u};
    float x0, x1;
    {
        u32x4 ah0, ah1; SCAN_LD_AV(ah0, ah1, sl + 192 + 2 * mg);
#pragma unroll
        for (int kt = 0; kt < 4; ++kt) { wA[kt] = *(const LAS f32x4*)(sl + 16 * kt + 4 * mg); bkA[kt] = ((const LAS unsigned*)sl)[128 + 16 * kt + v16]; }
        f32x4 d0, d1; SCAN_DOTS(ah0, ah1, d0, d1);
        x0 = asel ? d0[1] : d0[0]; x1 = asel ? d1[1] : d1[0];
    }
    float v0 = vb[0], v1 = vb[16];
#pragma unroll 1
    for (int s = 0; s < CHS; s += 2) {
        SCAN_STEP(s, wA, bkA, wB, bkB);
        SCAN_STEP(s + 1, wB, bkB, wA, bkA);
    }
}

#define Y_T(dir_, cc, s) ((dir_) == 0 ? (cc) * CHS + (s) : SEQ - 1 - (cc) * CHS - (s))
__device__ __forceinline__ void yflush_issue(unsigned (&yo)[4], const bf16* yb2  , int dir, int cc, int lane) {
    const int rg = lane >> 4;
    if (cc >= NCH / 2) {
#pragma unroll
        for (int i = 0; i < 4; ++i) yo[i] = *(const unsigned*)(yb2 + (size_t)Y_T(dir, cc, 4 * i + rg) * DM);
    } else {
#pragma unroll
        for (int i = 0; i < 4; ++i) yo[i] = 0u;
    }
}
__device__ __forceinline__ void yflush_finish(const unsigned (&yo)[4], bf16* yb2, const LAS float* ybuf  , int dir, int cc, int lane) {
    const int rg = lane >> 4, cp = lane & 15;
#pragma unroll
    for (int i = 0; i < 4; ++i) { const int s = 4 * i + rg; const f32x2 yv = *(const LAS f32x2*)(ybuf + s * 32 + 2 * cp);
        *(unsigned*)(yb2 + (size_t)Y_T(dir, cc, s) * DM) = pk2(yv.x + bflo(yo[i]), yv.y + bfhi(yo[i])); }
}

__device__ __forceinline__ void scan_phase(int l, LAS unsigned char* lds, int wave, int lane) {
    asm volatile("" : "+v"(lane));
    unsigned char* ws = KARG()->ws;
    LAS float* ring = (LAS float*)(lds + 32768);
    for (int bh = blockIdx.x; bh < BATCH * 16; bh += gridDim.x) {
        const int b = bh >> 4, h = bh & 15;
        LAS f32x4* sts = (LAS f32x4*)lds + (wave & 3) * 512 + lane;
        LAS float* cst = (LAS float*)(lds + CST_OFF);
        LAS float* ybw = (LAS float*)(lds + 133120) + (wave & 3) * 2 * CHS * 32;
        const int dirw = wave & 1, rhw = (wave >> 1) & 1;
        bf16* yb2 = (bf16*)(ws + OFF_YS) + (size_t)b * SEQ * DM + h * 64 + 32 * rhw + 2 * (lane & 15);
        prep_consts(l, h, cst);
        LDS_WAIT(); __syncthreads();
        f32x4 st[4][2];
#pragma unroll
        for (int k = 0; k < 8; ++k) st[k >> 1][k & 1] = (f32x4){0.f, 0.f, 0.f, 0.f};
        if (wave >= 4) PREP_ROLE(wave - 4, 0, 0);
        LDS_WAIT(); __syncthreads();
#pragma unroll 1
        for (int c = 0; c < NCH; ++c) {
            if (wave < 4) {
                scan_chunk(st, ring + (size_t)((c & 1) * 2 + dirw) * CHS * RSTEP, rhw, ybw + (c & 1) * CHS * 32, lane);
            } else {
                unsigned yo[4];
                if (c > 0) yflush_issue(yo, yb2, dirw, c - 1, lane);
                if (c + 1 < NCH) PREP_ROLE(wave - 4, c + 1, (c + 1) & 1);
                if (c > 0) yflush_finish(yo, yb2, ybw + ((c - 1) & 1) * CHS * 32, dirw, c - 1, lane);
            }
            if (c == NCH / 2) VM_WAIT(); else asm volatile("s_waitcnt vmcnt(4)" ::: "memory");
            LDS_WAIT(); __syncthreads();
        }
        if (wave >= 4) { unsigned yo[4]; yflush_issue(yo, yb2, dirw, NCH - 1, lane); yflush_finish(yo, yb2, ybw + ((NCH - 1) & 1) * CHS * 32, dirw, NCH - 1, lane); }
        VM_WAIT(); __syncthreads();
    }
}

__device__ __forceinline__ void postscan_phase(int l, int gw, int NGW, int lane) {
    asm volatile("" : "+s"(NGW), "+s"(gw));
    asm volatile("" : "+v"(lane));
    const CAS Params* p = KARG(); unsigned char* ws = p->ws;
    const bf16* vcur = (const bf16*)(ws + (l == 0 ? OFF_VFIRST : OFF_VFIN));
    const float* coef = (const float*)(ws + OFF_COEF);
    const int ch = 16 * lane, hd = lane >> 2;
    f32x4 g4[4], b4[4];
#pragma unroll
    for (int i = 0; i < 4; ++i) { g4[i] = *(const f32x4*)(p->in[I_LG] + (size_t)l * DM + ch + 4 * i); b4[i] = *(const f32x4*)(p->in[I_LB] + (size_t)l * DM + ch + 4 * i); }
    for (int m0 = gw; m0 < T; m0 += 2 * NGW) {
        u32x4 yr[2][2], vr[2][2]; float cf[2];
#pragma unroll
        for (int r = 0; r < 2; ++r) { const int m = m0 + r * NGW < T ? m0 + r * NGW : m0;
            const bf16* yp = (const bf16*)(ws + OFF_YS) + (size_t)m * DM + ch; const bf16* vp = vcur + (size_t)m * DM + ch;
            yr[r][0] = *(const u32x4*)yp; yr[r][1] = *(const u32x4*)(yp + 8); vr[r][0] = *(const u32x4*)vp; vr[r][1] = *(const u32x4*)(vp + 8);
            cf[r] = coef[(size_t)m * 16 + hd] + coef[((size_t)T + m) * 16 + hd]; }
#pragma unroll
        for (int r = 0; r < 2; ++r) { const int m = m0 + r * NGW; if (m < T) {
            float y[16], v[16];
            unpack8(yr[r][0], y); unpack8(yr[r][1], y + 8); unpack8(vr[r][0], v); unpack8(vr[r][1], v + 8);
            float sm = 0.f;
#pragma unroll
            for (int i = 0; i < 16; ++i) sm += y[i];
            sm += __shfl_xor(sm, 1); sm += __shfl_xor(sm, 2);
            const float mean = sm * (1.f / 64.f); float q = 0.f;
#pragma unroll
            for (int i = 0; i < 16; ++i) { y[i] -= mean; q += y[i] * y[i]; }
            q += __shfl_xor(q, 1); q += __shfl_xor(q, 2);
            const float rstd = rsqrtf(q * (1.f / 64.f) + 64e-5f);
            float o[16];
#pragma unroll
            for (int i = 0; i < 16; i += 4)
#pragma unroll
                for (int j = 0; j < 4; ++j) o[i + j] = y[i + j] * rstd * g4[i >> 2][j] + b4[i >> 2][j] + cf[r] * v[i + j];
            bf16* yp = (bf16*)(ws + OFF_YS) + (size_t)m * DM + ch;
            *(u32x4*)yp = pack8u(o); *(u32x4*)(yp + 8) = pack8u(o + 8); } }
    }
}

__device__ __forceinline__ float ret_log2g(int h) { const float e = exp2f(-5.0f - (float)h); return -1.4426950408889634f * (e + e * e * (0.5f + e * (0.33333333f + e * 0.25f))); }
constexpr int KP = 136;
constexpr int QP = 72;
__device__ __forceinline__ void stage_vt(const bf16* rawB, int b, int h, int j, LAS bf16* Vt, int tid) {
    const int m = tid >> 2, part = tid & 3;
    const bf16* src = rawB + ((size_t)b * SEQ + j * RC + m) * 2048 + 1024 + h * 128 + 32 * part;
#pragma unroll
    for (int q = 0; q < 4; ++q) { float f[8]; const u32x4 u = *(const u32x4*)(src + 8 * q);
        const unsigned w[4] = {u.x, u.y, u.z, u.w};
#pragma unroll
        for (int i = 0; i < 4; ++i) { Vt[(32 * part + 8 * q + 2 * i) * KP + m] = (bf16)(w[i] & 0xffffu); Vt[(32 * part + 8 * q + 2 * i + 1) * KP + m] = (bf16)(w[i] >> 16); }
        (void)f; }
}
__device__ __forceinline__ void rot8(const bf16* src, const float* rot, int pos, int part, float scale, float* o1, float* o2) {
    float x1[8], x2[8]; unpack8(*(const u32x4*)(src + 8 * part), x1); unpack8(*(const u32x4*)(src + 32 + 8 * part), x2);
    const float* cs = rot + (size_t)pos * 32 + 8 * part; const float* sn = rot + (size_t)2048 * 32 + (size_t)pos * 32 + 8 * part;
    const f32x4 c0 = *(const f32x4*)cs, c1 = *(const f32x4*)(cs + 4), s0 = *(const f32x4*)sn, s1 = *(const f32x4*)(sn + 4);
    const float cv[8] = {c0.x, c0.y, c0.z, c0.w, c1.x, c1.y, c1.z, c1.w}, sv[8] = {s0.x, s0.y, s0.z, s0.w, s1.x, s1.y, s1.z, s1.w};
#pragma unroll
    for (int i = 0; i < 8; ++i) { o1[i] = (x1[i] * cv[i] - x2[i] * sv[i]) * scale; o2[i] = (x1[i] * sv[i] + x2[i] * cv[i]) * scale; }
}
__device__ __forceinline__ void ret_states_phase(LAS unsigned char* lds, int wave, int lane_) {
    int tid = threadIdx.x; asm volatile("" : "+v"(tid)); const int lane = tid & 63;
    const CAS Params* p = KARG(); unsigned char* ws = p->ws; const int fr = lane & 15, fq = lane >> 4;
    const bf16* rawB = (const bf16*)(ws + OFF_RAWB); const float* rot = (const float*)(ws + OFF_ROT);
    LAS bf16* Kt = (LAS bf16*)lds; LAS bf16* Vt = (LAS bf16*)(lds + 64 * KP * 2);
    const int m = tid >> 2, part = tid & 3;
    for (int it = blockIdx.x; it < BATCH * 8 * 2; it += gridDim.x) {
        const int dir = it & 1, bh = it >> 1, b = bh >> 3, h = bh & 7;
        const float l2g = ret_log2g(h), dC = exp2f(l2g * (float)RC);
        const float z = exp2f(l2g * (float)(dir == 0 ? RC - 1 - m : m));
        f32x4 acc[4];
#pragma unroll
        for (int nb = 0; nb < 4; ++nb) acc[nb] = (f32x4){0.f, 0.f, 0.f, 0.f};
        u32x4 kx1, kx2, vraw[4]; f32x4 c0, c1, s0, s1;
#define R1_LOAD(J_) do { const int pos_ = (J_) * RC + m; const bf16* row_ = rawB + ((size_t)b * SEQ + pos_) * 2048; \
            kx1 = *(const u32x4*)(row_ + 512 + h * 64 + 8 * part); kx2 = *(const u32x4*)(row_ + 512 + h * 64 + 32 + 8 * part); \
            _Pragma("unroll") for (int q = 0; q < 4; ++q) vraw[q] = *(const u32x4*)(row_ + 1024 + h * 128 + 32 * part + 8 * q); \
            const float* cs_ = rot + (size_t)pos_ * 32 + 8 * part; const float* sn_ = cs_ + (size_t)2048 * 32; \
            c0 = *(const f32x4*)cs_; c1 = *(const f32x4*)(cs_ + 4); s0 = *(const f32x4*)sn_; s1 = *(const f32x4*)(sn_ + 4); } while (0)
        R1_LOAD(dir == 0 ? 0 : NRC - 1);
#pragma unroll 1
        for (int jj = 0; jj < NRC; ++jj) {
            const int j = dir == 0 ? jj : NRC - 1 - jj;
            bf16* so = (bf16*)(ws + OFF_ST) + ((size_t)(bh * NRC + j) * 2 + dir) * 8192;
#pragma unroll
            for (int nb = 0; nb < 4; ++nb)
#pragma unroll
                for (int i = 0; i < 4; ++i) { so[(16 * wave + 4 * fq + i) * 64 + nb * 16 + fr] = (bf16)f2bf(acc[nb][i]); acc[nb][i] *= dC; }
            {
                float x1[8], x2[8]; unpack8(kx1, x1); unpack8(kx2, x2);
                const float cv[8] = {c0.x, c0.y, c0.z, c0.w, c1.x, c1.y, c1.z, c1.w}, sv[8] = {s0.x, s0.y, s0.z, s0.w, s1.x, s1.y, s1.z, s1.w};
#pragma unroll
                for (int i = 0; i < 8; ++i) { Kt[(8 * part + i) * KP + m] = (bf16)f2bf((x1[i] * cv[i] - x2[i] * sv[i]) * z); Kt[(32 + 8 * part + i) * KP + m] = (bf16)f2bf((x1[i] * sv[i] + x2[i] * cv[i]) * z); }
#pragma unroll
                for (int q = 0; q < 4; ++q) { const unsigned w[4] = {vraw[q].x, vraw[q].y, vraw[q].z, vraw[q].w};
#pragma unroll
                    for (int i = 0; i < 4; ++i) { Vt[(32 * part + 8 * q + 2 * i) * KP + m] = (bf16)(w[i] & 0xffffu); Vt[(32 * part + 8 * q + 2 * i + 1) * KP + m] = (bf16)(w[i] >> 16); } }
            }
            LDS_WAIT(); __syncthreads();
            if (jj + 1 < NRC) R1_LOAD(dir == 0 ? jj + 1 : NRC - 2 - jj);
#pragma unroll
            for (int ks = 0; ks < 4; ++ks) {
                const bf16x8 av = *(const LAS bf16x8*)(Vt + (16 * wave + fr) * KP + 32 * ks + 8 * fq);
#pragma unroll
                for (int nb = 0; nb < 4; ++nb) { const bf16x8 bk = *(const LAS bf16x8*)(Kt + (nb * 16 + fr) * KP + 32 * ks + 8 * fq); acc[nb] = MFMA16(av, bk, acc[nb]); }
            }
            LDS_WAIT(); __syncthreads();
        }
#undef R1_LOAD
    }
}
__device__ __forceinline__ void ret_out_phase(int l, LAS unsigned char* lds, int wave, int lane_) {
    int tid = threadIdx.x; asm volatile("" : "+v"(tid)); const int lane = tid & 63;
    const CAS Params* p = KARG(); unsigned char* ws = p->ws; const int fr = lane & 15, fq = lane >> 4;
    const bf16* rawB = (const bf16*)(ws + OFF_RAWB); const float* rot = (const float*)(ws + OFF_ROT);
    LAS bf16* Qs = (LAS bf16*)lds; LAS bf16* Ks = (LAS bf16*)(lds + 128 * QP * 2); LAS bf16* Vt = (LAS bf16*)(lds + 2 * 128 * QP * 2); LAS bf16* Pw = (LAS bf16*)(lds + 2 * 128 * QP * 2 + 128 * KP * 2) + wave * 16 * KP;
    for (int it = blockIdx.x; it < BATCH * 8 * NRC; it += gridDim.x) {
        const int j = it % NRC, bh = it / NRC, b = bh >> 3, h = bh & 7;
        const float l2g = ret_log2g(h);
        const __amdgpu_buffer_rsrc_t strs = __builtin_amdgcn_make_buffer_rsrc((void*)(ws + OFF_ST), 0, 0x7fffffff, 0x00027000);
        const unsigned sfo = (unsigned)(((bh * NRC + j) * 2 + 0) * 8192 * 2);
        u32x4 sfv[4][2], sbv[4][2];
#define RET_LD_STATES(g) do { _Pragma("unroll") for (int o4 = 0; o4 < 4; ++o4) _Pragma("unroll") for (int ks = 0; ks < 2; ++ks) { \
            const unsigned eo = sfo + (unsigned)((((4 * (g) + o4) * 16 + fr) * 64 + 32 * ks + 8 * fq) * 2); \
            sfv[o4][ks] = __builtin_amdgcn_raw_buffer_load_b128(strs, eo, 0, 0x11); sbv[o4][ks] = __builtin_amdgcn_raw_buffer_load_b128(strs, eo + 16384u, 0, 0x11); } } while (0)
        RET_LD_STATES(0);
        {
            const int m = tid >> 2, part = tid & 3; const int pos = j * RC + m;
            const bf16* src = rawB + ((size_t)b * SEQ + pos) * 2048 + h * 64;
            float o1[8], o2[8];
            rot8(src, rot, pos, part, 0.125f, o1, o2);
            *(LAS u32x4*)(Qs + m * QP + 8 * part) = pack8u(o1); *(LAS u32x4*)(Qs + m * QP + 32 + 8 * part) = pack8u(o2);
            rot8(src + 512, rot, pos, part, 1.0f, o1, o2);
            *(LAS u32x4*)(Ks + m * QP + 8 * part) = pack8u(o1); *(LAS u32x4*)(Ks + m * QP + 32 + 8 * part) = pack8u(o2);
            stage_vt(rawB, b, h, j, Vt, tid);
        }
        LDS_WAIT(); __syncthreads();
        bf16x8 aq[2];
#pragma unroll
        for (int ks = 0; ks < 2; ++ks) aq[ks] = *(const LAS bf16x8*)(Qs + (16 * wave + fr) * QP + 32 * ks + 8 * fq);
#pragma unroll
        for (int nb = 0; nb < 8; ++nb) {
            f32x4 sc = {0.f, 0.f, 0.f, 0.f};
#pragma unroll
            for (int ks = 0; ks < 2; ++ks) { const bf16x8 bk = *(const LAS bf16x8*)(Ks + (nb * 16 + fr) * QP + 32 * ks + 8 * fq); sc = MFMA16(aq[ks], bk, sc); }
#pragma unroll
            for (int i = 0; i < 4; ++i) { const int n = 16 * wave + 4 * fq + i, mk = nb * 16 + fr; const int d = n > mk ? n - mk : mk - n;
                Pw[(4 * fq + i) * KP + mk] = (bf16)f2bf(sc[i] * __builtin_amdgcn_exp2f(l2g * (float)d)); }
        }
        LDS_WAIT(); asm volatile("" ::: "memory");
        f32x4 y1[8];
        f32x4 xfv, xbv;
#pragma unroll
        for (int i = 0; i < 4; ++i) { const int nl = 16 * wave + 4 * fq + i; xfv[i] = __builtin_amdgcn_exp2f(l2g * (float)(nl + 1)); xbv[i] = __builtin_amdgcn_exp2f(l2g * (float)(RC - nl)); }
        bf16x8 ap[4];
#pragma unroll
        for (int ks = 0; ks < 4; ++ks) ap[ks] = *(const LAS bf16x8*)(Pw + fr * KP + 32 * ks + 8 * fq);
#pragma unroll
        for (int g = 0; g < 2; ++g) {
            if (g == 1) { RET_LD_STATES(1); }
#pragma unroll
            for (int o4 = 0; o4 < 4; ++o4) {
                const int ob = 4 * g + o4;
                f32x4 y2 = {0.f, 0.f, 0.f, 0.f}, y3 = y2; y1[ob] = y2;
#pragma unroll
                for (int ks = 0; ks < 4; ++ks) { const bf16x8 bvv = *(const LAS bf16x8*)(Vt + (ob * 16 + fr) * KP + 32 * ks + 8 * fq); y1[ob] = MFMA16(ap[ks], bvv, y1[ob]); }
#pragma unroll
                for (int ks = 0; ks < 2; ++ks) { y2 = MFMA16(aq[ks], __builtin_bit_cast(bf16x8, sfv[o4][ks]), y2); y3 = MFMA16(aq[ks], __builtin_bit_cast(bf16x8, sbv[o4][ks]), y3); }
                y1[ob] = y1[ob] + xfv * y2 + xbv * y3;
            }
            asm volatile("" ::: "memory");
        }
#pragma unroll
        for (int i = 0; i < 4; ++i) {
            const int nl = 16 * wave + 4 * fq + i;
            float v[8]; float s = 0.f;
#pragma unroll
            for (int ob = 0; ob < 8; ++ob) { v[ob] = y1[ob][i]; s += v[ob]; }
            s += __shfl_xor(s, 1); s += __shfl_xor(s, 2); s += __shfl_xor(s, 4); s += __shfl_xor(s, 8);
            const float mean = s * (1.f / 128.f); float q = 0.f;
#pragma unroll
            for (int ob = 0; ob < 8; ++ob) { v[ob] -= mean; q += v[ob] * v[ob]; }
            q += __shfl_xor(q, 1); q += __shfl_xor(q, 2); q += __shfl_xor(q, 4); q += __shfl_xor(q, 8);
            const float rstd = rsqrtf(q * (1.f / 128.f) + 1e-6f);
            bf16* yo = (bf16*)(ws + OFF_YB) + ((size_t)b * SEQ + j * RC + nl) * DM + h * 128;
            const float* gn = p->in[I_RG] + (size_t)l * DM + h * 128;
#pragma unroll
            for (int ob = 0; ob < 8; ++ob) yo[ob * 16 + fr] = (bf16)f2bf(v[ob] * rstd * gn[ob * 16 + fr]);
        }
        __syncthreads();
    }
}

#define XB_TMO      128
#define XB_XCNT(j)  (256  + 64 * (j))
#define XB_XSUB(j)  (1280 + 64 * (j))
#define XB_XGEN(j)  (2304 + 64 * (j))
#define XB_TOP      3328
#define XB_TOPGEN   3392
#define XCD_BAR_WORDS 3456
#define XB_SPIN_CAP (1u << 18)

__device__ __forceinline__ unsigned xb_ld(unsigned* p)              { return __hip_atomic_load(p, __ATOMIC_RELAXED, __HIP_MEMORY_SCOPE_AGENT); }
__device__ __forceinline__ unsigned xb_add(unsigned* p, unsigned v) { return __hip_atomic_fetch_add(p, v, __ATOMIC_RELAXED, __HIP_MEMORY_SCOPE_AGENT); }
__device__ __forceinline__ unsigned xb_xcc_id() { return (unsigned)__builtin_amdgcn_s_getreg((3 << 11) | 20) & 0xFu; }
#define XB_SPIN(cond, bar) do { unsigned _sp = 0; while (cond) { __builtin_amdgcn_s_sleep(1); \
    if ((++_sp & 255u) == 0u) { if (xb_ld(&(bar)[XB_TMO])) break; if (_sp > XB_SPIN_CAP) { atomicAdd(&(bar)[XB_TMO], 1u); break; } } } } while (0)

struct XcdBarrier {
    unsigned* bar; unsigned x;
    volatile LAS unsigned* st;
};

__device__ __forceinline__ XcdBarrier xcd_barrier_post(unsigned* bar, volatile LAS unsigned* st) {
    XcdBarrier b; b.bar = bar; b.x = xb_xcc_id(); b.st = st;
    if (threadIdx.x == 0) (void)xb_add(&bar[XB_XCNT(b.x)], 1u);
    return b;
}
__device__ __forceinline__ void xcd_barrier_complete(unsigned* bar, unsigned x, unsigned& nloc, unsigned& nx) {
    const unsigned G = gridDim.x * gridDim.y * gridDim.z;
    unsigned sum, cnt, mine, sp = 0u;
    for (;;) {
        sum = 0u; cnt = 0u; mine = 0u;
#pragma unroll
        for (unsigned j = 0; j < 16; ++j) { const unsigned c = xb_ld(&bar[XB_XCNT(j)]); sum += c; cnt += (c > 0u) ? 1u : 0u; mine = (j == x) ? c : mine; }
        if (sum == G) break;
        __builtin_amdgcn_s_sleep(1);
        if ((++sp & 255u) == 0u) { if (xb_ld(&bar[XB_TMO])) break; if (sp > XB_SPIN_CAP) { atomicAdd(&bar[XB_TMO], 1u); break; } }
    }
    nloc = mine > 0u ? mine : 1u; nx = cnt > 0u ? cnt : 1u;
}

__device__ __forceinline__ void xcd_barrier(const XcdBarrier& b) {
    asm volatile("s_waitcnt vmcnt(0)" ::: "memory");
    __syncthreads();
    if (threadIdx.x == 0) {
        unsigned* bar = b.bar;
        __builtin_amdgcn_s_waitcnt(0);
        unsigned nloc = b.st[0], nx = b.st[1];
        if (nloc == 0u) { xcd_barrier_complete(bar, b.x, nloc, nx); b.st[0] = nloc; b.st[1] = nx; }
        const unsigned old = xb_add(&bar[XB_XSUB(b.x)], 1u);
        const unsigned gen = old / nloc;
        if (old + 1u == (gen + 1u) * nloc) {
            __builtin_amdgcn_fence(__ATOMIC_RELEASE, "agent");
            asm volatile("s_waitcnt vmcnt(0)" ::: "memory");
            const unsigned og = xb_add(&bar[XB_TOP], 1u);
            const unsigned tg = og / nx;
            if (og + 1u == (tg + 1u) * nx) xb_add(&bar[XB_TOPGEN], 1u);
            else XB_SPIN(xb_ld(&bar[XB_TOPGEN]) == tg, bar);
            __builtin_amdgcn_fence(__ATOMIC_ACQUIRE, "agent");
            xb_add(&bar[XB_XGEN(b.x)], 1u);
            asm volatile("s_waitcnt vmcnt(0)" ::: "memory");
        } else {
            XB_SPIN(xb_ld(&bar[XB_XGEN(b.x)]) == gen, bar);
            __builtin_amdgcn_fence(__ATOMIC_ACQUIRE, "agent");
            asm volatile("s_waitcnt vmcnt(0)" ::: "memory");
        }
    }
    __syncthreads();
}

#ifndef PHMASK
#define PHMASK 0xFFFF
#endif
#define PH(n) if constexpr ((PHMASK >> (n)) & 1)
#define GSYNC_CG() do { asm volatile("s_waitcnt vmcnt(0) lgkmcnt(0)" ::: "memory"); __syncthreads(); grid.sync(); __builtin_amdgcn_fence(__ATOMIC_ACQUIRE, "agent"); asm volatile("s_waitcnt vmcnt(0)" ::: "memory"); } while (0)
#define GSYNC() xcd_barrier(xbar)
__global__ void __launch_bounds__(512, 2) hybrid_fwd(Params p_unused) {
    extern __shared__ __attribute__((aligned(16))) unsigned char lds_raw[];
    LAS unsigned char* lds = (LAS unsigned char*)lds_raw;
    cg::grid_group grid = cg::this_grid();
    const int tid = threadIdx.x, lane = tid & 63, wave = __builtin_amdgcn_readfirstlane(tid >> 6);
    const int gw = blockIdx.x * 8 + wave, NGW = gridDim.x * 8;
    { volatile LAS unsigned* stw = (volatile LAS unsigned*)(lds + XB_LDS_OFF); if (threadIdx.x < 2) stw[threadIdx.x] = 0u; }
    __syncthreads();
    XcdBarrier xbar = xcd_barrier_post((unsigned*)KARG()->ws, (volatile LAS unsigned*)(lds + XB_LDS_OFF));
    GSYNC_CG();
    {
        float* rot = (float*)(KARG()->ws + OFF_ROT);
        for (int i = gw * 64 + lane; i < 2048 * 32; i += NGW * 64) { const int pos = i >> 5, jf = i & 31;
            const float fr_ = exp2f(-(float)jf * (13.287712379549449f / 32.0f)); float rev = (float)pos * fr_ * 0.15915494309189535f; rev -= rintf(rev);
            rot[i] = __builtin_amdgcn_cosf(rev); rot[2048 * 32 + i] = __builtin_amdgcn_sinf(rev); }
    }
#pragma unroll 1
    for (int l = 0; l < DEPTH; ++l) {
#define XIN (l == 0 ? KARG()->in[I_X] : (const float*)KARG()->out)
#define WSP(off) (KARG()->ws + (off))
        PH(0) convert_weights(l, lds, gw, NGW, wave, lane);
        PH(1) norm_phase(XIN, KARG()->in[I_NG] + (size_t)l * DM, (bf16*)WSP(OFF_XB), gw, NGW, lane);
        GSYNC();
        PH(2) run_gemm(lds, (const bf16*)WSP(OFF_XB), (const bf16*)WSP(OFF_WA), NA, FStoreA{(bf16*)WSP(OFF_RAWA)});
        GSYNC();
        PH(3) scan_phase(l, lds, wave, lane);
        GSYNC();
        PH(4) postscan_phase(l, gw, NGW, lane);
        PH(5) run_gemm(lds, (const bf16*)WSP(OFF_XB), (const bf16*)WSP(OFF_WB), 2048, FStoreB{(bf16*)WSP(OFF_RAWB)});
        GSYNC();
        PH(6) ret_states_phase(lds, wave, lane);
        GSYNC();
        PH(7) ret_out_phase(l, lds, wave, lane);
        GSYNC();
        PH(8) run_gemm(lds, (const bf16*)WSP(OFF_XB), (const bf16*)WSP(OFF_WG), 4096, FGates{WSP(0)});
        GSYNC();
        PH(9) run_gemm(lds, (const bf16*)WSP(OFF_YS), (const bf16*)WSP(OFF_Wa), DM, FGa{(const bf16*)WSP(OFF_SIGA), (bf16*)WSP(OFF_M1)});
        PH(10) run_gemm(lds, (const bf16*)WSP(OFF_YB), (const bf16*)WSP(OFF_Wb), DM, FGb{(const bf16*)WSP(OFF_SIGB), (const bf16*)WSP(OFF_M1), (bf16*)WSP(OFF_MG)});
        GSYNC();
        PH(11) run_gemm(lds, (const bf16*)WSP(OFF_MG), (const bf16*)WSP(OFF_Wo), DM, FGo{XIN, KARG()->out});
        GSYNC();
    }
    final_norm(KARG()->out, KARG()->in[I_FG], gw, NGW, lane);
}

extern "C" void kernel_launch(void* const* d_in, const int* in_sizes, int n_in, void* d_out, int out_size, void* d_ws, size_t ws_size, hipStream_t stream) {
    static int grid = 0;
    if (grid == 0) {
        if (n_in != 22 || ws_size < WS_END) { fprintf(stderr, "kernel_launch: unexpected n_in %d / ws_size %zu (need %zu)\n", n_in, ws_size, (size_t)WS_END); grid = -1; return; }
        int dev = 0, cus = 0, per_cu = 0;
        (void)hipGetDevice(&dev); (void)hipDeviceGetAttribute(&cus, hipDeviceAttributeMultiprocessorCount, dev);
        (void)hipFuncSetAttribute((const void*)hybrid_fwd, hipFuncAttributeMaxDynamicSharedMemorySize, LDS_BYTES);
        (void)hipOccupancyMaxActiveBlocksPerMultiprocessor(&per_cu, (const void*)hybrid_fwd, 512, LDS_BYTES);
        if (per_cu < 1) per_cu = 1;
        grid = cus * per_cu;
        (void)hipGetLastError();
    }
    if (grid < 0) return;
    Params p{};
    for (int i = 0; i < 22; ++i) p.in[i] = (const float*)d_in[i];
    p.out = (float*)d_out; p.ws = (unsigned char*)d_ws;
    if (hipMemsetAsync(d_ws, 0, 16384, stream) != hipSuccess) { fprintf(stderr, "kernel_launch: hipMemsetAsync of the barrier words failed\n"); return; }
    void* args[] = {&p};
    hipError_t e = hipLaunchCooperativeKernel((const void*)hybrid_fwd, dim3(grid), dim3(512), args, LDS_BYTES, stream);
    if (e != hipSuccess) fprintf(stderr, "cooperative launch failed: %s (grid %d)\n", hipGetErrorString(e), grid);
}
```
